# Optimizing an MI355X kernel written in HIP

```python
import jax
import jax.numpy as jnp
from jax import lax
import numpy as np

D_MODEL = 2048
BATCH = 4
SEQ = 2048
DEPTH = 2

GRID_W = 64
CTX_LEN = 256
N_GROUPS = 4
GROUP_W = D_MODEL // N_GROUPS
HEAD_DIM = 128
EPS = 1e-6

GLA_HEADS = GROUP_W // HEAD_DIM
GLA_DV = HEAD_DIM
GLA_DK = HEAD_DIM // 2
GLA_RANK = 16
GLA_TAU = 16.0
GLA_CHUNK = 32

GDN_HEADS = GROUP_W // HEAD_DIM
GDN_DK = HEAD_DIM
GDN_DV = HEAD_DIM
GDN_CONV = 5
GDN_CHUNK = 64

SC_WIDTH = GROUP_W
SC_CONV = 3

SWA_HEADS = GROUP_W // HEAD_DIM
SWA_KV_HEADS = 2
SWA_WINDOW = 128
SWA_BLOCK = 128
ROPE_BASE = 10000.0

IN_SPLITS = (
    ("gla_q", GLA_HEADS * GLA_DK), ("gla_k", GLA_HEADS * GLA_DK), ("gla_v", GLA_HEADS * GLA_DV),
    ("gla_lr_f", GLA_RANK), ("gla_lr_b", GLA_RANK), ("gla_gate", GROUP_W),
    ("gdn_q", GDN_HEADS * GDN_DK), ("gdn_k", GDN_HEADS * GDN_DK), ("gdn_v", GDN_HEADS * GDN_DV),
    ("gdn_a_f", GDN_HEADS), ("gdn_a_b", GDN_HEADS), ("gdn_b_f", GDN_HEADS), ("gdn_b_b", GDN_HEADS),
    ("gdn_gate", GROUP_W),
    ("sc_b", SC_WIDTH), ("sc_c", SC_WIDTH), ("sc_h", SC_WIDTH), ("sc_gate", GROUP_W),
    ("swa_q", SWA_HEADS * HEAD_DIM), ("swa_k", SWA_KV_HEADS * HEAD_DIM), ("swa_v", SWA_KV_HEADS * HEAD_DIM),
    ("swa_gate", GROUP_W),
)
IN_WIDTH = sum(size for _, size in IN_SPLITS)

kernel_name = "hybrid_parallel_group_flow_block"


def split_cols(u):
    out, off = {}, 0
    for name, size in IN_SPLITS:
        out[name] = u[..., off:off + size]
        off += size
    return out


def rmsnorm(x, g):
    xf = x.astype(jnp.float32)
    y = xf * lax.rsqrt(jnp.mean(xf * xf, axis=-1, keepdims=True) + EPS)
    return (y * g.astype(jnp.float32)).astype(x.dtype)


def l2norm(x):
    xf = x.astype(jnp.float32)
    return (xf * lax.rsqrt(jnp.sum(xf * xf, axis=-1, keepdims=True) + EPS)).astype(x.dtype)


def to_heads(t, n):
    b, l, _ = t.shape
    return t.reshape(b, l, n, -1).transpose(0, 2, 1, 3)


def from_heads(t):
    b, h, l, d = t.shape
    return t.transpose(0, 2, 1, 3).reshape(b, l, h * d)


def flip_seq(t):
    return jnp.flip(t, axis=2)


def dwconv(x, w):
    width = w.shape[0]
    return lax.conv_general_dilated(
        x, w[:, None, :].astype(x.dtype), window_strides=(1,),
        padding=[(width // 2, width // 2)], dimension_numbers=("NWC", "WIO", "NWC"),
        feature_group_count=x.shape[-1])


def axial_rope_tables(seq_len):
    rows = seq_len // GRID_W
    row = jnp.repeat(jnp.arange(rows, dtype=jnp.float32), GRID_W)
    col = jnp.tile(jnp.arange(GRID_W, dtype=jnp.float32), rows)
    axis_dim = HEAD_DIM // 2
    inv_freq = ROPE_BASE ** (-jnp.arange(0, axis_dim, 2, dtype=jnp.float32) / axis_dim)
    ang_r = row[:, None] * inv_freq
    ang_c = col[:, None] * inv_freq
    return (jnp.cos(ang_r), jnp.sin(ang_r), jnp.cos(ang_c), jnp.sin(ang_c))


def rotate_half(x, cos, sin):
    x1, x2 = jnp.split(x, 2, axis=-1)
    cos = cos[None, :, None, :].astype(x.dtype)
    sin = sin[None, :, None, :].astype(x.dtype)
    return jnp.concatenate([x1 * cos - x2 * sin, x2 * cos + x1 * sin], axis=-1)


def rope2d(x, tabs):
    cos_r, sin_r, cos_c, sin_c = tabs
    half = HEAD_DIM // 2
    return jnp.concatenate([rotate_half(x[..., :half], cos_r, sin_r),
                            rotate_half(x[..., half:], cos_c, sin_c)], axis=-1)


def gla_scan(q, k, v, log_a, s0):
    out_dtype = v.dtype
    q, k, v, log_a = (t.astype(jnp.float32) for t in (q, k, v, log_a))
    b, h, l, dk = q.shape
    dv = v.shape[-1]
    n = l // GLA_CHUNK
    q, k, log_a = (t.reshape(b, h, n, GLA_CHUNK, dk) for t in (q, k, log_a))
    v = v.reshape(b, h, n, GLA_CHUNK, dv)
    cum = jnp.cumsum(log_a, axis=3)
    incl = jnp.tril(jnp.ones((GLA_CHUNK, GLA_CHUNK), bool))[:, :, None]
    pair = jnp.exp(jnp.where(incl, cum[..., :, None, :] - cum[..., None, :, :], -jnp.inf))
    attn = jnp.einsum("bhnid,bhnjd,bhnijd->bhnij", q, k, pair)
    o_intra = jnp.einsum("bhnij,bhnjv->bhniv", attn, v)
    q_in = q * jnp.exp(cum)
    k_out = k * jnp.exp(cum[..., -1:, :] - cum)
    chunk_decay = jnp.exp(cum[..., -1, :])

    def step(state, inp):
        q_n, k_n, v_n, d_n = inp
        o = jnp.einsum("bhcd,bhdv->bhcv", q_n, state)
        state = state * d_n[..., None] + jnp.einsum("bhcd,bhcv->bhdv", k_n, v_n)
        return state, o

    xs = tuple(jnp.moveaxis(t, 2, 0) for t in (q_in, k_out, v, chunk_decay))
    state, o_inter = lax.scan(step, s0, xs)
    o = jnp.moveaxis(o_inter, 0, 2) + o_intra
    return o.reshape(b, h, l, dv).astype(out_dtype), state


def gla_mixer(s, sc, w_decay, b_decay, norm_w, with_ctx):
    def prep(seg):
        q = to_heads(seg["gla_q"], GLA_HEADS) * (GLA_DK ** -0.5)
        k = to_heads(seg["gla_k"], GLA_HEADS)
        v = to_heads(seg["gla_v"], GLA_HEADS)

        def log_decay(lr, d):
            z = (lr @ w_decay[d] + b_decay[d]).astype(jnp.float32)
            return to_heads(jax.nn.log_sigmoid(z) / GLA_TAU, GLA_HEADS)
        return q, k, v, log_decay(seg["gla_lr_f"], 0), log_decay(seg["gla_lr_b"], 1)

    q, k, v, la_f, la_b = prep(s)
    qc, kc, vc, lc_f, lc_b = prep(sc)
    s0 = jnp.zeros((q.shape[0], GLA_HEADS, GLA_DK, GLA_DV), jnp.float32)
    oc_f, st_f = gla_scan(qc, kc, vc, lc_f, s0)
    oc_b, st_b = gla_scan(flip_seq(qc), flip_seq(kc), flip_seq(vc), flip_seq(lc_b), s0)
    o_f, _ = gla_scan(q, k, v, la_f, st_f)
    o_b, _ = gla_scan(flip_seq(q), flip_seq(k), flip_seq(v), flip_seq(la_b), st_b)

    def finish(o, seg):
        return from_heads(rmsnorm(o, norm_w)) * jax.nn.silu(seg["gla_gate"])
    y = finish(o_f + flip_seq(o_b), s)
    yc = finish(oc_f + flip_seq(oc_b), sc) if with_ctx else None
    return y, yc


def gdn_scan(q, k, v, g, beta, s0):
    out_dtype = v.dtype
    q, k, v, g, beta = (t.astype(jnp.float32) for t in (q, k, v, g, beta))
    b, h, l, dk = q.shape
    dv = v.shape[-1]
    n = l // GDN_CHUNK
    q, k = (t.reshape(b, h, n, GDN_CHUNK, dk) for t in (q, k))
    v = v.reshape(b, h, n, GDN_CHUNK, dv)
    g, beta = (t.reshape(b, h, n, GDN_CHUNK) for t in (g, beta))
    cum = jnp.cumsum(g, axis=-1)
    incl = jnp.tril(jnp.ones((GDN_CHUNK, GDN_CHUNK), bool))
    strict = jnp.tril(jnp.ones((GDN_CHUNK, GDN_CHUNK), bool), -1)
    decay = jnp.exp(jnp.where(incl, cum[..., :, None] - cum[..., None, :], -jnp.inf))
    k_beta = k * beta[..., None]
    lower = jnp.where(strict, jnp.einsum("bhnid,bhnjd->bhnij", k_beta, k) * decay, 0.0)
    a_mat = lower + jnp.eye(GDN_CHUNK, dtype=jnp.float32)
    u = lax.linalg.triangular_solve(a_mat, v * beta[..., None], left_side=True, lower=True)
    w = lax.linalg.triangular_solve(a_mat, k_beta * jnp.exp(cum)[..., None], left_side=True, lower=True)
    attn = jnp.einsum("bhnid,bhnjd->bhnij", q, k) * decay
    q_in = q * jnp.exp(cum)[..., None]
    k_out = k * jnp.exp(cum[..., -1:] - cum)[..., None]
    chunk_decay = jnp.exp(cum[..., -1])

    def step(state, inp):
        u_n, w_n, q_n, k_n, a_n, d_n = inp
        v_new = u_n - jnp.einsum("bhcd,bhdv->bhcv", w_n, state)
        o = jnp.einsum("bhcd,bhdv->bhcv", q_n, state) + jnp.einsum("bhij,bhjv->bhiv", a_n, v_new)
        state = state * d_n[..., None, None] + jnp.einsum("bhcd,bhcv->bhdv", k_n, v_new)
        return state, o

    xs = tuple(jnp.moveaxis(t, 2, 0) for t in (u, w, q_in, k_out, attn, chunk_decay))
    state, o = lax.scan(step, s0, xs)
    o = jnp.moveaxis(o, 0, 2).reshape(b, h, l, dv)
    return o.astype(out_dtype), state


def gdn_mixer(s, sc, conv_w, a_log, dt_bias, norm_w, with_ctx):
    qd = GDN_HEADS * GDN_DK

    def prep(seg):
        qkv = jnp.concatenate([seg["gdn_q"], seg["gdn_k"], seg["gdn_v"]], axis=-1)
        qkv = jax.nn.silu(dwconv(qkv, conv_w))
        q = l2norm(to_heads(qkv[..., :qd], GDN_HEADS)) * (GDN_DK ** -0.5)
        k = l2norm(to_heads(qkv[..., qd:2 * qd], GDN_HEADS))
        v = to_heads(qkv[..., 2 * qd:], GDN_HEADS)

        def gates(a_in, b_in, d):
            a32 = a_in.astype(jnp.float32)
            g = -jnp.exp(a_log[d].astype(jnp.float32)) * jax.nn.softplus(a32 + dt_bias[d].astype(jnp.float32))
            return g.transpose(0, 2, 1), jax.nn.sigmoid(b_in.astype(jnp.float32)).transpose(0, 2, 1)
        g_f, b_f = gates(seg["gdn_a_f"], seg["gdn_b_f"], 0)
        g_b, b_b = gates(seg["gdn_a_b"], seg["gdn_b_b"], 1)
        return q, k, v, g_f, b_f, g_b, b_b

    q, k, v, g_f, b_f, g_b, b_b = prep(s)
    qc, kc, vc, gc_f, bc_f, gc_b, bc_b = prep(sc)
    s0 = jnp.zeros((q.shape[0], GDN_HEADS, GDN_DK, GDN_DV), jnp.float32)
    oc_f, st_f = gdn_scan(qc, kc, vc, gc_f, bc_f, s0)
    oc_b, st_b = gdn_scan(flip_seq(qc), flip_seq(kc), flip_seq(vc), flip_seq(gc_b), flip_seq(bc_b), s0)
    o_f, _ = gdn_scan(q, k, v, g_f, b_f, st_f)
    o_b, _ = gdn_scan(flip_seq(q), flip_seq(k), flip_seq(v), flip_seq(g_b), flip_seq(b_b), st_b)

    def finish(o, seg):
        return from_heads(rmsnorm(o, norm_w)) * jax.nn.silu(seg["gdn_gate"])
    y = finish(o_f + flip_seq(o_b), s)
    yc = finish(oc_f + flip_seq(oc_b), sc) if with_ctx else None
    return y, yc


def shortconv_branch(seg, conv_w):
    return seg["sc_b"] * dwconv(seg["sc_c"] * seg["sc_h"], conv_w) * jax.nn.silu(seg["sc_gate"])


def swa_latent(q, k, v, kc, vc, sink):
    b, l, hq, d = q.shape
    hkv = k.shape[2]
    grp = hq // hkv
    blk = SWA_BLOCK
    nb = l // blk
    lc = kc.shape[1]
    qb = q.reshape(b, nb, blk, hkv, grp, d)

    def band(t):
        tp = jnp.pad(t, ((0, 0), (blk, blk), (0, 0), (0, 0))).reshape(b, nb + 2, blk, hkv, d)
        return jnp.concatenate([tp[:, :-2], tp[:, 1:-1], tp[:, 2:]], axis=2)
    kb, vb = band(k), band(v)
    qpos = jnp.arange(l).reshape(nb, blk)
    kpos = qpos[:, :1] - blk + jnp.arange(3 * blk)[None, :]
    valid = ((jnp.abs(qpos[:, :, None] - kpos[:, None, :]) <= SWA_WINDOW)
             & (kpos[:, None, :] >= 0) & (kpos[:, None, :] < l))
    scale = HEAD_DIM ** -0.5
    s_loc = jnp.einsum("bnqhgd,bnkhd->bnhgqk", qb, kb).astype(jnp.float32) * scale
    s_loc = jnp.where(valid[None, :, None, None], s_loc, -jnp.inf)
    s_ctx = jnp.einsum("bnqhgd,bchd->bnhgqc", qb, kc).astype(jnp.float32) * scale
    s_sink = jnp.broadcast_to(sink.astype(jnp.float32).reshape(hkv, grp)[None, None, :, :, None, None],
                              s_loc.shape[:-1] + (1,))
    p = jax.nn.softmax(jnp.concatenate([s_loc, s_ctx, s_sink], axis=-1), axis=-1).astype(v.dtype)
    o = (jnp.einsum("bnhgqk,bnkhd->bnqhgd", p[..., :3 * blk], vb)
         + jnp.einsum("bnhgqc,bchd->bnqhgd", p[..., 3 * blk:3 * blk + lc], vc))
    return o.reshape(b, l, hq * d)


def ctx_attention(qc, kc, vc, sink):
    b, lc, hq, d = qc.shape
    hkv = kc.shape[2]
    grp = hq // hkv
    qg = qc.reshape(b, lc, hkv, grp, d)
    s = jnp.einsum("bqhgd,bkhd->bhgqk", qg, kc).astype(jnp.float32) * (HEAD_DIM ** -0.5)
    s_sink = jnp.broadcast_to(sink.astype(jnp.float32).reshape(hkv, grp)[None, :, :, None, None],
                              s.shape[:-1] + (1,))
    p = jax.nn.softmax(jnp.concatenate([s, s_sink], axis=-1), axis=-1)[..., :lc].astype(vc.dtype)
    return jnp.einsum("bhgqk,bkhd->bqhgd", p, vc).reshape(b, lc, hq * d)


def swa_mixer(s, sc, sink, rope, with_ctx):
    def qkv(seg):
        b, l, _ = seg["swa_q"].shape
        return (seg["swa_q"].reshape(b, l, SWA_HEADS, HEAD_DIM),
                seg["swa_k"].reshape(b, l, SWA_KV_HEADS, HEAD_DIM),
                seg["swa_v"].reshape(b, l, SWA_KV_HEADS, HEAD_DIM))
    q, k, v = qkv(s)
    qc, kc, vc = qkv(sc)
    q, k = rope2d(q, rope), rope2d(k, rope)
    y = swa_latent(q, k, v, kc, vc, sink) * jax.nn.silu(s["swa_gate"])
    yc = ctx_attention(qc, kc, vc, sink) * jax.nn.silu(sc["swa_gate"]) if with_ctx else None
    return y, yc


def setup_inputs(seed: int = 0) -> dict:
    key = jax.random.key(seed)
    ks = jax.random.split(key, 24)
    D = D_MODEL

    def nrm(k, shape, scale):
        return jax.random.normal(k, shape, jnp.float32) * scale

    dt = jnp.exp(jax.random.uniform(ks[14], (DEPTH, 2, GDN_HEADS), jnp.float32,
                                    np.log(1e-3), np.log(1e-1)))
    return {
        "x": nrm(ks[0], (BATCH, SEQ, D), 1.0),
        "c": nrm(ks[1], (BATCH, D), 1.0),
        "ctx": nrm(ks[2], (BATCH, CTX_LEN, D), 1.0),
        "c_ctx": nrm(ks[3], (D,), 1.0),
        "ada_w": nrm(ks[4], (DEPTH, D, 3 * D), 0.5 * D ** -0.5),
        "ada_b": nrm(ks[5], (DEPTH, 3 * D), 0.02),
        "norm_pre": 1.0 + nrm(ks[6], (DEPTH, D), 0.05),
        "norm_post": 1.0 + nrm(ks[7], (DEPTH, D), 0.05),
        "w_in": nrm(ks[8], (DEPTH, D, IN_WIDTH), D ** -0.5),
        "w_out": nrm(ks[9], (DEPTH, D, D), D ** -0.5),
        "gla_w_decay": nrm(ks[10], (DEPTH, 2, GLA_RANK, GLA_HEADS * GLA_DK), GLA_RANK ** -0.5),
        "gla_b_decay": 1.0 + nrm(ks[11], (DEPTH, 2, GLA_HEADS * GLA_DK), 0.5),
        "gla_norm": 1.0 + nrm(ks[12], (DEPTH, GLA_DV), 0.05),
        "gdn_conv": nrm(ks[13], (DEPTH, GDN_CONV, 3 * GDN_HEADS * GDN_DK), GDN_CONV ** -0.5),
        "gdn_a_log": jnp.log(jax.random.uniform(ks[15], (DEPTH, 2, GDN_HEADS), jnp.float32, 1.0, 16.0)),
        "gdn_dt_bias": dt + jnp.log(-jnp.expm1(-dt)),
        "gdn_norm": 1.0 + nrm(ks[16], (DEPTH, GDN_DV), 0.05),
        "sc_conv": nrm(ks[17], (DEPTH, SC_CONV, SC_WIDTH), SC_CONV ** -0.5),
        "swa_sink": nrm(ks[18], (DEPTH, SWA_HEADS), 0.5),
    }


def reference(x, c, ctx, c_ctx, ada_w, ada_b, norm_pre, norm_post, w_in, w_out,
              gla_w_decay, gla_b_decay, gla_norm, gdn_conv, gdn_a_log, gdn_dt_bias, gdn_norm,
              sc_conv, swa_sink):
    rope = axial_rope_tables(x.shape[1])
    h, hc = x, ctx
    for layer in range(DEPTH):
        with_ctx = layer < DEPTH - 1
        shift, scale, gate = jnp.split(jax.nn.silu(c) @ ada_w[layer] + ada_b[layer], 3, axis=-1)
        shift_c, scale_c, gate_c = jnp.split(jax.nn.silu(c_ctx) @ ada_w[layer] + ada_b[layer], 3, axis=-1)
        n = rmsnorm(h, norm_pre[layer]) * (1.0 + scale[:, None]) + shift[:, None]
        nc = rmsnorm(hc, norm_pre[layer]) * (1.0 + scale_c) + shift_c
        s = split_cols(n @ w_in[layer])
        sc = split_cols(nc @ w_in[layer])

        ya, yca = gla_mixer(s, sc, gla_w_decay[layer], gla_b_decay[layer], gla_norm[layer], with_ctx)
        yb, ycb = gdn_mixer(s, sc, gdn_conv[layer], gdn_a_log[layer], gdn_dt_bias[layer], gdn_norm[layer], with_ctx)
        yc_ = shortconv_branch(s, sc_conv[layer])
        yd, ycd = swa_mixer(s, sc, swa_sink[layer], rope, with_ctx)

        y = jnp.concatenate([ya, yb, yc_, yd], axis=-1) @ w_out[layer]
        h = h + gate[:, None] * rmsnorm(y, norm_post[layer])
        if with_ctx:
            ycc = shortconv_branch(sc, sc_conv[layer])
            yctx = jnp.concatenate([yca, ycb, ycc, ycd], axis=-1) @ w_out[layer]
            hc = hc + gate_c * rmsnorm(yctx, norm_post[layer])
    return h
```

```cpp
#include <hip/hip_runtime.h>
#include <hip/hip_cooperative_groups.h>
#include <cstdio>
namespace cg = cooperative_groups;

#define DI __device__ __forceinline__
#define LAS __attribute__((address_space(3)))
typedef unsigned short bf16_t;
typedef short bf16x8 __attribute__((ext_vector_type(8)));
typedef short s16x4 __attribute__((ext_vector_type(4)));
typedef float f32x4 __attribute__((ext_vector_type(4)));
typedef unsigned u32x4 __attribute__((ext_vector_type(4)));
typedef unsigned u32x2 __attribute__((ext_vector_type(2)));

constexpr int DM = 2048, NBATCH = 4, SL = 2048, CL = 256, NROW = 9216, NLAT = 8192, INW = 7216, NP = 7168, PT = 2304, NNAR = 48;
constexpr int C_GLA_Q = 0, C_GLA_K = 256, C_GLA_V = 512, C_GLA_G = 1024, C_GDN_Q = 1536, C_GDN_K = 2048, C_GDN_V = 2560,
              C_GDN_G = 3072, C_SC_B = 3584, C_SC_C = 4096, C_SC_H = 4608, C_SC_G = 5120, C_SWA_Q = 5632,
              C_SWA_K = 6144, C_SWA_V = 6400, C_SWA_G = 6656;
constexpr int G_LR = 0, G_A = 32, G_B = 40;
constexpr int LDS_BYTES = 147456;
#ifndef REP_P0
#define REP_P0 1
#endif
#ifndef REP_G1
#define REP_G1 1
#endif
#ifndef REP_PREP
#define REP_PREP 1
#endif
#ifndef REP_SCAN
#define REP_SCAN 1
#endif
#ifndef REP_GDNP
#define REP_GDNP 1
#endif
#ifndef REP_GLAP
#define REP_GLAP 1
#endif
#ifndef REP_GLAS
#define REP_GLAS 1
#endif
#ifndef REP_GDNS
#define REP_GDNS 1
#endif
#ifndef REP_SWA
#define REP_SWA 1
#endif
#ifndef REP_G2
#define REP_G2 1
#endif

constexpr size_t al256(size_t x) { return (x + 255) & ~(size_t)255; }
constexpr size_t WS_WINT = 0;
constexpr size_t WS_WOUTT = WS_WINT + al256((size_t)2 * NP * DM * 2);
constexpr size_t WS_MOD = WS_WOUTT + al256((size_t)2 * DM * DM * 2);
constexpr size_t WS_NBUF = WS_MOD + al256((size_t)2 * 5 * 6144 * 4);
constexpr size_t WS_SBUF = WS_NBUF + al256((size_t)NROW * DM * 2);
constexpr size_t WS_YBUF = WS_SBUF + al256((size_t)NROW * NP * 2);
constexpr size_t WS_HC = WS_YBUF + al256((size_t)NROW * DM * 2);
constexpr size_t WS_GLA_QT = WS_HC + al256((size_t)1024 * DM * 4);
constexpr size_t WS_GLA_KO = WS_GLA_QT + al256((size_t)32 * PT * 64 * 2);
constexpr size_t WS_GLA_AT = WS_GLA_KO + al256((size_t)32 * PT * 64 * 2);
constexpr size_t WS_GLA_DC = WS_GLA_AT + al256((size_t)32 * 72 * 32 * 32 * 2);
constexpr size_t WS_GDN_U = WS_GLA_DC + al256((size_t)32 * 72 * 64 * 4);
constexpr size_t WS_GDN_W = WS_GDN_U + al256((size_t)32 * PT * 128 * 2);
constexpr size_t WS_GDN_QI = WS_GDN_W + al256((size_t)32 * PT * 128 * 2);
constexpr size_t WS_GDN_KO = WS_GDN_QI + al256((size_t)32 * PT * 128 * 2);
constexpr size_t WS_GDN_AT = WS_GDN_KO + al256((size_t)32 * PT * 128 * 2);
constexpr size_t WS_GDN_DC = WS_GDN_AT + al256((size_t)32 * 36 * 64 * 64 * 2);
constexpr size_t WS_WNT = WS_GDN_DC + al256((size_t)32 * 36 * 4);
constexpr size_t WS_G = WS_WNT + al256((size_t)2 * NNAR * DM * 2);
constexpr size_t WS_KR = WS_G + al256((size_t)NROW * NNAR * 4);
constexpr size_t WS_BAR = WS_KR + al256((size_t)NLAT * 256 * 2);
constexpr size_t WS_END = WS_BAR + al256((size_t)3456 * 4);

struct P {
    const float *x, *c, *ctx, *c_ctx, *ada_w, *ada_b, *norm_pre, *norm_post, *w_in, *w_out, *gla_wd, *gla_bd, *gla_norm, *gdn_conv, *gdn_alog,
        *gdn_dtb, *gdn_norm, *sc_conv, *swa_sink;
    float* out;
    unsigned char* ws;
};

typedef __bf16 bf16v2 __attribute__((ext_vector_type(2)));
DI bf16_t f2bf(float f) { return __builtin_bit_cast(bf16_t, (__bf16)f); }
DI float bf2f(bf16_t b) { return __uint_as_float(((unsigned)b) << 16); }
DI unsigned pk2(float lo, float hi) { bf16v2 v = {(__bf16)lo, (__bf16)hi}; return __builtin_bit_cast(unsigned, v); }
DI float lo16(unsigned u) { return __uint_as_float(u << 16); }
DI float hi16(unsigned u) { return __uint_as_float(u & 0xFFFF0000u); }
DI void unpack8(u32x4 v, float* o) { o[0] = lo16(v.x); o[1] = hi16(v.x); o[2] = lo16(v.y); o[3] = hi16(v.y); o[4] = lo16(v.z); o[5] = hi16(v.z); o[6] = lo16(v.w); o[7] = hi16(v.w); }
DI u32x4 pack8(const float* o) { u32x4 r; r.x = pk2(o[0], o[1]); r.y = pk2(o[2], o[3]); r.z = pk2(o[4], o[5]); r.w = pk2(o[6], o[7]); return r; }
DI float siluf(float x) { return x * __builtin_amdgcn_rcpf(1.f + __expf(-x)); }
DI bf16x8 ld8(const bf16_t* p) { return *(const bf16x8*)p; }
DI bf16x8 ld4x2(const bf16_t* p0, const bf16_t* p1) {
    s16x4 a = *(const s16x4*)p0, b = *(const s16x4*)p1;
    return __builtin_shufflevector(a, b, 0, 1, 2, 3, 4, 5, 6, 7);
}
DI s16x4 trread(const bf16_t* p) { return __builtin_amdgcn_ds_read_tr16_b64_v4i16((LAS s16x4*)p); }
DI bf16x8 tr2(const bf16_t* p0, const bf16_t* p1) { s16x4 a = trread(p0), b = trread(p1); return __builtin_shufflevector(a, b, 0, 1, 2, 3, 4, 5, 6, 7); }
DI bf16x8 packacc(f32x4 a, f32x4 b) {
    u32x4 r; r.x = pk2(a[0], a[1]); r.y = pk2(a[2], a[3]); r.z = pk2(b[0], b[1]); r.w = pk2(b[2], b[3]);
    return __builtin_bit_cast(bf16x8, r);
}
DI f32x4 mfma16(bf16x8 a, bf16x8 b, f32x4 c) { return __builtin_amdgcn_mfma_f32_16x16x32_bf16(a, b, c, 0, 0, 0); }
DI float wave_sum(float v) {
#pragma unroll
    for (int o = 32; o >= 1; o >>= 1) v += __shfl_xor(v, o);
    return v;
}
DI int otid() { int t = threadIdx.x; asm volatile("" : "+v"(t)); return t; }
DI int osgpr(int v) { asm volatile("" : "+s"(v)); return v; }
DI int prow(int b, int dir, int p) {
    if (p < CL) { const int t = dir ? (CL - 1 - p) : p; return NLAT + b * CL + t; }
    const int q = p - CL; const int t = dir ? (SL - 1 - q) : q; return b * SL + t;
}

namespace pg8 {
constexpr int BM = 256, BK = 64, HALF = 128, HTB = HALF * BK * 2, NXCD = 8, WGM = 4;
DI int lds_byte(int r, int c) { const int st = (r >> 4) * 2 + (c >> 5), rr = r & 15, cc = c & 31, ob = rr * 64 + cc * 2; return st * 1024 + (ob ^ (((ob >> 9) & 1) << 5)); }
DI void stage_rc(int b, int& R, int& C) { const int st = b / 1024, sb = b % 1024, swz = sb ^ (((sb >> 9) & 1) << 5); R = (st >> 1) * 16 + swz / 64; C = (st & 1) * 32 + (swz % 64) / 2; }
DI int perm32(int rho) { const int n = rho >> 4, i = rho & 15; return 8 * (i >> 2) + 4 * n + (i & 3); }
struct Unit { int pm, pn; };
struct Gemm { const bf16_t* A; const bf16_t* Bt; int M, N, K; };
struct StaticOrder {
    int nM, nN, nwg, G, c;
    DI void init(int M, int N, int G_, int c_) { nM = M / BM; nN = N / BM; nwg = nM * nN; G = G_; c = c_; }
    DI bool next(int i, Unit& u) const {
        const long L = (long)i * G + c; if (L >= nwg) return false;
        int wgid = (int)L; { const int q = nwg / NXCD, r = nwg % NXCD, xcd = wgid % NXCD, off = wgid / NXCD; wgid = (xcd < r ? xcd * (q + 1) : r * (q + 1) + (xcd - r) * q) + off; }
        const int nig = WGM * nN, gid = wgid / nig, fm = gid * WGM, gsz = (nM - fm) < WGM ? (nM - fm) : WGM;
        u.pm = fm + ((wgid % nig) % gsz); u.pn = (wgid % nig) / gsz; return true;
    }
};
struct EpiBf16 {
    bf16_t* O; int ldc;
    DI void operator()(const f32x4 (&acc)[2][2][4][2], const Unit& u, int wr, int wc, int fr, int fq) const {
        const int row0 = u.pm * BM + wr * 64 + fr; const int col0 = u.pn * BM + wc * 32 + 8 * fq;
#pragma unroll
        for (int ai = 0; ai < 2; ++ai)
#pragma unroll
            for (int m = 0; m < 4; ++m) { bf16_t* rowp = O + (size_t)(row0 + ai * HALF + m * 16) * ldc + col0;
#pragma unroll
                for (int bj = 0; bj < 2; ++bj) { const f32x4 v0 = acc[ai][bj][m][0], v1 = acc[ai][bj][m][1];
                    u32x4 w; w.x = pk2(v0[0], v0[1]); w.y = pk2(v0[2], v0[3]); w.z = pk2(v1[0], v1[1]); w.w = pk2(v1[2], v1[3]);
                    *(u32x4*)(rowp + bj * HALF) = w; } }
    }
};

DI void gemm_phase(LAS unsigned char* lds, const Gemm g, const StaticOrder& S, const EpiBf16& E) {
    const int tid = otid(), wid = __builtin_amdgcn_readfirstlane(tid >> 6), lane = tid & 63, wr = wid >> 2, wc = wid & 3, fr = lane & 15, fq = lane >> 4;
    const int K = g.K, nt = K / BK;
    unsigned voffA[2], voffB[2];
#pragma unroll
    for (int i = 0; i < 2; ++i) { int R, C; stage_rc(tid * 16 + i * 8192, R, C); const int Rb = (R & ~31) + perm32(R & 31);
        voffA[i] = (unsigned)(R * K + C) * 2u; voffB[i] = (unsigned)(Rb * K + C) * 2u; }
    const size_t kstep = (size_t)(BK * 2);
    const size_t hstep = (size_t)HALF * K * 2;
    const size_t tstep = 2 * hstep;
    const unsigned ldsw = (unsigned)wid * 1024u;
    const int aoff = lds_byte(wr * 64 + fr, fq * 8), boff = lds_byte(wc * 32 + fr, fq * 8);
#define PG8_SA(b, h) (((b) * 2 + (h)) * HTB)
#define PG8_SB(b, h) ((4 + (b) * 2 + (h)) * HTB)
#define PG8_STAGE(bufoff, gbase, voff) do { _Pragma("unroll") for (int _i = 0; _i < 2; ++_i) \
        __builtin_amdgcn_global_load_lds((const unsigned*)((const char*)(gbase) + (voff)[_i]), (LAS unsigned*)(lds + (bufoff) + ldsw + _i * 8192), 16, 0, 0); } while (0)
#define PG8_LDA(dst, b, h) do { _Pragma("unroll") for (int m = 0; m < 4; ++m) _Pragma("unroll") for (int k = 0; k < 2; ++k) dst[m][k] = *(const LAS bf16x8*)(lds + PG8_SA(b, h) + aoff + m * 2048 + k * 1024); } while (0)
#define PG8_LDB(dst, b, h) do { _Pragma("unroll") for (int n = 0; n < 2; ++n) _Pragma("unroll") for (int k = 0; k < 2; ++k) dst[n][k] = *(const LAS bf16x8*)(lds + PG8_SB(b, h) + boff + n * 2048 + k * 1024); } while (0)
#define PG8_MMA(ai, bj, At, Bt) do { __builtin_amdgcn_s_setprio(1); _Pragma("unroll") for (int m = 0; m < 4; ++m) _Pragma("unroll") for (int n = 0; n < 2; ++n) _Pragma("unroll") for (int k = 0; k < 2; ++k) \
        acc[ai][bj][m][n] = __builtin_amdgcn_mfma_f32_16x16x32_bf16(Bt[n][k], At[m][k], acc[ai][bj][m][n], 0, 0, 0); __builtin_amdgcn_s_setprio(0); } while (0)
#define PG8_WAIT_V(n) asm volatile("s_waitcnt vmcnt(" #n ")" ::: "memory")
#define PG8_WAIT_L(n) asm volatile("s_waitcnt lgkmcnt(" #n ")" ::: "memory")
#define PG8_BAR __builtin_amdgcn_s_barrier()
#define PG8_SCHED __builtin_amdgcn_sched_barrier(0)
    Unit cur, nxt; int ui = 0;
    if (!S.next(0, cur)) return;
    f32x4 acc[2][2][4][2];
#pragma unroll
    for (int a = 0; a < 2; ++a)
#pragma unroll
        for (int b = 0; b < 2; ++b)
#pragma unroll
            for (int m = 0; m < 4; ++m)
#pragma unroll
                for (int n = 0; n < 2; ++n) acc[a][b][m][n] = (f32x4){0.f, 0.f, 0.f, 0.f};
    bf16x8 At[4][2], B0[2][2], B1[2][2];
    const char* cA = (const char*)g.A + (size_t)cur.pm * tstep; const char* cB = (const char*)g.Bt + (size_t)cur.pn * tstep;
    PG8_STAGE(PG8_SB(0, 0), cB, voffB); PG8_STAGE(PG8_SA(0, 0), cA, voffA); PG8_STAGE(PG8_SB(0, 1), cB + hstep, voffB); PG8_STAGE(PG8_SA(0, 1), cA + hstep, voffA);
    if (wr == 1) PG8_BAR;
    PG8_WAIT_V(4); PG8_BAR;
    PG8_STAGE(PG8_SB(1, 0), cB + kstep, voffB); PG8_STAGE(PG8_SA(1, 0), cA + kstep, voffA); PG8_STAGE(PG8_SB(1, 1), cB + hstep + kstep, voffB);
    PG8_WAIT_V(6); PG8_BAR;
    for (;;) {
        const bool has_next = S.next(ui + 1, nxt);
        const char* nA = has_next ? (const char*)g.A + (size_t)nxt.pm * tstep : cA; const char* nB = has_next ? (const char*)g.Bt + (size_t)nxt.pn * tstep : cB;
        for (int t = 0; t < nt; t += 2) {
            const bool last = (t == nt - 2);
            const char* a1 = cA + (size_t)(t + 1) * kstep;
            const char* a2 = last ? nA : cA + (size_t)(t + 2) * kstep; const char* b2 = last ? nB : cB + (size_t)(t + 2) * kstep;
            const char* a3 = a2 + kstep; const char* b3 = b2 + kstep;
            PG8_LDB(B0, 0, 0); PG8_SCHED; PG8_LDA(At, 0, 0); PG8_STAGE(PG8_SA(1, 1), a1 + hstep, voffA);
            PG8_WAIT_L(8); PG8_BAR; PG8_WAIT_L(0); PG8_MMA(0, 0, At, B0); PG8_BAR; PG8_SCHED;
            PG8_LDB(B1, 0, 1); PG8_STAGE(PG8_SB(0, 0), b2, voffB);
            PG8_BAR; PG8_WAIT_L(0); PG8_MMA(0, 1, At, B1); PG8_BAR;
            PG8_LDA(At, 0, 1); PG8_STAGE(PG8_SA(0, 0), a2, voffA);
            PG8_BAR; PG8_WAIT_L(0); PG8_MMA(1, 0, At, B0); PG8_BAR; PG8_SCHED;
            PG8_STAGE(PG8_SB(0, 1), b2 + hstep, voffB);
            PG8_WAIT_V(6); PG8_BAR; PG8_MMA(1, 1, At, B1); PG8_BAR;
            PG8_LDB(B0, 1, 0); PG8_SCHED; PG8_LDA(At, 1, 0); PG8_STAGE(PG8_SA(0, 1), a2 + hstep, voffA);
            PG8_WAIT_L(8); PG8_BAR; PG8_WAIT_L(0); PG8_MMA(0, 0, At, B0); PG8_BAR; PG8_SCHED;
            PG8_LDB(B1, 1, 1); PG8_STAGE(PG8_SB(1, 0), b3, voffB);
            PG8_BAR; PG8_WAIT_L(0); PG8_MMA(0, 1, At, B1); PG8_BAR;
            PG8_LDA(At, 1, 1); PG8_STAGE(PG8_SA(1, 0), a3, voffA);
            PG8_BAR; PG8_WAIT_L(0); PG8_MMA(1, 0, At, B0); PG8_BAR; PG8_SCHED;
            PG8_STAGE(PG8_SB(1, 1), b3 + hstep, voffB);
            PG8_WAIT_V(6); PG8_BAR; PG8_MMA(1, 1, At, B1); PG8_BAR;
        }
        E(acc, cur, wr, wc, fr, fq);
        if (!has_next) break;
#pragma unroll
        for (int a = 0; a < 2; ++a)
#pragma unroll
            for (int b = 0; b < 2; ++b)
#pragma unroll
                for (int m = 0; m < 4; ++m)
#pragma unroll
                    for (int n = 0; n < 2; ++n) acc[a][b][m][n] = (f32x4){0.f, 0.f, 0.f, 0.f};
        cur = nxt; cA = nA; cB = nB; ++ui;
    }
    PG8_WAIT_V(0);
    if (wr == 0) PG8_BAR;
    PG8_BAR;
#undef PG8_SA
#undef PG8_SB
#undef PG8_STAGE
#undef PG8_LDA
#undef PG8_LDB
#undef PG8_MMA
#undef PG8_WAIT_V
#undef PG8_WAIT_L
#undef PG8_BAR
#undef PG8_SCHED
}
}

DI void adaln_item(const P& p, int a, unsigned char* smem) {
    float* sc = (float*)smem;
    float* red = sc + 5 * 2048;
    float* mod = (float*)(p.ws + WS_MOD);
    const int tid = otid();
    for (int e = tid; e < 5 * 2048; e += 512) { const int r = e >> 11, k = e & 2047; const float v = r < 4 ? p.c[r * 2048 + k] : p.c_ctx[k]; sc[e] = siluf(v); }
    __syncthreads();
    const int l = a / 96, j0 = (a % 96) * 64, cg4 = (tid & 15) * 4, kg = tid >> 4;
    const float* w = p.ada_w + (size_t)l * 2048 * 6144 + j0 + cg4;
    f32x4 acc[5];
#pragma unroll
    for (int r = 0; r < 5; ++r) acc[r] = (f32x4){0.f, 0.f, 0.f, 0.f};
#pragma unroll 1
    for (int i0 = 0; i0 < 64; i0 += 16) {
        f32x4 wv[16];
#pragma unroll
        for (int i = 0; i < 16; ++i) wv[i] = __builtin_nontemporal_load((const f32x4*)(w + (size_t)(kg + 32 * (i0 + i)) * 6144));
#pragma unroll
        for (int i = 0; i < 16; ++i) {
            const int k = kg + 32 * (i0 + i);
#pragma unroll
            for (int r = 0; r < 5; ++r) acc[r] += wv[i] * sc[r * 2048 + k];
        }
    }
#pragma unroll
    for (int r = 0; r < 5; ++r) *(f32x4*)(red + (kg * 5 + r) * 64 + cg4) = acc[r];
    __syncthreads();
    if (tid < 320) {
        const int r = tid >> 6, tx = tid & 63; float sum = 0.f;
#pragma unroll
        for (int k2 = 0; k2 < 32; ++k2) sum += red[(k2 * 5 + r) * 64 + tx];
        mod[(l * 5 + r) * 6144 + j0 + tx] = sum + p.ada_b[l * 6144 + j0 + tx];
    }
    __syncthreads();
}

DI void transpose_item(const float* src, int ld, int srcoff, bf16_t* dst, int kt, int nt, unsigned char* smem) {
    float* tile = (float*)smem;
    const int tid = otid();
#pragma unroll
    for (int i = 0; i < 8; ++i) {
        const int kr = (tid >> 6) + 8 * i, nc = (tid & 63) * 4;
        const f32x4 v = __builtin_nontemporal_load((const f32x4*)(src + (size_t)(kt * 64 + kr) * ld + srcoff + nt * 256 + nc));
        tile[kr * 257 + nc + 0] = v[0]; tile[kr * 257 + nc + 1] = v[1]; tile[kr * 257 + nc + 2] = v[2]; tile[kr * 257 + nc + 3] = v[3];
    }
    __syncthreads();
    {
        const int n = tid >> 1, k0 = (tid & 1) * 32;
#pragma unroll
        for (int k8 = 0; k8 < 4; ++k8) {
            float o[8];
#pragma unroll
            for (int j = 0; j < 8; ++j) o[j] = tile[(k0 + 8 * k8 + j) * 257 + n];
            *(u32x4*)(dst + (size_t)(nt * 256 + n) * 2048 + kt * 64 + k0 + 8 * k8) = pack8(o);
        }
    }
    __syncthreads();
}
DI void narrow_item(const float* src, bf16_t* dst, int kt) {
    const int tid = otid();
#pragma unroll
    for (int j = 0; j < 6; ++j) {
        const int e = tid + 512 * j, kr = e / 48, cn = e % 48;
        const int sc = cn < 32 ? 1024 + cn : 3104 + (cn - 32);
        dst[(size_t)cn * 2048 + kt * 64 + kr] = f2bf(src[(size_t)(kt * 64 + kr) * INW + sc]);
    }
}
DI void skinny_tile(const P& p, int l, int r0, float* red) {
    const bf16_t* A = (const bf16_t*)(p.ws + WS_NBUF);
    const bf16_t* Bt = (const bf16_t*)(p.ws + WS_WNT) + (size_t)l * NNAR * DM;
    float* G = (float*)(p.ws + WS_G);
    const int tid = otid(), w = tid >> 6, lane = tid & 63, l15 = lane & 15, g = lane >> 4;
    f32x4 acc[3];
#pragma unroll
    for (int n = 0; n < 3; ++n) acc[n] = (f32x4){0.f, 0.f, 0.f, 0.f};
    const bf16_t* ap = A + (size_t)(r0 + l15) * DM + 256 * w + 8 * g;
    const bf16_t* bp = Bt + (size_t)l15 * DM + 256 * w + 8 * g;
#pragma unroll
    for (int ks = 0; ks < 8; ++ks) {
        const bf16x8 a0 = *(const bf16x8*)(ap + 32 * ks);
#pragma unroll
        for (int n = 0; n < 3; ++n) acc[n] = mfma16(a0, *(const bf16x8*)(bp + (size_t)16 * n * DM + 32 * ks), acc[n]);
    }
#pragma unroll
    for (int n = 0; n < 3; ++n)
#pragma unroll
        for (int r = 0; r < 4; ++r) red[w * 768 + (4 * g + r) * 48 + 16 * n + l15] = acc[n][r];
    __syncthreads();
    for (int e = tid; e < 768; e += 512) {
        float sum = 0.f;
#pragma unroll
        for (int k = 0; k < 8; ++k) sum += red[k * 768 + e];
        G[(size_t)r0 * NNAR + e] = sum;
    }
    __syncthreads();
}

DI void norm0_phase(const P& p, unsigned char* smem) {
    const int tid = otid(); const int wave = tid >> 6, lane = tid & 63;
    const float* mod = (const float*)(p.ws + WS_MOD);
    bf16_t* nb = (bf16_t*)(p.ws + WS_NBUF);
    for (int rt = osgpr(blockIdx.x); rt < NROW / 16; rt += gridDim.x) {
      for (int rr = 0; rr < 2; ++rr) {
        const int row = rt * 16 + wave * 2 + rr;
        const float* h = row < NLAT ? p.x + (size_t)row * DM : p.ctx + (size_t)(row - NLAT) * DM;
        const int mr = row < NLAT ? (row >> 11) : 4;
        f32x4 v[8]; float ss = 0.f;
#pragma unroll
        for (int i = 0; i < 8; ++i) { v[i] = __builtin_nontemporal_load((const f32x4*)(h + i * 256 + lane * 4)); ss += v[i][0] * v[i][0] + v[i][1] * v[i][1] + v[i][2] * v[i][2] + v[i][3] * v[i][3]; }
        ss = wave_sum(ss);
        const float rstd = rsqrtf(ss * (1.f / 2048.f) + 1e-6f);
        const float* md = mod + (size_t)mr * 6144;
#pragma unroll
        for (int i = 0; i < 8; ++i) {
            const int j = i * 256 + lane * 4;
            const f32x4 gw = *(const f32x4*)(p.norm_pre + j), sh = *(const f32x4*)(md + j), scl = *(const f32x4*)(md + 2048 + j);
            float o[4];
#pragma unroll
            for (int e = 0; e < 4; ++e) o[e] = v[i][e] * rstd * gw[e] * (1.f + scl[e]) + sh[e];
            u32x2 w; w.x = pk2(o[0], o[1]); w.y = pk2(o[2], o[3]);
            *(u32x2*)(nb + (size_t)row * DM + j) = w;
        }
      }
      asm volatile("s_waitcnt vmcnt(0)" ::: "memory"); __syncthreads();
      skinny_tile(p, 0, rt * 16, (float*)smem);
    }
}

DI void post_phase(const P& p, int l, unsigned char* smem, int t0, int t1, int bstart, int bstride) {
    const int tid = otid(); const int wave = tid >> 6, lane = tid & 63;
    const float* mod = (const float*)(p.ws + WS_MOD);
    bf16_t* nb = (bf16_t*)(p.ws + WS_NBUF);
    const bf16_t* yo = (const bf16_t*)(p.ws + WS_SBUF);
    float* hc = (float*)(p.ws + WS_HC);
    for (int rt = t0 + osgpr(bstart); rt < t1; rt += bstride) {
      for (int rr = 0; rr < 2; ++rr) {
        const int row = rt * 16 + wave * 2 + rr;
        const int mr = row < NLAT ? (row >> 11) : 4;
        const float* h = l == 0 ? (row < NLAT ? p.x + (size_t)row * DM : p.ctx + (size_t)(row - NLAT) * DM) : p.out + (size_t)row * DM;
        float* hdst = row < NLAT ? p.out + (size_t)row * DM : hc + (size_t)(row - NLAT) * DM;
        f32x4 y[8]; float ss = 0.f;
#pragma unroll
        for (int i = 0; i < 8; ++i) {
            const u32x2 w = __builtin_nontemporal_load((const u32x2*)(yo + (size_t)row * DM + i * 256 + lane * 4));
            y[i] = (f32x4){lo16(w.x), hi16(w.x), lo16(w.y), hi16(w.y)};
            ss += y[i][0] * y[i][0] + y[i][1] * y[i][1] + y[i][2] * y[i][2] + y[i][3] * y[i][3];
        }
        ss = wave_sum(ss);
        const float rstd = rsqrtf(ss * (1.f / 2048.f) + 1e-6f);
        const float* md = mod + (size_t)(l * 5 + mr) * 6144;
        float ss2 = 0.f;
#pragma unroll
        for (int i = 0; i < 8; ++i) {
            const int j = i * 256 + lane * 4;
            const f32x4 hv = __builtin_nontemporal_load((const f32x4*)(h + j)), gt = *(const f32x4*)(md + 4096 + j), nw = *(const f32x4*)(p.norm_post + l * DM + j);
#pragma unroll
            for (int e = 0; e < 4; ++e) { y[i][e] = hv[e] + gt[e] * (y[i][e] * rstd * nw[e]); ss2 += y[i][e] * y[i][e]; }
            __builtin_nontemporal_store(y[i], (f32x4*)(hdst + j));
        }
        if (l == 0) {
            ss2 = wave_sum(ss2);
            const float rstd2 = rsqrtf(ss2 * (1.f / 2048.f) + 1e-6f);
            const float* md1 = mod + (size_t)(5 + mr) * 6144;
#pragma unroll
            for (int i = 0; i < 8; ++i) {
                const int j = i * 256 + lane * 4;
                const f32x4 gw = *(const f32x4*)(p.norm_pre + DM + j), sh = *(const f32x4*)(md1 + j), scl = *(const f32x4*)(md1 + 2048 + j);
                float o[4];
#pragma unroll
                for (int e = 0; e < 4; ++e) o[e] = y[i][e] * rstd2 * gw[e] * (1.f + scl[e]) + sh[e];
                u32x2 w; w.x = pk2(o[0], o[1]); w.y = pk2(o[2], o[3]);
                *(u32x2*)(nb + (size_t)row * DM + j) = w;
            }
        }
      }
      if (l == 0) { asm volatile("s_waitcnt vmcnt(0)" ::: "memory"); __syncthreads(); skinny_tile(p, 1, rt * 16, (float*)smem); }
    }
}

DI void conv_item(const P& p, int l, int r32) {
    const bf16_t* S = (const bf16_t*)(p.ws + WS_SBUF);
    bf16_t* Y = (bf16_t*)(p.ws + WS_YBUF);
    const int tid = otid(); const int row0 = r32 * 32 + (tid >> 6) * 4, ch = (tid & 63) * 8;
    int t0, len;
    if (row0 < NLAT) { t0 = row0 & 2047; len = SL; } else { t0 = (row0 - NLAT) & 255; len = CL; }
    u32x4 rc[6], rh[6], rb[4], rg[4];
#pragma unroll
    for (int k = 0; k < 6; ++k) {
        int tt = t0 + k - 1; const int tcl = tt < 0 ? 0 : (tt >= len ? len - 1 : tt);
        const bf16_t* rp = S + (size_t)(row0 + (tcl - t0)) * NP;
        rc[k] = __builtin_nontemporal_load((const u32x4*)(rp + C_SC_C + ch)); rh[k] = __builtin_nontemporal_load((const u32x4*)(rp + C_SC_H + ch));
    }
#pragma unroll
    for (int k = 0; k < 4; ++k) { const bf16_t* rp = S + (size_t)(row0 + k) * NP; rb[k] = __builtin_nontemporal_load((const u32x4*)(rp + C_SC_B + ch)); rg[k] = __builtin_nontemporal_load((const u32x4*)(rp + C_SC_G + ch)); }
    f32x4 w0[3], w1[3];
#pragma unroll
    for (int j = 0; j < 3; ++j) { const float* w = p.sc_conv + (size_t)(l * 3 + j) * 512 + ch; w0[j] = *(const f32x4*)w; w1[j] = *(const f32x4*)(w + 4); }
    float prod[6][8];
#pragma unroll
    for (int k = 0; k < 6; ++k) {
        const int tt = t0 + k - 1; const float msk = (tt >= 0 && tt < len) ? 1.f : 0.f;
        float cc[8], hh[8]; unpack8(rc[k], cc); unpack8(rh[k], hh);
#pragma unroll
        for (int e = 0; e < 8; ++e) prod[k][e] = cc[e] * hh[e] * msk;
    }
#pragma unroll
    for (int k = 0; k < 4; ++k) {
        float bb[8], gg[8], o[8]; unpack8(rb[k], bb); unpack8(rg[k], gg);
#pragma unroll
        for (int e = 0; e < 8; ++e) {
            const float wa = e < 4 ? w0[0][e & 3] : w1[0][e & 3], wb = e < 4 ? w0[1][e & 3] : w1[1][e & 3], wc = e < 4 ? w0[2][e & 3] : w1[2][e & 3];
            const float acc = wa * prod[k][e] + wb * prod[k + 1][e] + wc * prod[k + 2][e];
            o[e] = bb[e] * acc * siluf(gg[e]);
        }
        *(u32x4*)(Y + (size_t)(row0 + k) * DM + 1024 + ch) = pack8(o);
    }
}

DI void finish_item(const P& p, int l, int r16) {
    const bf16_t* S = (const bf16_t*)(p.ws + WS_SBUF);
    bf16_t* Y = (bf16_t*)(p.ws + WS_YBUF);
    const bf16_t* O = (const bf16_t*)(p.ws + WS_NBUF);
    const int tid = otid(); const int row0 = r16 * 16 + (tid >> 7) * 4, u = tid & 127, mx = u >> 6, hh = (u >> 4) & 3, sub = u & 15;
    const int chn = 128 * hh + 8 * sub;
    u32x4 ra[4], rb[4], rg[4];
#pragma unroll
    for (int k = 0; k < 4; ++k) {
        ra[k] = __builtin_nontemporal_load((const u32x4*)(O + ((size_t)(mx * 2 + 0) * NROW + row0 + k) * 512 + chn));
        rb[k] = __builtin_nontemporal_load((const u32x4*)(O + ((size_t)(mx * 2 + 1) * NROW + row0 + k) * 512 + chn));
        rg[k] = __builtin_nontemporal_load((const u32x4*)(S + (size_t)(row0 + k) * NP + (mx ? C_GDN_G : C_GLA_G) + chn));
    }
    const float* nwp = (mx ? p.gdn_norm : p.gla_norm) + l * 128 + 8 * sub;
    const f32x4 nw0 = *(const f32x4*)nwp, nw1 = *(const f32x4*)(nwp + 4);
#pragma unroll
    for (int k = 0; k < 4; ++k) {
        float a[8], b[8], o[8], gt[8];
        unpack8(ra[k], a); unpack8(rb[k], b); unpack8(rg[k], gt);
        float ss = 0.f;
#pragma unroll
        for (int e = 0; e < 8; ++e) { o[e] = a[e] + b[e]; ss += o[e] * o[e]; }
        ss += __shfl_xor(ss, 1); ss += __shfl_xor(ss, 2); ss += __shfl_xor(ss, 4); ss += __shfl_xor(ss, 8);
        const float rstd = rsqrtf(ss * (1.f / 128.f) + 1e-6f);
#pragma unroll
        for (int e = 0; e < 8; ++e) o[e] = o[e] * rstd * (e < 4 ? nw0[e & 3] : nw1[e & 3]) * siluf(gt[e]);
        *(u32x4*)(Y + (size_t)(row0 + k) * DM + 512 * mx + chn) = pack8(o);
    }
}

DI void gla_prep_item(const P& p, int l, int item, unsigned char* smem) {
    const int c = item % 72, bd = item / 72, dir = bd & 1, b = bd >> 1;
    float* slr = (float*)smem;
    float* stot = slr + 512;
    float* slast = stot + 256;
    bf16_t* sq = (bf16_t*)(slast + 256);
    bf16_t* sk = sq + 4 * 32 * 72;
    const bf16_t* S = (const bf16_t*)(p.ws + WS_SBUF);
    bf16_t* QT = (bf16_t*)(p.ws + WS_GLA_QT); bf16_t* KO = (bf16_t*)(p.ws + WS_GLA_KO); bf16_t* AT = (bf16_t*)(p.ws + WS_GLA_AT); float* DC = (float*)(p.ws + WS_GLA_DC);
    const int tid = otid();
    { const int i = tid >> 4, r = tid & 15; slr[i * 16 + r] = ((const float*)(p.ws + WS_G))[(size_t)prow(b, dir, 32 * c + i) * NNAR + G_LR + 16 * dir + r]; }
    __syncthreads();
    const int cch = tid & 255, half = tid >> 8, h = cch >> 6, d = cch & 63;
    bf16_t qraw[16], kraw[16];
#pragma unroll
    for (int ii = 0; ii < 16; ++ii) { const size_t row = (size_t)prow(b, dir, 32 * c + 16 * half + ii); qraw[ii] = S[row * NP + C_GLA_Q + cch]; kraw[ii] = S[row * NP + C_GLA_K + cch]; }
    float wd[16];
#pragma unroll
    for (int r = 0; r < 16; ++r) wd[r] = p.gla_wd[((size_t)(l * 2 + dir) * 16 + r) * 256 + cch];
    const float bdv = p.gla_bd[(l * 2 + dir) * 256 + cch];
    float cum[16]; float run = 0.f;
#pragma unroll
    for (int ii = 0; ii < 16; ++ii) {
        const int i = 16 * half + ii; float z = bdv;
#pragma unroll
        for (int r = 0; r < 16; ++r) z += slr[i * 16 + r] * wd[r];
        const float ls = fminf(z, 0.f) - __logf(1.f + __expf(-fabsf(z)));
        run += ls * (1.f / 16.f); cum[ii] = run;
    }
    if (half == 0) stot[cch] = run;
    __syncthreads();
    if (half == 1) { const float t = stot[cch];
#pragma unroll
        for (int ii = 0; ii < 16; ++ii) cum[ii] += t;
        slast[cch] = cum[15]; }
    __syncthreads();
    const float cl = slast[cch];
    const int seq = (dir * 4 + b) * 4 + h;
#pragma unroll
    for (int ii = 0; ii < 16; ++ii) {
        const int i = 16 * half + ii, pp = 32 * c + i;
        const float q = bf2f(qraw[ii]) * 0.125f, k = bf2f(kraw[ii]);
        const float qt = q * __expf(cum[ii]), kt = k * __expf(-cum[ii]), ko = k * __expf(cl - cum[ii]);
        QT[((size_t)seq * PT + pp) * 64 + d] = f2bf(qt); KO[((size_t)seq * PT + pp) * 64 + d] = f2bf(ko);
        sq[(h * 32 + i) * 72 + d] = f2bf(qt); sk[(h * 32 + i) * 72 + d] = f2bf(kt);
    }
    if (half == 0) DC[((size_t)seq * 72 + c) * 64 + d] = __expf(cl);
    __syncthreads();
    {
        const int w = tid >> 6, lane = tid & 63, l15 = lane & 15, g = lane >> 4, hh = w >> 1, mt = w & 1;
        const int seqh = (dir * 4 + b) * 4 + hh;
#pragma unroll
        for (int nt = 0; nt < 2; ++nt) {
            f32x4 acc = (f32x4){0.f, 0.f, 0.f, 0.f};
#pragma unroll
            for (int ks = 0; ks < 2; ++ks) {
                const bf16x8 a = ld8(sq + (hh * 32 + 16 * mt + l15) * 72 + 32 * ks + 8 * g), bb = ld8(sk + (hh * 32 + 16 * nt + l15) * 72 + 32 * ks + 8 * g);
                acc = mfma16(bb, a, acc);
            }
            const int i = 16 * mt + l15, j0 = 16 * nt + 4 * g;
            u32x2 ov; ov.x = pk2(j0 <= i ? acc[0] : 0.f, j0 + 1 <= i ? acc[1] : 0.f); ov.y = pk2(j0 + 2 <= i ? acc[2] : 0.f, j0 + 3 <= i ? acc[3] : 0.f);
            *(u32x2*)(AT + (((size_t)seqh * 72 + c) * 32 + i) * 32 + j0) = ov;
        }
    }
    __syncthreads();
}

struct GlaRegs { u32x4 rv, rq, ra; float rd; };
DI void gla_scan_item(const P& p, int seq, unsigned char* smem) {
    const int dir = seq >> 4, b = (seq >> 2) & 3, h = seq & 3;
    constexpr int BUFB = 20736;
    const bf16_t* S = (const bf16_t*)(p.ws + WS_SBUF);
    const bf16_t* QT = (const bf16_t*)(p.ws + WS_GLA_QT); const bf16_t* KO = (const bf16_t*)(p.ws + WS_GLA_KO); const bf16_t* AT = (const bf16_t*)(p.ws + WS_GLA_AT); const float* DC = (const float*)(p.ws + WS_GLA_DC);
    bf16_t* OG = (bf16_t*)(p.ws + WS_NBUF) + (size_t)dir * NROW * 512;
    const int tid = otid(), w = tid >> 6, lane = tid & 63, l15 = lane & 15, g = lane >> 4, q4 = l15 >> 2, p4 = l15 & 3;
    auto loadr = [&](GlaRegs& R, int c) {
        if (c >= 72) return;
        { const int pos = tid >> 4, ch = tid & 15; R.rv = *(const u32x4*)(S + (size_t)prow(b, dir, 32 * c + pos) * NP + C_GLA_V + 128 * h + 8 * ch); }
        { const int t2 = tid & 255, pos = t2 >> 3, ch = t2 & 7; const bf16_t* src = (tid < 256 ? QT : KO) + ((size_t)seq * PT + 32 * c + pos) * 64 + 8 * ch; R.rq = __builtin_nontemporal_load((const u32x4*)src); }
        if (tid < 128) { const int i = tid >> 2, ch = tid & 3; R.ra = __builtin_nontemporal_load((const u32x4*)(AT + (((size_t)seq * 72 + c) * 32 + i) * 32 + 8 * ch)); }
        if (tid >= 128 && tid < 192) R.rd = DC[((size_t)seq * 72 + c) * 64 + (tid - 128)];
    };
    auto storel = [&](const GlaRegs& R, int buf) {
        unsigned char* base = smem + buf * BUFB;
        bf16_t* sat = (bf16_t*)base; bf16_t* sqt = (bf16_t*)(base + 2560); bf16_t* sko = (bf16_t*)(base + 2560 + 4608); bf16_t* sv = (bf16_t*)(base + 2560 + 9216); float* sdc = (float*)(base + 2560 + 9216 + 8704);
        { const int pos = tid >> 4, ch = tid & 15; *(u32x4*)(sv + pos * 136 + 8 * ch) = R.rv; }
        { const int t2 = tid & 255, pos = t2 >> 3, ch = t2 & 7; *(u32x4*)((tid < 256 ? sqt : sko) + pos * 72 + 8 * ch) = R.rq; }
        if (tid < 128) { const int i = tid >> 2, ch = tid & 3; *(u32x4*)(sat + i * 40 + 8 * ch) = R.ra; }
        if (tid >= 128 && tid < 192) sdc[tid - 128] = R.rd;
    };
    f32x4 st[4];
#pragma unroll
    for (int i = 0; i < 4; ++i) st[i] = (f32x4){0.f, 0.f, 0.f, 0.f};
    const int sgn = dir ? -1 : 1;
    auto compute = [&](int c) {
        const unsigned char* base = smem + (c & 1) * BUFB;
        const bf16_t* sat = (const bf16_t*)base; const bf16_t* sqt = (const bf16_t*)(base + 2560); const bf16_t* sko = (const bf16_t*)(base + 2560 + 4608); const bf16_t* sv = (const bf16_t*)(base + 2560 + 9216); const float* sdc = (const float*)(base + 2560 + 9216 + 8704);
        const int dv0 = 16 * w;
        const bf16x8 vb = tr2(sv + (8 * g + q4) * 136 + dv0 + 4 * p4, sv + (8 * g + 4 + q4) * 136 + dv0 + 4 * p4);
        bf16x8 bs[2];
        bs[0] = packacc(st[0], st[1]); bs[1] = packacc(st[2], st[3]);
#pragma unroll
        for (int mt = 0; mt < 2; ++mt) {
            f32x4 acc = (f32x4){0.f, 0.f, 0.f, 0.f};
            acc = mfma16(vb, ld8(sat + (16 * mt + l15) * 40 + 8 * g), acc);
#pragma unroll
            for (int ks = 0; ks < 2; ++ks) {
                const bf16_t* r0 = sqt + (16 * mt + l15) * 72 + 32 * ks + 4 * g;
                acc = mfma16(bs[ks], ld4x2(r0, r0 + 16), acc);
            }
            bf16_t* ob = OG + (size_t)prow(b, dir, 32 * c) * 512 + 128 * h;
            u32x2 ov; ov.x = pk2(acc[0], acc[1]); ov.y = pk2(acc[2], acc[3]);
            *(u32x2*)(ob + sgn * ((16 * mt + l15) * 512) + dv0 + 4 * g) = ov;
        }
#pragma unroll
        for (int dt = 0; dt < 4; ++dt) {
            const bf16x8 ak = tr2(sko + (8 * g + q4) * 72 + 16 * dt + 4 * p4, sko + (8 * g + 4 + q4) * 72 + 16 * dt + 4 * p4);
#pragma unroll
            for (int r = 0; r < 4; ++r) st[dt][r] *= sdc[16 * dt + 4 * g + r];
            st[dt] = mfma16(ak, vb, st[dt]);
        }
    };
    GlaRegs R0, R1, R2, R3, R4, R5;
    loadr(R0, 0); loadr(R1, 1); loadr(R2, 2); loadr(R3, 3); loadr(R4, 4); loadr(R5, 5);
#pragma unroll 1
    for (int c = 0; c < 72; c += 6) {
        storel(R0, 0); __syncthreads(); loadr(R0, c + 6); compute(c);
        storel(R1, 1); __syncthreads(); loadr(R1, c + 7); compute(c + 1);
        storel(R2, 0); __syncthreads(); loadr(R2, c + 8); compute(c + 2);
        storel(R3, 1); __syncthreads(); loadr(R3, c + 9); compute(c + 3);
        storel(R4, 0); __syncthreads(); loadr(R4, c + 10); compute(c + 4);
        storel(R5, 1); __syncthreads(); loadr(R5, c + 11); compute(c + 5);
    }
    __syncthreads();
}

DI void gdn_conv16(const bf16_t* raw, const float* cw, int ti, int cch, float* out) {
#pragma unroll
    for (int e = 0; e < 16; ++e) out[e] = 0.f;
#pragma unroll 1
    for (int j = 0; j < 5; ++j) {
        const bf16_t* rp = raw + (ti + j) * 392 + cch;
        float xv[16];
        unpack8(*(const u32x4*)rp, xv); unpack8(*(const u32x4*)(rp + 8), xv + 8);
        const float* w = cw + j * 384 + cch;
#pragma unroll
        for (int e4 = 0; e4 < 4; ++e4) { const f32x4 wv = *(const f32x4*)(w + 4 * e4);
#pragma unroll
            for (int e = 0; e < 4; ++e) out[4 * e4 + e] += wv[e] * xv[4 * e4 + e]; }
    }
#pragma unroll
    for (int e = 0; e < 16; ++e) out[e] = siluf(out[e]);
}

DI f32x4 mfma4(float a, float b, f32x4 c) { return __builtin_amdgcn_mfma_f32_16x16x4f32(a, b, c, 0, 0, 0); }

DI void gdn_prep_item(const P& p, int l, int item, unsigned char* smem) {
    const int sc = item % 36, bh = item / 36, h = bh & 3, b = bh >> 2;
    constexpr int LS = 68;
    bf16_t* sK = (bf16_t*)smem;
    bf16_t* sKB = sK + 64 * 136;
    bf16_t* sQ = sKB + 64 * 136;
    bf16_t* sVb = sQ + 64 * 136;
    bf16_t* sKEb = sVb + 64 * 136;
    float* sL = (float*)(sKEb + 64 * 136);
    bf16_t* sLb = (bf16_t*)(sL + 64 * LS);
    bf16_t* sTd = sLb + 64 * 72;
    float* sg = (float*)(sTd + 4 * 16 * 24); float* sbeta = sg + 64; float* scum = sbeta + 64;
    const bf16_t* S = (const bf16_t*)(p.ws + WS_SBUF);
    bf16_t* U = (bf16_t*)(p.ws + WS_GDN_U); bf16_t* W = (bf16_t*)(p.ws + WS_GDN_W); bf16_t* QI = (bf16_t*)(p.ws + WS_GDN_QI); bf16_t* KO = (bf16_t*)(p.ws + WS_GDN_KO);
    bf16_t* AT = (bf16_t*)(p.ws + WS_GDN_AT); float* DC = (float*)(p.ws + WS_GDN_DC);
    const int tid = otid(), ti = tid >> 3, sub = tid & 7;
    const int w = __builtin_amdgcn_readfirstlane(tid >> 6), lane = tid & 63, l15 = lane & 15, g = lane >> 4, q4 = l15 >> 2, p4 = l15 & 3;
    int len, base, tlo, nseg, cseg, coff;
    if (sc < 4) { len = CL; base = NLAT + b * CL; cseg = sc; nseg = 4; coff = 0; } else { len = SL; base = b * SL; cseg = sc - 4; nseg = 32; coff = 4; }
    tlo = 64 * cseg;
    const size_t row = (size_t)(base + tlo + ti);
    const float* Gp = (const float*)(p.ws + WS_G) + row * NNAR;
    const float a_raw0 = Gp[G_A + h], a_raw1 = Gp[G_A + 4 + h], b_raw0 = Gp[G_B + h], b_raw1 = Gp[G_B + 4 + h];
    float* sCW = scum + 64;
    bf16_t* raw = (bf16_t*)smem;
    if (tid < 480) { const int j = tid / 96, r = tid % 96, part = r >> 5, e4 = r & 31;
        *(f32x4*)(sCW + j * 384 + part * 128 + 4 * e4) = *(const f32x4*)(p.gdn_conv + ((size_t)l * 5 + j) * 1536 + part * 512 + 128 * h + 4 * e4); }
#pragma unroll
    for (int k = 0; k < 7; ++k) {
        const int e = tid + 512 * k;
        if (e < 68 * 48) {
            const int r = e / 48, pc = e % 48, part = pc >> 4, wi = pc & 15;
            const int tt = tlo - 2 + r;
            u32x4 v = (u32x4){0u, 0u, 0u, 0u};
            if (tt >= 0 && tt < len) v = __builtin_nontemporal_load((const u32x4*)(S + (size_t)(base + tt) * NP + C_GDN_Q + part * 512 + 128 * h + 8 * wi));
            *(u32x4*)(raw + r * 392 + part * 128 + 8 * wi) = v;
        }
    }
    __syncthreads();
    float xq[16], xk[16], xv[16];
    gdn_conv16(raw, sCW, ti, 0 + 16 * sub, xq);
    gdn_conv16(raw, sCW, ti, 128 + 16 * sub, xk);
    gdn_conv16(raw, sCW, ti, 256 + 16 * sub, xv);
    float sq_ = 0.f, sk_ = 0.f;
#pragma unroll
    for (int e = 0; e < 16; ++e) { sq_ += xq[e] * xq[e]; sk_ += xk[e] * xk[e]; }
    sq_ += __shfl_xor(sq_, 1); sq_ += __shfl_xor(sq_, 2); sq_ += __shfl_xor(sq_, 4);
    sk_ += __shfl_xor(sk_, 1); sk_ += __shfl_xor(sk_, 2); sk_ += __shfl_xor(sk_, 4);
    const float rq = rsqrtf(sq_ + 1e-6f) * 0.08838834764831845f, rk = rsqrtf(sk_ + 1e-6f);
#pragma unroll
    for (int e = 0; e < 16; ++e) { xq[e] *= rq; xk[e] *= rk; }
#pragma unroll 1
  for (int dir = 0; dir < 2; ++dir) {
    const int seq = (dir * 4 + b) * 4 + h;
    const int c = coff + (dir ? nseg - 1 - cseg : cseg);
    const int i = dir ? 63 - ti : ti;
    const int pp = 64 * c + i;
    if (sub == 0) {
        const float a_in = dir ? a_raw1 : a_raw0, b_in = dir ? b_raw1 : b_raw0;
        const float A = __expf(p.gdn_alog[(l * 2 + dir) * 4 + h]);
        const float xx = a_in + p.gdn_dtb[(l * 2 + dir) * 4 + h];
        const float sp = fmaxf(xx, 0.f) + log1pf(__expf(-fabsf(xx)));
        sg[i] = -A * sp; sbeta[i] = __builtin_amdgcn_rcpf(1.f + __expf(-b_in));
    }
    __syncthreads();
    if (tid < 64) {
        float v = sg[tid];
#pragma unroll
        for (int o = 1; o < 64; o <<= 1) { const float u = __shfl_up(v, o); if (tid >= o) v += u; }
        scum[tid] = v;
    }
    __syncthreads();
    const float cumi = scum[i], cl = scum[63], bet = sbeta[i], ei = __expf(cumi), eo = __expf(cl - cumi);
    {
        float t1[16], t2[16];
        *(u32x4*)(sK + i * 136 + 16 * sub) = pack8(xk); *(u32x4*)(sK + i * 136 + 16 * sub + 8) = pack8(xk + 8);
        *(u32x4*)(sQ + i * 136 + 16 * sub) = pack8(xq); *(u32x4*)(sQ + i * 136 + 16 * sub + 8) = pack8(xq + 8);
#pragma unroll
        for (int e = 0; e < 16; ++e) { t1[e] = xk[e] * bet; t2[e] = xv[e] * bet; }
        *(u32x4*)(sKB + i * 136 + 16 * sub) = pack8(t1); *(u32x4*)(sKB + i * 136 + 16 * sub + 8) = pack8(t1 + 8);
        *(u32x4*)(sVb + i * 136 + 16 * sub) = pack8(t2); *(u32x4*)(sVb + i * 136 + 16 * sub + 8) = pack8(t2 + 8);
#pragma unroll
        for (int e = 0; e < 16; ++e) t2[e] = t1[e] * ei;
        *(u32x4*)(sKEb + i * 136 + 16 * sub) = pack8(t2); *(u32x4*)(sKEb + i * 136 + 16 * sub + 8) = pack8(t2 + 8);
#pragma unroll
        for (int e = 0; e < 16; ++e) { t1[e] = xq[e] * ei; t2[e] = xk[e] * eo; }
        bf16_t* qd = QI + ((size_t)seq * PT + pp) * 128 + 16 * sub; bf16_t* kd = KO + ((size_t)seq * PT + pp) * 128 + 16 * sub;
        __builtin_nontemporal_store(pack8(t1), (u32x4*)qd); __builtin_nontemporal_store(pack8(t1 + 8), (u32x4*)(qd + 8));
        __builtin_nontemporal_store(pack8(t2), (u32x4*)kd); __builtin_nontemporal_store(pack8(t2 + 8), (u32x4*)(kd + 8));
        if (tid == 0) DC[seq * 36 + c] = __expf(cl);
    }
    __syncthreads();
    {
        const int mt = w >> 1;
#pragma unroll
        for (int n2 = 0; n2 < 2; ++n2) {
            const int nt = 2 * (w & 1) + n2;
            f32x4 aL = (f32x4){0.f, 0.f, 0.f, 0.f}, aA = (f32x4){0.f, 0.f, 0.f, 0.f};
#pragma unroll
            for (int ks = 0; ks < 4; ++ks) {
                const bf16x8 bk = ld8(sK + (16 * nt + l15) * 136 + 32 * ks + 8 * g);
                aL = mfma16(bk, ld8(sKB + (16 * mt + l15) * 136 + 32 * ks + 8 * g), aL);
                aA = mfma16(bk, ld8(sQ + (16 * mt + l15) * 136 + 32 * ks + 8 * g), aA);
            }
            const int ii = 16 * mt + l15, j0 = 16 * nt + 4 * g;
            const f32x4 cj = *(const f32x4*)(scum + j0); const float ci = scum[ii];
            f32x4 lv; float av[4];
#pragma unroll
            for (int r = 0; r < 4; ++r) {
                const float dcy = __expf(fminf(ci - cj[r], 0.f));
                lv[r] = (j0 + r < ii) ? aL[r] * dcy : 0.f;
                av[r] = (j0 + r <= ii) ? aA[r] * dcy : 0.f;
            }
            *(f32x4*)(sL + ii * LS + j0) = lv;
            { u32x2 lb; lb.x = pk2(lv[0], lv[1]); lb.y = pk2(lv[2], lv[3]); *(u32x2*)(sLb + ii * 72 + j0) = lb; }
            { u32x2 ab; ab.x = pk2(av[0], av[1]); ab.y = pk2(av[2], av[3]); *(u32x2*)(AT + (((size_t)seq * 36 + c) * 64 + ii) * 64 + j0) = ab; }
        }
    }
    __syncthreads();
    if (tid < 64) {
        const int I = tid >> 4, cc = tid & 15;
        float tt[16];
#pragma unroll
        for (int r = 0; r < 16; ++r) tt[r] = (r == cc) ? 1.f : 0.f;
#pragma unroll
        for (int j = 0; j < 15; ++j) {
            const float tj = tt[j];
#pragma unroll
            for (int r = j + 1; r < 16; ++r) tt[r] -= sL[(16 * I + r) * LS + 16 * I + j] * tj;
        }
#pragma unroll
        for (int r = 0; r < 16; ++r) sTd[(I * 16 + r) * 24 + cc] = f2bf(tt[r]);
    }
    __syncthreads();
    {
        const bf16_t* Rb = w < 4 ? sVb : sKEb;
        bf16_t* dstb = (w < 4 ? U : W) + ((size_t)seq * PT + 64 * c) * 128;
#pragma unroll
        for (int n2 = 0; n2 < 2; ++n2) {
            const int col0 = 32 * (w & 3) + 16 * n2;
            s16x4 Xb[4];
#pragma unroll
            for (int I = 0; I < 4; ++I) {
                f32x4 accL = (f32x4){0.f, 0.f, 0.f, 0.f};
#pragma unroll
                for (int J = 0; J < I; ++J)
                    accL = __builtin_amdgcn_mfma_f32_16x16x16bf16_1k(*(const s16x4*)(sLb + (16 * I + l15) * 72 + 16 * J + 4 * g), Xb[J], accL, 0, 0, 0);
                f32x4 rhs;
#pragma unroll
                for (int r = 0; r < 4; ++r) rhs[r] = bf2f(Rb[(16 * I + 4 * g + r) * 136 + col0 + l15]) - accL[r];
                u32x2 pb; pb.x = pk2(rhs[0], rhs[1]); pb.y = pk2(rhs[2], rhs[3]);
                const f32x4 X = __builtin_amdgcn_mfma_f32_16x16x16bf16_1k(*(const s16x4*)(sTd + (I * 16 + l15) * 24 + 4 * g), __builtin_bit_cast(s16x4, pb), (f32x4){0.f, 0.f, 0.f, 0.f}, 0, 0, 0);
                u32x2 px; px.x = pk2(X[0], X[1]); px.y = pk2(X[2], X[3]);
                Xb[I] = __builtin_bit_cast(s16x4, px);
#pragma unroll
                for (int r = 0; r < 4; ++r) dstb[(size_t)(16 * I + 4 * g + r) * 128 + col0 + l15] = f2bf(X[r]);
            }
        }
    }
    __syncthreads();
  }
}

struct GdnRegs { u32x4 r[8]; };
DI void gdn_scan_item(const P& p, int item, unsigned char* smem) {
    const int seq = (item & 7) * 4 + (item >> 5), cq = (item >> 3) & 3;
    const int dir = seq >> 4, b = (seq >> 2) & 3, h = seq & 3;
    constexpr int BUFB = 3 * 17408 + 9216 + 5120;
    bf16_t* sVN = (bf16_t*)(smem + 2 * BUFB);
    float* sdec = (float*)(smem + 2 * BUFB + 5120);
    const bf16_t* U = (const bf16_t*)(p.ws + WS_GDN_U); const bf16_t* W = (const bf16_t*)(p.ws + WS_GDN_W); const bf16_t* QI = (const bf16_t*)(p.ws + WS_GDN_QI); const bf16_t* KO = (const bf16_t*)(p.ws + WS_GDN_KO);
    const bf16_t* AT = (const bf16_t*)(p.ws + WS_GDN_AT); const float* DC = (const float*)(p.ws + WS_GDN_DC);
    bf16_t* OG = (bf16_t*)(p.ws + WS_NBUF) + (size_t)(2 + dir) * NROW * 512;
    const int tid = otid(), w = tid >> 6, lane = tid & 63, l15 = lane & 15, g = lane >> 4, q4 = l15 >> 2, p4 = l15 & 3;
    const int mt = w >> 1, nt = w & 1;
    auto loadr = [&](GdnRegs& R, int c) {
        if (c >= 36) return;
        u32x4* rr = R.r;
#pragma unroll
        for (int k = 0; k < 2; ++k) {
            const int e = tid + 512 * k, r = e >> 4, ch = e & 15; const size_t off = ((size_t)seq * PT + 64 * c + r) * 128 + 8 * ch;
            rr[k] = *(const u32x4*)(W + off); rr[2 + k] = *(const u32x4*)(QI + off); rr[4 + k] = *(const u32x4*)(KO + off);
        }
        { const int r = tid >> 3, ch = tid & 7; rr[6] = *(const u32x4*)(AT + (((size_t)seq * 36 + c) * 64 + r) * 64 + 8 * ch); }
        if (tid < 256) { const int r = tid >> 2, ch = tid & 3; rr[7] = __builtin_nontemporal_load((const u32x4*)(U + ((size_t)seq * PT + 64 * c + r) * 128 + 32 * cq + 8 * ch)); }
    };
    auto storel = [&](const GdnRegs& R, int buf) {
        const u32x4* rr = R.r;
        bf16_t* sW = (bf16_t*)(smem + buf * BUFB); bf16_t* sQI = sW + 64 * 136; bf16_t* sKO = sQI + 64 * 136; bf16_t* sAT = sKO + 64 * 136; bf16_t* sU = sAT + 64 * 72;
#pragma unroll
        for (int k = 0; k < 2; ++k) {
            const int e = tid + 512 * k, r = e >> 4, ch = e & 15; const int off = r * 136 + 8 * ch;
            *(u32x4*)(sW + off) = rr[k]; *(u32x4*)(sQI + off) = rr[2 + k]; *(u32x4*)(sKO + off) = rr[4 + k];
        }
        { const int r = tid >> 3, ch = tid & 7; *(u32x4*)(sAT + r * 72 + 8 * ch) = rr[6]; }
        if (tid < 256) { const int r = tid >> 2, ch = tid & 3; *(u32x4*)(sU + r * 40 + 8 * ch) = rr[7]; }
    };
    u32x4* sBS = (u32x4*)(smem + 2 * BUFB + 5120 + 256);
    f32x4 st[2];
    st[0] = (f32x4){0.f, 0.f, 0.f, 0.f}; st[1] = (f32x4){0.f, 0.f, 0.f, 0.f};
    sBS[(nt * 4 + mt) * 64 + lane] = (u32x4){0u, 0u, 0u, 0u};
    if (tid < 36) sdec[tid] = DC[seq * 36 + tid];
    const int sgn = dir ? -1 : 1;
    auto step = [&](GdnRegs& R, int c) {
        storel(R, c & 1);
        __syncthreads();
        loadr(R, c + 3);
        const bf16_t* sW = (const bf16_t*)(smem + (c & 1) * BUFB); const bf16_t* sQI = sW + 64 * 136; const bf16_t* sKO = sQI + 64 * 136; const bf16_t* sAT = sKO + 64 * 136; const bf16_t* sU = sAT + 64 * 72;
        const float dec = sdec[c];
        bf16x8 Bs[4];
#pragma unroll
        for (int ks = 0; ks < 4; ++ks) Bs[ks] = __builtin_bit_cast(bf16x8, sBS[(nt * 4 + ks) * 64 + lane]);
        {
            f32x4 acc = (f32x4){0.f, 0.f, 0.f, 0.f};
#pragma unroll
            for (int ks = 0; ks < 4; ++ks) { const bf16_t* r0 = sW + (16 * mt + l15) * 136 + 32 * ks + 4 * g; acc = mfma16(Bs[ks], ld4x2(r0, r0 + 16), acc); }
            {
                const u32x2 uu = *(const u32x2*)(sU + (16 * mt + l15) * 40 + 16 * nt + 4 * g);
                u32x2 vv; vv.x = pk2(lo16(uu.x) - acc[0], hi16(uu.x) - acc[1]); vv.y = pk2(lo16(uu.y) - acc[2], hi16(uu.y) - acc[3]);
                *(u32x2*)(sVN + (16 * mt + l15) * 40 + 16 * nt + 4 * g) = vv;
            }
        }
        __syncthreads();
        bf16x8 Bv[2];
#pragma unroll
        for (int k2 = 0; k2 < 2; ++k2) Bv[k2] = tr2(sVN + (32 * k2 + 8 * g + q4) * 40 + 16 * nt + 4 * p4, sVN + (32 * k2 + 8 * g + 4 + q4) * 40 + 16 * nt + 4 * p4);
        {
            f32x4 acc = (f32x4){0.f, 0.f, 0.f, 0.f};
#pragma unroll
            for (int ks = 0; ks < 4; ++ks) { const bf16_t* r0 = sQI + (16 * mt + l15) * 136 + 32 * ks + 4 * g; acc = mfma16(Bs[ks], ld4x2(r0, r0 + 16), acc); }
#pragma unroll
            for (int k2 = 0; k2 < 2; ++k2) acc = mfma16(Bv[k2], ld8(sAT + (16 * mt + l15) * 72 + 32 * k2 + 8 * g), acc);
            bf16_t* ob = OG + (size_t)prow(b, dir, 64 * c) * 512 + 128 * h + 32 * cq;
            u32x2 ov; ov.x = pk2(acc[0], acc[1]); ov.y = pk2(acc[2], acc[3]);
            *(u32x2*)(ob + sgn * ((16 * mt + l15) * 512) + 16 * nt + 4 * g) = ov;
        }
#pragma unroll
        for (int j = 0; j < 2; ++j) {
            const int dt = 2 * mt + j;
            st[j] *= dec;
#pragma unroll
            for (int k2 = 0; k2 < 2; ++k2) {
                const bf16x8 ak = tr2(sKO + (32 * k2 + 8 * g + q4) * 136 + 16 * dt + 4 * p4, sKO + (32 * k2 + 8 * g + 4 + q4) * 136 + 16 * dt + 4 * p4);
                st[j] = mfma16(ak, Bv[k2], st[j]);
            }
        }
        sBS[(nt * 4 + mt) * 64 + lane] = __builtin_bit_cast(u32x4, packacc(st[0], st[1]));
    };
    GdnRegs R0, R1, R2;
    loadr(R0, 0); loadr(R1, 1); loadr(R2, 2);
#pragma unroll 1
    for (int c = 0; c < 36; c += 3) { step(R0, c); step(R1, c + 1); step(R2, c + 2); }
    __syncthreads();
}

DI void rope8(float* x1, float* x2, int g8, float posv) {
#pragma unroll
    for (int e = 0; e < 8; ++e) {
        const float inv = exp2f(-(float)(g8 + e) * 0.41524101186092f);
        float s, c; __sincosf(posv * inv, &s, &c);
        const float a = x1[e], bb = x2[e];
        x1[e] = a * c - bb * s; x2[e] = bb * c + a * s;
    }
}

DI void krope_item(const P& p, int r32) {
    const bf16_t* S = (const bf16_t*)(p.ws + WS_SBUF);
    bf16_t* KR = (bf16_t*)(p.ws + WS_KR);
    const int tid = otid(); const int row = r32 * 32 + (tid >> 4), u = tid & 15, hk = u >> 3, hf = (u >> 2) & 1, e8 = (u & 3) * 8;
    const bf16_t* src = S + (size_t)row * NP + C_SWA_K + 128 * hk + 64 * hf + e8;
    float x1[8], x2[8]; unpack8(__builtin_nontemporal_load((const u32x4*)src), x1); unpack8(__builtin_nontemporal_load((const u32x4*)(src + 32)), x2);
    const int kp = row & 2047;
    rope8(x1, x2, e8, (float)(hf == 0 ? (kp >> 6) : (kp & 63)));
    bf16_t* dst = KR + (size_t)row * 256 + 128 * hk + 64 * hf + e8;
    *(u32x4*)dst = pack8(x1); *(u32x4*)(dst + 32) = pack8(x2);
}

struct SwaRegs { u32x4 pr1, pr2, pv1, pv2; };
DI void swa_item(const P& p, int l, int item, unsigned char* smem) {
    bf16_t* sK0 = (bf16_t*)smem;
    __syncthreads();
    const bf16_t* S = (const bf16_t*)(p.ws + WS_SBUF);
    const bf16_t* KR = (const bf16_t*)(p.ws + WS_KR);
    bf16_t* Y = (bf16_t*)(p.ws + WS_YBUF);
    bool lat; int b, hk, qb;
    if (item < 256) { lat = true; b = item >> 6; hk = (item >> 5) & 1; qb = item & 31; } else { const int it = item - 256; lat = false; b = it >> 3; hk = (it >> 2) & 1; qb = it & 3; }
    const int tid = otid(), w = tid >> 6, lane = tid & 63, l15 = lane & 15, g = lane >> 4, q4 = l15 >> 2, p4 = l15 & 3;
    const int hq = 2 * hk + (w >> 2);
    const int qpos = 64 * qb + 16 * (w & 3) + l15;
    const size_t qrow = lat ? (size_t)(b * SL + qpos) : (size_t)(NLAT + b * CL + qpos);
    bf16x8 Qf[4];
    {
        float xs[4][8];
#pragma unroll
        for (int ks = 0; ks < 4; ++ks) unpack8(*(const u32x4*)(S + qrow * NP + C_SWA_Q + 128 * hq + 32 * ks + 8 * g), xs[ks]);
        if (lat) { rope8(xs[0], xs[1], 8 * g, (float)(qpos >> 6)); rope8(xs[2], xs[3], 8 * g, (float)(qpos & 63)); }
        const float qs = 0.08838834764831845f * 1.4426950408889634f;
#pragma unroll
        for (int ks = 0; ks < 4; ++ks) {
#pragma unroll
            for (int e = 0; e < 8; ++e) xs[ks][e] *= qs;
            Qf[ks] = __builtin_bit_cast(bf16x8, pack8(xs[ks]));
        }
    }
    float m = p.swa_sink[l * 4 + hq] * 1.4426950408889634f;
    float lsum = (g == 0) ? 1.f : 0.f;
    f32x4 ot[8];
#pragma unroll
    for (int i = 0; i < 8; ++i) ot[i] = (f32x4){0.f, 0.f, 0.f, 0.f};
    int lo = 0, ntl = 0;
    if (lat) { lo = 64 * qb - 128; if (lo < 0) lo = 0; int hi = 64 * qb + 192; if (hi > SL) hi = SL; ntl = (hi - lo) >> 6; }
    const int ntot = ntl + 4;
    const int skey = tid >> 3, ssub = tid & 7, shf = ssub >> 2, se8 = (ssub & 3) * 8;
    auto kvload = [&](SwaRegs& R, int tix) {
        if (tix >= ntot) return;
        const bool loc = tix < ntl;
        const int kpos0 = loc ? lo + 64 * tix : 64 * (tix - ntl);
        const size_t krow0 = loc ? (size_t)(b * SL + kpos0) : (size_t)(NLAT + b * CL + kpos0);
        const bf16_t* src = loc ? KR + (krow0 + skey) * 256 + 128 * hk + 64 * shf + se8 : S + (krow0 + skey) * NP + C_SWA_K + 128 * hk + 64 * shf + se8;
        R.pr1 = *(const u32x4*)src; R.pr2 = *(const u32x4*)(src + 32);
        const bf16_t* vsrc = S + (krow0 + skey) * NP + C_SWA_V + 128 * hk + 16 * ssub;
        R.pv1 = *(const u32x4*)vsrc; R.pv2 = *(const u32x4*)(vsrc + 8);
    };
    auto tile = [&](SwaRegs& R, int tix) {
        const bool loc = tix < ntl;
        const int kpos0 = loc ? lo + 64 * tix : 64 * (tix - ntl);
        bf16_t* sK = sK0 + (tix & 1) * 17920; bf16_t* sV = sK + 64 * 136;
        {
            const u32x4 r1 = R.pr1, r2 = R.pr2;
            *(u32x4*)(sK + skey * 136 + 64 * shf + se8) = r1; *(u32x4*)(sK + skey * 136 + 64 * shf + 32 + se8) = r2;
            *(u32x4*)(sV + skey * 144 + 16 * ssub) = R.pv1; *(u32x4*)(sV + skey * 144 + 16 * ssub + 8) = R.pv2;
        }
        __syncthreads();
        kvload(R, tix + 2);
        f32x4 sc[4];
#pragma unroll
        for (int kt = 0; kt < 4; ++kt) {
            f32x4 acc = (f32x4){0.f, 0.f, 0.f, 0.f};
#pragma unroll
            for (int ks = 0; ks < 4; ++ks) acc = mfma16(ld8(sK + (16 * kt + l15) * 136 + 32 * ks + 8 * g), Qf[ks], acc);
            sc[kt] = acc;
        }
        if (loc && (kpos0 <= 64 * qb - 128 || kpos0 >= 64 * qb + 128)) {
#pragma unroll
            for (int kt = 0; kt < 4; ++kt)
#pragma unroll
                for (int r = 0; r < 4; ++r) { const int dd = kpos0 + 16 * kt + 4 * g + r - qpos; if (dd > 128 || dd < -128) sc[kt][r] = -1e30f; }
        }
        float tmax = -1e30f;
#pragma unroll
        for (int kt = 0; kt < 4; ++kt)
#pragma unroll
            for (int r = 0; r < 4; ++r) tmax = fmaxf(tmax, sc[kt][r]);
        tmax = fmaxf(tmax, __shfl_xor(tmax, 16)); tmax = fmaxf(tmax, __shfl_xor(tmax, 32));
        const float mn = fmaxf(m, tmax), alpha = __builtin_amdgcn_exp2f(m - mn);
        m = mn;
        float psum = 0.f;
#pragma unroll
        for (int kt = 0; kt < 4; ++kt)
#pragma unroll
            for (int r = 0; r < 4; ++r) { const float pv = __builtin_amdgcn_exp2f(sc[kt][r] - mn); sc[kt][r] = pv; psum += pv; }
        lsum = lsum * alpha + psum;
        bf16x8 Bp[2];
        Bp[0] = packacc(sc[0], sc[1]); Bp[1] = packacc(sc[2], sc[3]);
#pragma unroll
        for (int nt = 0; nt < 8; ++nt) {
            ot[nt] *= alpha;
#pragma unroll
            for (int k2 = 0; k2 < 2; ++k2) {
                const bf16x8 av = tr2(sV + (32 * k2 + 4 * g + q4) * 144 + 16 * nt + 4 * p4, sV + (32 * k2 + 16 + 4 * g + q4) * 144 + 16 * nt + 4 * p4);
                ot[nt] = mfma16(av, Bp[k2], ot[nt]);
            }
        }
    };
    SwaRegs RA, RB;
    kvload(RA, 0); kvload(RB, 1);
#pragma unroll 1
    for (int tix = 0; tix < ntot; tix += 2) { tile(RA, tix); if (tix + 1 < ntot) tile(RB, tix + 1); }
    lsum += __shfl_xor(lsum, 16); lsum += __shfl_xor(lsum, 32);
    const float inv = __builtin_amdgcn_rcpf(lsum);
#pragma unroll
    for (int nt = 0; nt < 8; ++nt) {
        const int dvb = 16 * nt + 4 * g;
        const u32x2 gw = *(const u32x2*)(S + qrow * NP + C_SWA_G + 128 * hq + dvb);
        const float g0 = lo16(gw.x), g1 = hi16(gw.x), g2 = lo16(gw.y), g3 = hi16(gw.y);
        u32x2 o; o.x = pk2(ot[nt][0] * inv * siluf(g0), ot[nt][1] * inv * siluf(g1)); o.y = pk2(ot[nt][2] * inv * siluf(g2), ot[nt][3] * inv * siluf(g3));
        *(u32x2*)(Y + qrow * DM + 1536 + 128 * hq + dvb) = o;
    }
}


#define XB_TMO      128
#define XB_XCNT(j)  (256  + 64 * (j))
#define XB_XSUB(j)  (1280 + 64 * (j))
#define XB_XGEN(j)  (2304 + 64 * (j))
#define XB_TOP      3328
#define XB_TOPGEN   3392
#define XCD_BAR_WORDS 3456
#define XB_SPIN_CAP (1u << 18)
DI unsigned xb_ld(unsigned* p)              { return __hip_atomic_load(p, __ATOMIC_RELAXED, __HIP_MEMORY_SCOPE_AGENT); }
DI unsigned xb_add(unsigned* p, unsigned v) { return __hip_atomic_fetch_add(p, v, __ATOMIC_RELAXED, __HIP_MEMORY_SCOPE_AGENT); }
DI unsigned xb_xcc_id() { return (unsigned)__builtin_amdgcn_s_getreg((3 << 11) | 20) & 0xFu; }
#define XB_SPIN(cond, bar) do { unsigned _sp = 0; while (cond) { __builtin_amdgcn_s_sleep(1); \
    if ((++_sp & 255u) == 0u) { if (xb_ld(&(bar)[XB_TMO])) break; if (_sp > XB_SPIN_CAP) { atomicAdd(&(bar)[XB_TMO], 1u); break; } } } } while (0)
struct XcdBarrier { unsigned* bar; unsigned x; volatile LAS unsigned* st; };
DI XcdBarrier xcd_barrier_post(unsigned* bar, volatile LAS unsigned* st) {
    XcdBarrier b; b.bar = bar; b.x = xb_xcc_id(); b.st = st;
    if (threadIdx.x == 0) (void)xb_add(&bar[XB_XCNT(b.x)], 1u);
    return b;
}
DI void xcd_barrier_complete(unsigned* bar, unsigned x, unsigned& nloc, unsigned& nx) {
    const unsigned G = gridDim.x * gridDim.y * gridDim.z;
    unsigned sum, cnt, mine, sp = 0u;
    for (;;) {
        sum = 0u; cnt = 0u; mine = 0u;
#pragma unroll
        for (unsigned j = 0; j < 16; ++j) { const unsigned c = xb_ld(&bar[XB_XCNT(j)]); sum += c; cnt += (c > 0u) ? 1u : 0u; mine = (j == x) ? c : mine; }
        if (sum == G) break;
        __builtin_amdgcn_s_sleep(1);
        if ((++sp & 255u) == 0u) { if (xb_ld(&bar[XB_TMO])) break; if (sp > XB_SPIN_CAP) { atomicAdd(&bar[XB_TMO], 1u); break; } }
    }
    nloc = mine > 0u ? mine : 1u; nx = cnt > 0u ? cnt : 1u;
}
DI void xcd_barrier(const XcdBarrier& b) {
    asm volatile("s_waitcnt vmcnt(0)" ::: "memory");
    __syncthreads();
    if (threadIdx.x == 0) {
        unsigned* bar = b.bar;
        __builtin_amdgcn_s_waitcnt(0);
        unsigned nloc = b.st[0], nx = b.st[1];
        if (nloc == 0u) { xcd_barrier_complete(bar, b.x, nloc, nx); b.st[0] = nloc; b.st[1] = nx; }
        const unsigned old = xb_add(&bar[XB_XSUB(b.x)], 1u);
        const unsigned gen = old / nloc;
        if (old + 1u == (gen + 1u) * nloc) {
            __builtin_amdgcn_fence(__ATOMIC_RELEASE, "agent");
            asm volatile("s_waitcnt vmcnt(0)" ::: "memory");
            const unsigned og = xb_add(&bar[XB_TOP], 1u);
            const unsigned tg = og / nx;
            if (og + 1u == (tg + 1u) * nx) xb_add(&bar[XB_TOPGEN], 1u);
            else XB_SPIN(xb_ld(&bar[XB_TOPGEN]) == tg, bar);
            __builtin_amdgcn_fence(__ATOMIC_ACQUIRE, "agent");
            xb_add(&bar[XB_XGEN(b.x)], 1u);
            asm volatile("s_waitcnt vmcnt(0)" ::: "memory");
        } else {
            XB_SPIN(xb_ld(&bar[XB_XGEN(b.x)]) == gen, bar);
            __builtin_amdgcn_fence(__ATOMIC_ACQUIRE, "agent");
            asm volatile("s_waitcnt vmcnt(0)" ::: "memory");
        }
    }
    __syncthreads();
}

DI void weight_prep_item(const P& q, int l, int it, unsigned char* sm) {
    if (it < 96) adaln_item(q, l * 96 + it, sm);
    else if (it < 96 + 896) { const int r = it - 96, kt = r / 28, nt = r % 28;
        const int n0 = nt * 256, srcoff = n0 < 1024 ? 0 : (n0 < 3072 ? 32 : 48);
        transpose_item(q.w_in + (size_t)l * DM * INW, INW, srcoff, (bf16_t*)(q.ws + WS_WINT) + (size_t)l * NP * DM, kt, nt, sm); }
    else if (it < 96 + 896 + 256) { const int r = it - 96 - 896, kt = r / 8, nt = r % 8;
        transpose_item(q.w_out + (size_t)l * DM * DM, DM, 0, (bf16_t*)(q.ws + WS_WOUTT) + (size_t)l * DM * DM, kt, nt, sm); }
    else { const int kt = it - 96 - 896 - 256;
        narrow_item(q.w_in + (size_t)l * DM * INW, (bf16_t*)(q.ws + WS_WNT) + (size_t)l * NNAR * DM, kt); }
}

#define ITEM_BEGIN { size_t z_ = 0; asm volatile("" : "+s"(z_)); q.ws = p.ws + z_; sm = smem + osgpr(0); }
#define PHASE_BEGIN P q = p; { size_t z_ = 0; asm volatile("" : "+s"(z_)); q.ws = p.ws + z_; } unsigned char* sm = smem + osgpr(0); const int b1 = osgpr(bid); (void)sm; (void)b1;
__global__ __launch_bounds__(512, 2) void mega(P p) {
    extern __shared__ __attribute__((aligned(16))) unsigned char smem[];
    cg::grid_group grid = cg::this_grid();
    const int bid = blockIdx.x, nb = gridDim.x;
    volatile LAS unsigned* xst = (volatile LAS unsigned*)(smem + LDS_BYTES - 16);
    if (threadIdx.x < 4) xst[threadIdx.x] = 0u;
    __syncthreads();
    const XcdBarrier xb = xcd_barrier_post((unsigned*)(p.ws + WS_BAR), xst);
    if (p.ws == nullptr) grid.sync();
    for (int rep = 0; rep < REP_P0; ++rep) {
        PHASE_BEGIN
        for (int it = b1; it < 2560; it += nb) { ITEM_BEGIN weight_prep_item(q, it & 1, it >> 1, sm); }
    }
    xcd_barrier(xb);
    { PHASE_BEGIN norm0_phase(q, sm); }
    xcd_barrier(xb);
#pragma unroll 1
    for (int l0 = 0; l0 < 2; ++l0) {
        const int l = osgpr(l0);
        for (int rep = 0; rep < REP_G1; ++rep) {
            if (rep) xcd_barrier(xb);
            PHASE_BEGIN
            pg8::Gemm g{(const bf16_t*)(q.ws + WS_NBUF), (const bf16_t*)(q.ws + WS_WINT) + (size_t)l * NP * DM, NROW, NP, DM};
            pg8::StaticOrder so; so.init(g.M, g.N, nb, b1);
            pg8::EpiBf16 e{(bf16_t*)(q.ws + WS_SBUF), NP};
            pg8::gemm_phase((LAS unsigned char*)sm, g, so, e);
        }
        xcd_barrier(xb);
        for (int rep = 0; rep < REP_PREP; ++rep) {
            if (rep) xcd_barrier(xb);
            PHASE_BEGIN
            const int nconv = (l == 0 ? NROW : NLAT) / 32;
            for (int it = b1; it < 576 + 576 + nconv + 256; it += nb) {
                ITEM_BEGIN
                if (it < 576) { for (int r2 = 0; r2 < REP_GDNP; ++r2) gdn_prep_item(q, l, it, sm); }
                else if (it < 576 + 576) { for (int r2 = 0; r2 < REP_GLAP; ++r2) gla_prep_item(q, l, it - 576, sm); }
                else if (it < 576 + 576 + nconv) conv_item(q, l, it - 576 - 576);
                else krope_item(q, it - 576 - 576 - nconv);
            }
        }
        xcd_barrier(xb);
        for (int rep = 0; rep < REP_SCAN; ++rep) {
            if (rep) xcd_barrier(xb);
            PHASE_BEGIN
            if (b1 < 32) { for (int r2 = 0; r2 < REP_GLAS; ++r2) gla_scan_item(q, b1, sm); }
            else if (b1 < 160) { for (int r2 = 0; r2 < REP_GDNS; ++r2) gdn_scan_item(q, b1 - 32, sm); }
            else if (nb == 256) {
                const int j = b1 - 160, x = j & 7, slot = j >> 3, nloc = l == 0 ? 36 : 32;
                for (int li = slot; li < nloc; li += 12) { ITEM_BEGIN
                    const int it = li < 32 ? ((x >> 1) * 64 + (x & 1) * 32 + li) : (256 + (x >> 1) * 8 + (x & 1) * 4 + (li - 32));
                    for (int r2 = 0; r2 < REP_SWA; ++r2) swa_item(q, l, it, sm); }
            }
            else { const int nsw = l == 0 ? 288 : 256; for (int it = b1 - 160; it < nsw; it += nb - 160) { ITEM_BEGIN for (int r2 = 0; r2 < REP_SWA; ++r2) swa_item(q, l, it, sm); } }
        }
        xcd_barrier(xb);
        { PHASE_BEGIN const int nf = (l == 0 ? NROW : NLAT) / 16; for (int it = b1; it < nf; it += nb) { ITEM_BEGIN finish_item(q, l, it); } }
        xcd_barrier(xb);
        for (int rep = 0; rep < REP_G2; ++rep) {
            if (rep) xcd_barrier(xb);
            PHASE_BEGIN
            pg8::Gemm g{(const bf16_t*)(q.ws + WS_YBUF), (const bf16_t*)(q.ws + WS_WOUTT) + (size_t)l * DM * DM, NLAT, DM, DM};
            pg8::StaticOrder so; so.init(g.M, g.N, nb, b1);
            pg8::EpiBf16 e{(bf16_t*)(q.ws + WS_SBUF), DM};
            pg8::gemm_phase((LAS unsigned char*)sm, g, so, e);
        }
        xcd_barrier(xb);
        if (l == 0) {
            {
                PHASE_BEGIN
                if (b1 < 32) {
                    pg8::Gemm g{(const bf16_t*)(q.ws + WS_YBUF) + (size_t)NLAT * DM, (const bf16_t*)(q.ws + WS_WOUTT), NROW - NLAT, DM, DM};
                    pg8::StaticOrder so; so.init(g.M, g.N, 32, b1);
                    pg8::EpiBf16 e{(bf16_t*)(q.ws + WS_SBUF) + (size_t)NLAT * DM, DM};
                    pg8::gemm_phase((LAS unsigned char*)sm, g, so, e);
                } else post_phase(q, 0, sm, 0, NLAT / 16, b1 - 32, nb - 32);
            }
            xcd_barrier(xb);
            { PHASE_BEGIN post_phase(q, 0, sm, NLAT / 16, NROW / 16, b1, nb); }
            xcd_barrier(xb);
        } else {
            PHASE_BEGIN post_phase(q, 1, sm, 0, NLAT / 16, b1, nb);
        }
    }
}

extern "C" void kernel_launch(void* const* d_in, const int* in_sizes, int n_in, void* d_out, int out_size, void* d_ws, size_t ws_size, hipStream_t stream) {
    static int grid = 0;
    if (grid == 0) {
        if (n_in != 19 || ws_size < WS_END) { fprintf(stderr, "kernel_launch: unexpected n_in %d / ws_size %zu (need %zu)\n", n_in, ws_size, (size_t)WS_END); grid = -1; return; }
        int dev = 0, cus = 0, per_cu = 0;
        hipGetDevice(&dev);
        hipDeviceGetAttribute(&cus, hipDeviceAttributeMultiprocessorCount, dev);
        hipFuncSetAttribute((const void*)mega, hipFuncAttributeMaxDynamicSharedMemorySize, LDS_BYTES);
        hipOccupancyMaxActiveBlocksPerMultiprocessor(&per_cu, (const void*)mega, 512, LDS_BYTES);
        if (per_cu < 1) per_cu = 1;
        grid = cus * per_cu;
        fprintf(stderr, "kernel_launch: cus %d per_cu %d grid %d ws %zu need %zu\n", cus, per_cu, grid, ws_size, (size_t)WS_END);
    }
    if (grid < 0) return;
    P p{};
    const float** f = (const float**)&p;
    for (int i = 0; i < 19; ++i) f[i] = (const float*)d_in[i];
    p.out = (float*)d_out; p.ws = (unsigned char*)d_ws;
    (void)hipMemsetAsync((unsigned char*)d_ws + WS_BAR, 0, 3456 * 4, stream);
    void* args[] = {&p};
    hipError_t e = hipLaunchCooperativeKernel((const void*)mega, dim3(grid), dim3(512), args, LDS_BYTES, stream);
    if (e != hipSuccess) fprintf(stderr, "cooperative launch failed: %s (grid %d)\n", hipGetErrorString(e), grid);
}
```

```cpp
#include <hip/hip_runtime.h>
#include <hip/hip_cooperative_groups.h>
#include <cstdio>
namespace cg = cooperative_groups;

#define DI __device__ __forceinline__
#define LAS __attribute__((address_space(3)))
typedef unsigned short bf16_t;
typedef short bf16x8 __attribute__((ext_vector_type(8)));
typedef short s16x4 __attribute__((ext_vector_type(4)));
typedef float f32x4 __attribute__((ext_vector_type(4)));
typedef unsigned u32x4 __attribute__((ext_vector_type(4)));
typedef unsigned u32x2 __attribute__((ext_vector_type(2)));

constexpr int DM = 2048, NBATCH = 4, SL = 2048, CL = 256, NROW = 9216, NLAT = 8192, INW = 7216, NP = 7168, PT = 2304, NNAR = 48;
constexpr int C_GLA_Q = 0, C_GLA_K = 256, C_GLA_V = 512, C_GLA_G = 1024, C_GDN_Q = 1536, C_GDN_K = 2048, C_GDN_V = 2560,
              C_GDN_G = 3072, C_SC_B = 3584, C_SC_C = 4096, C_SC_H = 4608, C_SC_G = 5120, C_SWA_Q = 5632,
              C_SWA_K = 6144, C_SWA_V = 6400, C_SWA_G = 6656;
constexpr int G_LR = 0, G_A = 32, G_B = 40;
constexpr int LDS_BYTES = 147456;
#ifndef REP_P0
#define REP_P0 1
#endif
#ifndef REP_G1
#define REP_G1 1
#endif
#ifndef REP_PREP
#define REP_PREP 1
#endif
#ifndef REP_SCAN
#define REP_SCAN 1
#endif
#ifndef REP_GDNP
#define REP_GDNP 1
#endif
#ifndef REP_GLAP
#define REP_GLAP 1
#endif
#ifndef REP_GLAS
#define REP_GLAS 1
#endif
#ifndef REP_GDNS
#define REP_GDNS 1
#endif
#ifndef REP_SWA
#define REP_SWA 1
#endif
#ifndef REP_G2
#define REP_G2 1
#endif

constexpr size_t al256(size_t x) { return (x + 255) & ~(size_t)255; }
constexpr size_t WS_WINT = 0;
constexpr size_t WS_WOUTT = WS_WINT + al256((size_t)2 * NP * DM * 2);
constexpr size_t WS_MOD = WS_WOUTT + al256((size_t)2 * DM * DM * 2);
constexpr size_t WS_NBUF = WS_MOD + al256((size_t)2 * 5 * 6144 * 4);
constexpr size_t WS_SBUF = WS_NBUF + al256((size_t)NROW * DM * 2);
constexpr size_t WS_YBUF = WS_SBUF + al256((size_t)NROW * NP * 2);
constexpr size_t WS_HC = WS_YBUF + al256((size_t)NROW * DM * 2);
constexpr size_t WS_GLA_QT = WS_HC + al256((size_t)1024 * DM * 4);
constexpr size_t WS_GLA_KO = WS_GLA_QT + al256((size_t)32 * PT * 64 * 2);
constexpr size_t WS_GLA_AT = WS_GLA_KO + al256((size_t)32 * PT * 64 * 2);
constexpr size_t WS_GLA_DC = WS_GLA_AT + al256((size_t)32 * 72 * 32 * 32 * 2);
constexpr size_t WS_GDN_U = WS_GLA_DC + al256((size_t)32 * 72 * 64 * 4);
constexpr size_t WS_GDN_W = WS_GDN_U + al256((size_t)32 * PT * 128 * 2);
constexpr size_t WS_GDN_QI = WS_GDN_W + al256((size_t)32 * PT * 128 * 2);
constexpr size_t WS_GDN_KO = WS_GDN_QI + al256((size_t)32 * PT * 128 * 2);
constexpr size_t WS_GDN_AT = WS_GDN_KO + al256((size_t)32 * PT * 128 * 2);
constexpr size_t WS_GDN_DC = WS_GDN_AT + al256((size_t)32 * 36 * 64 * 64 * 2);
constexpr size_t WS_WNT = WS_GDN_DC + al256((size_t)32 * 36 * 4);
constexpr size_t WS_G = WS_WNT + al256((size_t)2 * NNAR * DM * 2);
constexpr size_t WS_KR = WS_G + al256((size_t)NROW * NNAR * 4);
constexpr size_t WS_BAR = WS_KR + al256((size_t)NLAT * 256 * 2);
constexpr size_t WS_END = WS_BAR + al256((size_t)3456 * 4);

struct P {
    const float *x, *c, *ctx, *c_ctx, *ada_w, *ada_b, *norm_pre, *norm_post, *w_in, *w_out, *gla_wd, *gla_bd, *gla_norm, *gdn_conv, *gdn_alog,
        *gdn_dtb, *gdn_norm, *sc_conv, *swa_sink;
    float* out;
    unsigned char* ws;
};

typedef __bf16 bf16v2 __attribute__((ext_vector_type(2)));
DI bf16_t f2bf(float f) { return __builtin_bit_cast(bf16_t, (__bf16)f); }
DI float bf2f(bf16_t b) { return __uint_as_float(((unsigned)b) << 16); }
DI unsigned pk2(float lo, float hi) { bf16v2 v = {(__bf16)lo, (__bf16)hi}; return __builtin_bit_cast(unsigned, v); }
DI float lo16(unsigned u) { return __uint_as_float(u << 16); }
DI float hi16(unsigned u) { return __uint_as_float(u & 0xFFFF0000u); }
DI void unpack8(u32x4 v, float* o) { o[0] = lo16(v.x); o[1] = hi16(v.x); o[2] = lo16(v.y); o[3] = hi16(v.y); o[4] = lo16(v.z); o[5] = hi16(v.z); o[6] = lo16(v.w); o[7] = hi16(v.w); }
DI u32x4 pack8(const float* o) { u32x4 r; r.x = pk2(o[0], o[1]); r.y = pk2(o[2], o[3]); r.z = pk2(o[4], o[5]); r.w = pk2(o[6], o[7]); return r; }
DI float siluf(float x) { return x * __builtin_amdgcn_rcpf(1.f + __expf(-x)); }
DI bf16x8 ld8(const bf16_t* p) { return *(const bf16x8*)p; }
DI bf16x8 ld4x2(const bf16_t* p0, const bf16_t* p1) {
    s16x4 a = *(const s16x4*)p0, b = *(const s16x4*)p1;
    return __builtin_shufflevector(a, b, 0, 1, 2, 3, 4, 5, 6, 7);
}
DI s16x4 trread(const bf16_t* p) { return __builtin_amdgcn_ds_read_tr16_b64_v4i16((LAS s16x4*)p); }
DI bf16x8 tr2(const bf16_t* p0, const bf16_t* p1) { s16x4 a = trread(p0), b = trread(p1); return __builtin_shufflevector(a, b, 0, 1, 2, 3, 4, 5, 6, 7); }
DI bf16x8 packacc(f32x4 a, f32x4 b) {
    u32x4 r; r.x = pk2(a[0], a[1]); r.y = pk2(a[2], a[3]); r.z = pk2(b[0], b[1]); r.w = pk2(b[2], b[3]);
    return __builtin_bit_cast(bf16x8, r);
}
DI f32x4 mfma16(bf16x8 a, bf16x8 b, f32x4 c) { return __builtin_amdgcn_mfma_f32_16x16x32_bf16(a, b, c, 0, 0, 0); }
DI float wave_sum(float v) {
#pragma unroll
    for (int o = 32; o >= 1; o >>= 1) v += __shfl_xor(v, o);
    return v;
}
DI int otid() { int t = threadIdx.x; asm volatile("" : "+v"(t)); return t; }
DI int osgpr(int v) { asm volatile("" : "+s"(v)); return v; }
DI int prow(int b, int dir, int p) {
    if (p < CL) { const int t = dir ? (CL - 1 - p) : p; return NLAT + b * CL + t; }
    const int q = p - CL; const int t = dir ? (SL - 1 - q) : q; return b * SL + t;
}

namespace pg8 {
constexpr int BM = 256, BK = 64, HALF = 128, HTB = HALF * BK * 2, NXCD = 8, WGM = 4;
DI int lds_byte(int r, int c) { const int st = (r >> 4) * 2 + (c >> 5), rr = r & 15, cc = c & 31, ob = rr * 64 + cc * 2; return st * 1024 + (ob ^ (((ob >> 9) & 1) << 5)); }
DI void stage_rc(int b, int& R, int& C) { const int st = b / 1024, sb = b % 1024, swz = sb ^ (((sb >> 9) & 1) << 5); R = (st >> 1) * 16 + swz / 64; C = (st & 1) * 32 + (swz % 64) / 2; }
DI int perm32(int rho) { const int n = rho >> 4, i = rho & 15; return 8 * (i >> 2) + 4 * n + (i & 3); }
struct Unit { int pm, pn; };
struct Gemm { const bf16_t* A; const bf16_t* Bt; int M, N, K; };
struct StaticOrder {
    int nM, nN, nwg, G, c;
    DI void init(int M, int N, int G_, int c_) { nM = M / BM; nN = N / BM; nwg = nM * nN; G = G_; c = c_; }
    DI bool next(int i, Unit& u) const {
        const long L = (long)i * G + c; if (L >= nwg) return false;
        int wgid = (int)L; { const int q = nwg / NXCD, r = nwg % NXCD, xcd = wgid % NXCD, off = wgid / NXCD; wgid = (xcd < r ? xcd * (q + 1) : r * (q + 1) + (xcd - r) * q) + off; }
        const int nig = WGM * nN, gid = wgid / nig, fm = gid * WGM, gsz = (nM - fm) < WGM ? (nM - fm) : WGM;
        u.pm = fm + ((wgid % nig) % gsz); u.pn = (wgid % nig) / gsz; return true;
    }
};
struct EpiBf16 {
    bf16_t* O; int ldc;
    DI void operator()(const f32x4 (&acc)[2][2][4][2], const Unit& u, int wr, int wc, int fr, int fq) const {
        const int row0 = u.pm * BM + wr * 64 + fr; const int col0 = u.pn * BM + wc * 32 + 8 * fq;
#pragma unroll
        for (int ai = 0; ai < 2; ++ai)
#pragma unroll
            for (int m = 0; m < 4; ++m) { bf16_t* rowp = O + (size_t)(row0 + ai * HALF + m * 16) * ldc + col0;
#pragma unroll
                for (int bj = 0; bj < 2; ++bj) { const f32x4 v0 = acc[ai][bj][m][0], v1 = acc[ai][bj][m][1];
                    u32x4 w; w.x = pk2(v0[0], v0[1]); w.y = pk2(v0[2], v0[3]); w.z = pk2(v1[0], v1[1]); w.w = pk2(v1[2], v1[3]);
                    *(u32x4*)(rowp + bj * HALF) = w; } }
    }
};

DI void gemm_phase(LAS unsigned char* lds, const Gemm g, const StaticOrder& S, const EpiBf16& E) {
    const int tid = otid(), wid = __builtin_amdgcn_readfirstlane(tid >> 6), lane = tid & 63, wr = wid >> 2, wc = wid & 3, fr = lane & 15, fq = lane >> 4;
    const int K = g.K, nt = K / BK;
    unsigned voffA[2], voffB[2];
#pragma unroll
    for (int i = 0; i < 2; ++i) { int R, C; stage_rc(tid * 16 + i * 8192, R, C); const int Rb = (R & ~31) + perm32(R & 31);
        voffA[i] = (unsigned)(R * K + C) * 2u; voffB[i] = (unsigned)(Rb * K + C) * 2u; }
    const size_t kstep = (size_t)(BK * 2);
    const size_t hstep = (size_t)HALF * K * 2;
    const size_t tstep = 2 * hstep;
    const unsigned ldsw = (unsigned)wid * 1024u;
    const int aoff = lds_byte(wr * 64 + fr, fq * 8), boff = lds_byte(wc * 32 + fr, fq * 8);
#define PG8_SA(b, h) (((b) * 2 + (h)) * HTB)
#define PG8_SB(b, h) ((4 + (b) * 2 + (h)) * HTB)
#define PG8_STAGE(bufoff, gbase, voff) do { _Pragma("unroll") for (int _i = 0; _i < 2; ++_i) \
        __builtin_amdgcn_global_load_lds((const unsigned*)((const char*)(gbase) + (voff)[_i]), (LAS unsigned*)(lds + (bufoff) + ldsw + _i * 8192), 16, 0, 0); } while (0)
#define PG8_LDA(dst, b, h) do { _Pragma("unroll") for (int m = 0; m < 4; ++m) _Pragma("unroll") for (int k = 0; k < 2; ++k) dst[m][k] = *(const LAS bf16x8*)(lds + PG8_SA(b, h) + aoff + m * 2048 + k * 1024); } while (0)
#define PG8_LDB(dst, b, h) do { _Pragma("unroll") for (int n = 0; n < 2; ++n) _Pragma("unroll") for (int k = 0; k < 2; ++k) dst[n][k] = *(const LAS bf16x8*)(lds + PG8_SB(b, h) + boff + n * 2048 + k * 1024); } while (0)
#define PG8_MMA(ai, bj, At, Bt) do { __builtin_amdgcn_s_setprio(1); _Pragma("unroll") for (int m = 0; m < 4; ++m) _Pragma("unroll") for (int n = 0; n < 2; ++n) _Pragma("unroll") for (int k = 0; k < 2; ++k) \
        acc[ai][bj][m][n] = __builtin_amdgcn_mfma_f32_16x16x32_bf16(Bt[n][k], At[m][k], acc[ai][bj][m][n], 0, 0, 0); __builtin_amdgcn_s_setprio(0); } while (0)
#define PG8_WAIT_V(n) asm volatile("s_waitcnt vmcnt(" #n ")" ::: "memory")
#define PG8_WAIT_L(n) asm volatile("s_waitcnt lgkmcnt(" #n ")" ::: "memory")
#define PG8_BAR __builtin_amdgcn_s_barrier()
#define PG8_SCHED __builtin_amdgcn_sched_barrier(0)
    Unit cur, nxt; int ui = 0;
    if (!S.next(0, cur)) return;
    f32x4 acc[2][2][4][2];
#pragma unroll
    for (int a = 0; a < 2; ++a)
#pragma unroll
        for (int b = 0; b < 2; ++b)
#pragma unroll
            for (int m = 0; m < 4; ++m)
#pragma unroll
                for (int n = 0; n < 2; ++n) acc[a][b][m][n] = (f32x4){0.f, 0.f, 0.f, 0.f};
    bf16x8 At[4][2], B0[2][2], B1[2][2];
    const char* cA = (const char*)g.A + (size_t)cur.pm * tstep; const char* cB = (const char*)g.Bt + (size_t)cur.pn * tstep;
    PG8_STAGE(PG8_SB(0, 0), cB, voffB); PG8_STAGE(PG8_SA(0, 0), cA, voffA); PG8_STAGE(PG8_SB(0, 1), cB + hstep, voffB); PG8_STAGE(PG8_SA(0, 1), cA + hstep, voffA);
    if (wr == 1) PG8_BAR;
    PG8_WAIT_V(4); PG8_BAR;
    PG8_STAGE(PG8_SB(1, 0), cB + kstep, voffB); PG8_STAGE(PG8_SA(1, 0), cA + kstep, voffA); PG8_STAGE(PG8_SB(1, 1), cB + hstep + kstep, voffB);
    PG8_WAIT_V(6); PG8_BAR;
    for (;;) {
        const bool has_next = S.next(ui + 1, nxt);
        const char* nA = has_next ? (const char*)g.A + (size_t)nxt.pm * tstep : cA; const char* nB = has_next ? (const char*)g.Bt + (size_t)nxt.pn * tstep : cB;
        for (int t = 0; t < nt; t += 2) {
            const bool last = (t == nt - 2);
            const char* a1 = cA + (size_t)(t + 1) * kstep;
            const char* a2 = last ? nA : cA + (size_t)(t + 2) * kstep; const char* b2 = last ? nB : cB + (size_t)(t + 2) * kstep;
            const char* a3 = a2 + kstep; const char* b3 = b2 + kstep;
            PG8_LDB(B0, 0, 0); PG8_SCHED; PG8_LDA(At, 0, 0); PG8_STAGE(PG8_SA(1, 1), a1 + hstep, voffA);
            PG8_WAIT_L(8); PG8_BAR; PG8_WAIT_L(0); PG8_MMA(0, 0, At, B0); PG8_BAR; PG8_SCHED;
            PG8_LDB(B1, 0, 1); PG8_STAGE(PG8_SB(0, 0), b2, voffB);
            PG8_BAR; PG8_WAIT_L(0); PG8_MMA(0, 1, At, B1); PG8_BAR;
            PG8_LDA(At, 0, 1); PG8_STAGE(PG8_SA(0, 0), a2, voffA);
            PG8_BAR; PG8_WAIT_L(0); PG8_MMA(1, 0, At, B0); PG8_BAR; PG8_SCHED;
            PG8_STAGE(PG8_SB(0, 1), b2 + hstep, voffB);
            PG8_WAIT_V(6); PG8_BAR; PG8_MMA(1, 1, At, B1); PG8_BAR;
            PG8_LDB(B0, 1, 0); PG8_SCHED; PG8_LDA(At, 1, 0); PG8_STAGE(PG8_SA(0, 1), a2 + hstep, voffA);
            PG8_WAIT_L(8); PG8_BAR; PG8_WAIT_L(0); PG8_MMA(0, 0, At, B0); PG8_BAR; PG8_SCHED;
            PG8_LDB(B1, 1, 1); PG8_STAGE(PG8_SB(1, 0), b3, voffB);
            PG8_BAR; PG8_WAIT_L(0); PG8_MMA(0, 1, At, B1); PG8_BAR;
            PG8_LDA(At, 1, 1); PG8_STAGE(PG8_SA(1, 0), a3, voffA);
            PG8_BAR; PG8_WAIT_L(0); PG8_MMA(1, 0, At, B0); PG8_BAR; PG8_SCHED;
            PG8_STAGE(PG8_SB(1, 1), b3 + hstep, voffB);
            PG8_WAIT_V(6); PG8_BAR; PG8_MMA(1, 1, At, B1); PG8_BAR;
        }
        E(acc, cur, wr, wc, fr, fq);
        if (!has_next) break;
#pragma unroll
        for (int a = 0; a < 2; ++a)
#pragma unroll
            for (int b = 0; b < 2; ++b)
#pragma unroll
                for (int m = 0; m < 4; ++m)
#pragma unroll
                    for (int n = 0; n < 2; ++n) acc[a][b][m][n] = (f32x4){0.f, 0.f, 0.f, 0.f};
        cur = nxt; cA = nA; cB = nB; ++ui;
    }
    PG8_WAIT_V(0);
    if (wr == 0) PG8_BAR;
    PG8_BAR;
#undef PG8_SA
#undef PG8_SB
#undef PG8_STAGE
#undef PG8_LDA
#undef PG8_LDB
#undef PG8_MMA
#undef PG8_WAIT_V
#undef PG8_WAIT_L
#undef PG8_BAR
#undef PG8_SCHED
}
}

DI void adaln_item(const P& p, int a, unsigned char* smem) {
    float* sc = (float*)smem;
    float* red = sc + 5 * 2048;
    float* mod = (float*)(p.ws + WS_MOD);
    const int tid = otid();
    for (int e = tid; e < 5 * 2048; e += 512) { const int r = e >> 11, k = e & 2047; const float v = r < 4 ? p.c[r * 2048 + k] : p.c_ctx[k]; sc[e] = siluf(v); }
    __syncthreads();
    const int l = a / 96, j0 = (a % 96) * 64, cg4 = (tid & 15) * 4, kg = tid >> 4;
    const float* w = p.ada_w + (size_t)l * 2048 * 6144 + j0 + cg4;
    f32x4 acc[5];
#pragma unroll
    for (int r = 0; r < 5; ++r) acc[r] = (f32x4){0.f, 0.f, 0.f, 0.f};
#pragma unroll 1
    for (int i0 = 0; i0 < 64; i0 += 16) {
        f32x4 wv[16];
#pragma unroll
        for (int i = 0; i < 16; ++i) wv[i] = __builtin_nontemporal_load((const f32x4*)(w + (size_t)(kg + 32 * (i0 + i)) * 6144));
#pragma unroll
        for (int i = 0; i < 16; ++i) {
            const int k = kg + 32 * (i0 + i);
#pragma unroll
            for (int r = 0; r < 5; ++r) acc[r] += wv[i] * sc[r * 2048 + k];
        }
    }
#pragma unroll
    for (int r = 0; r < 5; ++r) *(f32x4*)(red + (kg * 5 + r) * 64 + cg4) = acc[r];
    __syncthreads();
    if (tid < 320) {
        const int r = tid >> 6, tx = tid & 63; float sum = 0.f;
#pragma unroll
        for (int k2 = 0; k2 < 32; ++k2) sum += red[(k2 * 5 + r) * 64 + tx];
        mod[(l * 5 + r) * 6144 + j0 + tx] = sum + p.ada_b[l * 6144 + j0 + tx];
    }
    __syncthreads();
}

DI void transpose_item(const float* src, int ld, int srcoff, bf16_t* dst, int kt, int nt, unsigned char* smem) {
    float* tile = (float*)smem;
    const int tid = otid();
#pragma unroll
    for (int i = 0; i < 8; ++i) {
        const int kr = (tid >> 6) + 8 * i, nc = (tid & 63) * 4;
        const f32x4 v = __builtin_nontemporal_load((const f32x4*)(src + (size_t)(kt * 64 + kr) * ld + srcoff + nt * 256 + nc));
        tile[kr * 257 + nc + 0] = v[0]; tile[kr * 257 + nc + 1] = v[1]; tile[kr * 257 + nc + 2] = v[2]; tile[kr * 257 + nc + 3] = v[3];
    }
    __syncthreads();
    {
        const int n = tid >> 1, k0 = (tid & 1) * 32;
#pragma unroll
        for (int k8 = 0; k8 < 4; ++k8) {
            float o[8];
#pragma unroll
            for (int j = 0; j < 8; ++j) o[j] = tile[(k0 + 8 * k8 + j) * 257 + n];
            *(u32x4*)(dst + (size_t)(nt * 256 + n) * 2048 + kt * 64 + k0 + 8 * k8) = pack8(o);
        }
    }
    __syncthreads();
}
DI void narrow_item(const float* src, bf16_t* dst, int kt) {
    const int tid = otid();
#pragma unroll
    for (int j = 0; j < 6; ++j) {
        const int e = tid + 512 * j, kr = e / 48, cn = e % 48;
        const int sc = cn < 32 ? 1024 + cn : 3104 + (cn - 32);
        dst[(size_t)cn * 2048 + kt * 64 + kr] = f2bf(src[(size_t)(kt * 64 + kr) * INW + sc]);
    }
}
DI void skinny_tile(const P& p, int l, int r0, float* red) {
    const bf16_t* A = (const bf16_t*)(p.ws + WS_NBUF);
    const bf16_t* Bt = (const bf16_t*)(p.ws + WS_WNT) + (size_t)l * NNAR * DM;
    float* G = (float*)(p.ws + WS_G);
    const int tid = otid(), w = tid >> 6, lane = tid & 63, l15 = lane & 15, g = lane >> 4;
    f32x4 acc[3];
#pragma unroll
    for (int n = 0; n < 3; ++n) acc[n] = (f32x4){0.f, 0.f, 0.f, 0.f};
    const bf16_t* ap = A + (size_t)(r0 + l15) * DM + 256 * w + 8 * g;
    const bf16_t* bp = Bt + (size_t)l15 * DM + 256 * w + 8 * g;
#pragma unroll
    for (int ks = 0; ks < 8; ++ks) {
        const bf16x8 a0 = *(const bf16x8*)(ap + 32 * ks);
#pragma unroll
        for (int n = 0; n < 3; ++n) acc[n] = mfma16(a0, *(const bf16x8*)(bp + (size_t)16 * n * DM + 32 * ks), acc[n]);
    }
#pragma unroll
    for (int n = 0; n < 3; ++n)
#pragma unroll
        for (int r = 0; r < 4; ++r) red[w * 768 + (4 * g + r) * 48 + 16 * n + l15] = acc[n][r];
    __syncthreads();
    for (int e = tid; e < 768; e += 512) {
        float sum = 0.f;
#pragma unroll
        for (int k = 0; k < 8; ++k) sum += red[k * 768 + e];
        G[(size_t)r0 * NNAR + e] = sum;
    }
    __syncthreads();
}

DI void norm0_phase(const P& p, unsigned char* smem) {
    const int tid = otid(); const int wave = tid >> 6, lane = tid & 63;
    const float* mod = (const float*)(p.ws + WS_MOD);
    bf16_t* nb = (bf16_t*)(p.ws + WS_NBUF);
    for (int rt = osgpr(blockIdx.x); rt < NROW / 16; rt += gridDim.x) {
      for (int rr = 0; rr < 2; ++rr) {
        const int row = rt * 16 + wave * 2 + rr;
        const float* h = row < NLAT ? p.x + (size_t)row * DM : p.ctx + (size_t)(row - NLAT) * DM;
        const int mr = row < NLAT ? (row >> 11) : 4;
        f32x4 v[8]; float ss = 0.f;
#pragma unroll
        for (int i = 0; i < 8; ++i) { v[i] = __builtin_nontemporal_load((const f32x4*)(h + i * 256 + lane * 4)); ss += v[i][0] * v[i][0] + v[i][1] * v[i][1] + v[i][2] * v[i][2] + v[i][3] * v[i][3]; }
        ss = wave_sum(ss);
        const float rstd = rsqrtf(ss * (1.f / 2048.f) + 1e-6f);
        const float* md = mod + (size_t)mr * 6144;
#pragma unroll
        for (int i = 0; i < 8; ++i) {
            const int j = i * 256 + lane * 4;
            const f32x4 gw = *(const f32x4*)(p.norm_pre + j), sh = *(const f32x4*)(md + j), scl = *(const f32x4*)(md + 2048 + j);
            float o[4];
#pragma unroll
            for (int e = 0; e < 4; ++e) o[e] = v[i][e] * rstd * gw[e] * (1.f + scl[e]) + sh[e];
            u32x2 w; w.x = pk2(o[0], o[1]); w.y = pk2(o[2], o[3]);
            *(u32x2*)(nb + (size_t)row * DM + j) = w;
        }
      }
      asm volatile("s_waitcnt vmcnt(0)" ::: "memory"); __syncthreads();
      skinny_tile(p, 0, rt * 16, (float*)smem);
    }
}

DI void post_phase(const P& p, int l, unsigned char* smem, int t0, int t1, int bstart, int bstride) {
    const int tid = otid(); const int wave = tid >> 6, lane = tid & 63;
    const float* mod = (const float*)(p.ws + WS_MOD);
    bf16_t* nb = (bf16_t*)(p.ws + WS_NBUF);
    const bf16_t* yo = (const bf16_t*)(p.ws + WS_SBUF);
    float* hc = (float*)(p.ws + WS_HC);
    for (int rt = t0 + osgpr(bstart); rt < t1; rt += bstride) {
      for (int rr = 0; rr < 2; ++rr) {
        const int row = rt * 16 + wave * 2 + rr;
        const int mr = row < NLAT ? (row >> 11) : 4;
        const float* h = l == 0 ? (row < NLAT ? p.x + (size_t)row * DM : p.ctx + (size_t)(row - NLAT) * DM) : p.out + (size_t)row * DM;
        float* hdst = row < NLAT ? p.out + (size_t)row * DM : hc + (size_t)(row - NLAT) * DM;
        f32x4 y[8]; float ss = 0.f;
#pragma unroll
        for (int i = 0; i < 8; ++i) {
            const u32x2 w = __builtin_nontemporal_load((const u32x2*)(yo + (size_t)row * DM + i * 256 + lane * 4));
            y[i] = (f32x4){lo16(w.x), hi16(w.x), lo16(w.y), hi16(w.y)};
            ss += y[i][0] * y[i][0] + y[i][1] * y[i][1] + y[i][2] * y[i][2] + y[i][3] * y[i][3];
        }
        ss = wave_sum(ss);
        const float rstd = rsqrtf(ss * (1.f / 2048.f) + 1e-6f);
        const float* md = mod + (size_t)(l * 5 + mr) * 6144;
        float ss2 = 0.f;
#pragma unroll
        for (int i = 0; i < 8; ++i) {
            const int j = i * 256 + lane * 4;
            const f32x4 hv = __builtin_nontemporal_load((const f32x4*)(h + j)), gt = *(const f32x4*)(md + 4096 + j), nw = *(const f32x4*)(p.norm_post + l * DM + j);
#pragma unroll
            for (int e = 0; e < 4; ++e) { y[i][e] = hv[e] + gt[e] * (y[i][e] * rstd * nw[e]); ss2 += y[i][e] * y[i][e]; }
            __builtin_nontemporal_store(y[i], (f32x4*)(hdst + j));
        }
        if (l == 0) {
            ss2 = wave_sum(ss2);
            const float rstd2 = rsqrtf(ss2 * (1.f / 2048.f) + 1e-6f);
            const float* md1 = mod + (size_t)(5 + mr) * 6144;
#pragma unroll
            for (int i = 0; i < 8; ++i) {
                const int j = i * 256 + lane * 4;
                const f32x4 gw = *(const f32x4*)(p.norm_pre + DM + j), sh = *(const f32x4*)(md1 + j), scl = *(const f32x4*)(md1 + 2048 + j);
                float o[4];
#pragma unroll
                for (int e = 0; e < 4; ++e) o[e] = y[i][e] * rstd2 * gw[e] * (1.f + scl[e]) + sh[e];
                u32x2 w; w.x = pk2(o[0], o[1]); w.y = pk2(o[2], o[3]);
                *(u32x2*)(nb + (size_t)row * DM + j) = w;
            }
        }
      }
      if (l == 0) { asm volatile("s_waitcnt vmcnt(0)" ::: "memory"); __syncthreads(); skinny_tile(p, 1, rt * 16, (float*)smem); }
    }
}

DI void conv_item(const P& p, int l, int r32) {
    const bf16_t* S = (const bf16_t*)(p.ws + WS_SBUF);
    bf16_t* Y = (bf16_t*)(p.ws + WS_YBUF);
    const int tid = otid(); const int row0 = r32 * 32 + (tid >> 6) * 4, ch = (tid & 63) * 8;
    int t0, len;
    if (row0 < NLAT) { t0 = row0 & 2047; len = SL; } else { t0 = (row0 - NLAT) & 255; len = CL; }
    u32x4 rc[6], rh[6], rb[4], rg[4];
#pragma unroll
    for (int k = 0; k < 6; ++k) {
        int tt = t0 + k - 1; const int tcl = tt < 0 ? 0 : (tt >= len ? len - 1 : tt);
        const bf16_t* rp = S + (size_t)(row0 + (tcl - t0)) * NP;
        rc[k] = __builtin_nontemporal_load((const u32x4*)(rp + C_SC_C + ch)); rh[k] = __builtin_nontemporal_load((const u32x4*)(rp + C_SC_H + ch));
    }
#pragma unroll
    for (int k = 0; k < 4; ++k) { const bf16_t* rp = S + (size_t)(row0 + k) * NP; rb[k] = __builtin_nontemporal_load((const u32x4*)(rp + C_SC_B + ch)); rg[k] = __builtin_nontemporal_load((const u32x4*)(rp + C_SC_G + ch)); }
    f32x4 w0[3], w1[3];
#pragma unroll
    for (int j = 0; j < 3; ++j) { const float* w = p.sc_conv + (size_t)(l * 3 + j) * 512 + ch; w0[j] = *(const f32x4*)w; w1[j] = *(const f32x4*)(w + 4); }
    float prod[6][8];
#pragma unroll
    for (int k = 0; k < 6; ++k) {
        const int tt = t0 + k - 1; const float msk = (tt >= 0 && tt < len) ? 1.f : 0.f;
        float cc[8], hh[8]; unpack8(rc[k], cc); unpack8(rh[k], hh);
#pragma unroll
        for (int e = 0; e < 8; ++e) prod[k][e] = cc[e] * hh[e] * msk;
    }
#pragma unroll
    for (int k = 0; k < 4; ++k) {
        float bb[8], gg[8], o[8]; unpack8(rb[k], bb); unpack8(rg[k], gg);
#pragma unroll
        for (int e = 0; e < 8; ++e) {
            const float wa = e < 4 ? w0[0][e & 3] : w1[0][e & 3], wb = e < 4 ? w0[1][e & 3] : w1[1][e & 3], wc = e < 4 ? w0[2][e & 3] : w1[2][e & 3];
            const float acc = wa * prod[k][e] + wb * prod[k + 1][e] + wc * prod[k + 2][e];
            o[e] = bb[e] * acc * siluf(gg[e]);
        }
        *(u32x4*)(Y + (size_t)(row0 + k) * DM + 1024 + ch) = pack8(o);
    }
}

DI void finish_item(const P& p, int l, int r16) {
    const bf16_t* S = (const bf16_t*)(p.ws + WS_SBUF);
    bf16_t* Y = (bf16_t*)(p.ws + WS_YBUF);
    const bf16_t* O = (const bf16_t*)(p.ws + WS_NBUF);
    const int tid = otid(); const int row0 = r16 * 16 + (tid >> 7) * 4, u = tid & 127, mx = u >> 6, hh = (u >> 4) & 3, sub = u & 15;
    const int chn = 128 * hh + 8 * sub;
    u32x4 ra[4], rb[4], rg[4];
#pragma unroll
    for (int k = 0; k < 4; ++k) {
        ra[k] = __builtin_nontemporal_load((const u32x4*)(O + ((size_t)(mx * 2 + 0) * NROW + row0 + k) * 512 + chn));
        rb[k] = __builtin_nontemporal_load((const u32x4*)(O + ((size_t)(mx * 2 + 1) * NROW + row0 + k) * 512 + chn));
        rg[k] = __builtin_nontemporal_load((const u32x4*)(S + (size_t)(row0 + k) * NP + (mx ? C_GDN_G : C_GLA_G) + chn));
    }
    const float* nwp = (mx ? p.gdn_norm : p.gla_norm) + l * 128 + 8 * sub;
    const f32x4 nw0 = *(const f32x4*)nwp, nw1 = *(const f32x4*)(nwp + 4);
#pragma unroll
    for (int k = 0; k < 4; ++k) {
        float a[8], b[8], o[8], gt[8];
        unpack8(ra[k], a); unpack8(rb[k], b); unpack8(rg[k], gt);
        float ss = 0.f;
#pragma unroll
        for (int e = 0; e < 8; ++e) { o[e] = a[e] + b[e]; ss += o[e] * o[e]; }
        ss += __shfl_xor(ss, 1); ss += __shfl_xor(ss, 2); ss += __shfl_xor(ss, 4); ss += __shfl_xor(ss, 8);
        const float rstd = rsqrtf(ss * (1.f / 128.f) + 1e-6f);
#pragma unroll
        for (int e = 0; e < 8; ++e) o[e] = o[e] * rstd * (e < 4 ? nw0[e & 3] : nw1[e & 3]) * siluf(gt[e]);
        *(u32x4*)(Y + (size_t)(row0 + k) * DM + 512 * mx + chn) = pack8(o);
    }
}

DI void gla_prep_item(const P& p, int l, int item, unsigned char* smem) {
    const int c = item % 72, bd = item / 72, dir = bd & 1, b = bd >> 1;
    float* slr = (float*)smem;
    float* stot = slr + 512;
    float* slast = stot + 256;
    bf16_t* sq = (bf16_t*)(slast + 256);
    bf16_t* sk = sq + 4 * 32 * 72;
    const bf16_t* S = (const bf16_t*)(p.ws + WS_SBUF);
    bf16_t* QT = (bf16_t*)(p.ws + WS_GLA_QT); bf16_t* KO = (bf16_t*)(p.ws + WS_GLA_KO); bf16_t* AT = (bf16_t*)(p.ws + WS_GLA_AT); float* DC = (float*)(p.ws + WS_GLA_DC);
    const int tid = otid();
    { const int i = tid >> 4, r = tid & 15; slr[i * 16 + r] = ((const float*)(p.ws + WS_G))[(size_t)prow(b, dir, 32 * c + i) * NNAR + G_LR + 16 * dir + r]; }
    __syncthreads();
    const int cch = tid & 255, half = tid >> 8, h = cch >> 6, d = cch & 63;
    bf16_t qraw[16], kraw[16];
#pragma unroll
    for (int ii = 0; ii < 16; ++ii) { const size_t row = (size_t)prow(b, dir, 32 * c + 16 * half + ii); qraw[ii] = S[row * NP + C_GLA_Q + cch]; kraw[ii] = S[row * NP + C_GLA_K + cch]; }
    float wd[16];
#pragma unroll
    for (int r = 0; r < 16; ++r) wd[r] = p.gla_wd[((size_t)(l * 2 + dir) * 16 + r) * 256 + cch];
    const float bdv = p.gla_bd[(l * 2 + dir) * 256 + cch];
    float cum[16]; float run = 0.f;
#pragma unroll
    for (int ii = 0; ii < 16; ++ii) {
        const int i = 16 * half + ii; float z = bdv;
#pragma unroll
        for (int r = 0; r < 16; ++r) z += slr[i * 16 + r] * wd[r];
        const float ls = fminf(z, 0.f) - __logf(1.f + __expf(-fabsf(z)));
        run += ls * (1.f / 16.f); cum[ii] = run;
    }
    if (half == 0) stot[cch] = run;
    __syncthreads();
    if (half == 1) { const float t = stot[cch];
#pragma unroll
        for (int ii = 0; ii < 16; ++ii) cum[ii] += t;
        slast[cch] = cum[15]; }
    __syncthreads();
    const float cl = slast[cch];
    const int seq = (dir * 4 + b) * 4 + h;
#pragma unroll
    for (int ii = 0; ii < 16; ++ii) {
        const int i = 16 * half + ii, pp = 32 * c + i;
        const float q = bf2f(qraw[ii]) * 0.125f, k = bf2f(kraw[ii]);
        const float qt = q * __expf(cum[ii]), kt = k * __expf(-cum[ii]), ko = k * __expf(cl - cum[ii]);
        QT[((size_t)seq * PT + pp) * 64 + d] = f2bf(qt); KO[((size_t)seq * PT + pp) * 64 + d] = f2bf(ko);
        sq[(h * 32 + i) * 72 + d] = f2bf(qt); sk[(h * 32 + i) * 72 + d] = f2bf(kt);
    }
    if (half == 0) DC[((size_t)seq * 72 + c) * 64 + d] = __expf(cl);
    __syncthreads();
    {
        const int w = tid >> 6, lane = tid & 63, l15 = lane & 15, g = lane >> 4, hh = w >> 1, mt = w & 1;
        const int seqh = (dir * 4 + b) * 4 + hh;
#pragma unroll
        for (int nt = 0; nt < 2; ++nt) {
            f32x4 acc = (f32x4){0.f, 0.f, 0.f, 0.f};
#pragma unroll
            for (int ks = 0; ks < 2; ++ks) {
                const bf16x8 a = ld8(sq + (hh * 32 + 16 * mt + l15) * 72 + 32 * ks + 8 * g), bb = ld8(sk + (hh * 32 + 16 * nt + l15) * 72 + 32 * ks + 8 * g);
                acc = mfma16(bb, a, acc);
            }
            const int i = 16 * mt + l15, j0 = 16 * nt + 4 * g;
            u32x2 ov; ov.x = pk2(j0 <= i ? acc[0] : 0.f, j0 + 1 <= i ? acc[1] : 0.f); ov.y = pk2(j0 + 2 <= i ? acc[2] : 0.f, j0 + 3 <= i ? acc[3] : 0.f);
            *(u32x2*)(AT + (((size_t)seqh * 72 + c) * 32 + i) * 32 + j0) = ov;
        }
    }
    __syncthreads();
}

struct GlaRegs { u32x4 rv, rq, ra; float rd; };
DI void gla_scan_item(const P& p, int seq, unsigned char* smem) {
    const int dir = seq >> 4, b = (seq >> 2) & 3, h = seq & 3;
    constexpr int BUFB = 20736;
    const bf16_t* S = (const bf16_t*)(p.ws + WS_SBUF);
    const bf16_t* QT = (const bf16_t*)(p.ws + WS_GLA_QT); const bf16_t* KO = (const bf16_t*)(p.ws + WS_GLA_KO); const bf16_t* AT = (const bf16_t*)(p.ws + WS_GLA_AT); const float* DC = (const float*)(p.ws + WS_GLA_DC);
    bf16_t* OG = (bf16_t*)(p.ws + WS_NBUF) + (size_t)dir * NROW * 512;
    const int tid = otid(), w = tid >> 6, lane = tid & 63, l15 = lane & 15, g = lane >> 4, q4 = l15 >> 2, p4 = l15 & 3;
    auto loadr = [&](GlaRegs& R, int c) {
        if (c >= 72) return;
        { const int pos = tid >> 4, ch = tid & 15; R.rv = *(const u32x4*)(S + (size_t)prow(b, dir, 32 * c + pos) * NP + C_GLA_V + 128 * h + 8 * ch); }
        { const int t2 = tid & 255, pos = t2 >> 3, ch = t2 & 7; const bf16_t* src = (tid < 256 ? QT : KO) + ((size_t)seq * PT + 32 * c + pos) * 64 + 8 * ch; R.rq = __builtin_nontemporal_load((const u32x4*)src); }
        if (tid < 128) { const int i = tid >> 2, ch = tid & 3; R.ra = __builtin_nontemporal_load((const u32x4*)(AT + (((size_t)seq * 72 + c) * 32 + i) * 32 + 8 * ch)); }
        if (tid >= 128 && tid < 192) R.rd = DC[((size_t)seq * 72 + c) * 64 + (tid - 128)];
    };
    auto storel = [&](const GlaRegs& R, int buf) {
        unsigned char* base = smem + buf * BUFB;
        bf16_t* sat = (bf16_t*)base; bf16_t* sqt = (bf16_t*)(base + 2560); bf16_t* sko = (bf16_t*)(base + 2560 + 4608); bf16_t* sv = (bf16_t*)(base + 2560 + 9216); float* sdc = (float*)(base + 2560 + 9216 + 8704);
        { const int pos = tid >> 4, ch = tid & 15; *(u32x4*)(sv + pos * 136 + 8 * ch) = R.rv; }
        { const int t2 = tid & 255, pos = t2 >> 3, ch = t2 & 7; *(u32x4*)((tid < 256 ? sqt : sko) + pos * 72 + 8 * ch) = R.rq; }
        if (tid < 128) { const int i = tid >> 2, ch = tid & 3; *(u32x4*)(sat + i * 40 + 8 * ch) = R.ra; }
        if (tid >= 128 && tid < 192) sdc[tid - 128] = R.rd;
    };
    f32x4 st[4];
#pragma unroll
    for (int i = 0; i < 4; ++i) st[i] = (f32x4){0.f, 0.f, 0.f, 0.f};
    const int sgn = dir ? -1 : 1;
    auto compute = [&](int c) {
        const unsigned char* base = smem + (c & 1) * BUFB;
        const bf16_t* sat = (const bf16_t*)base; const bf16_t* sqt = (const bf16_t*)(base + 2560); const bf16_t* sko = (const bf16_t*)(base + 2560 + 4608); const bf16_t* sv = (const bf16_t*)(base + 2560 + 9216); const float* sdc = (const float*)(base + 2560 + 9216 + 8704);
        const int dv0 = 16 * w;
        const bf16x8 vb = tr2(sv + (8 * g + q4) * 136 + dv0 + 4 * p4, sv + (8 * g + 4 + q4) * 136 + dv0 + 4 * p4);
        bf16x8 bs[2];
        bs[0] = packacc(st[0], st[1]); bs[1] = packacc(st[2], st[3]);
#pragma unroll
        for (int mt = 0; mt < 2; ++mt) {
            f32x4 acc = (f32x4){0.f, 0.f, 0.f, 0.f};
            acc = mfma16(vb, ld8(sat + (16 * mt + l15) * 40 + 8 * g), acc);
#pragma unroll
            for (int ks = 0; ks < 2; ++ks) {
                const bf16_t* r0 = sqt + (16 * mt + l15) * 72 + 32 * ks + 4 * g;
                acc = mfma16(bs[ks], ld4x2(r0, r0 + 16), acc);
            }
            bf16_t* ob = OG + (size_t)prow(b, dir, 32 * c) * 512 + 128 * h;
            u32x2 ov; ov.x = pk2(acc[0], acc[1]); ov.y = pk2(acc[2], acc[3]);
            *(u32x2*)(ob + sgn * ((16 * mt + l15) * 512) + dv0 + 4 * g) = ov;
        }
#pragma unroll
        for (int dt = 0; dt < 4; ++dt) {
            const bf16x8 ak = tr2(sko + (8 * g + q4) * 72 + 16 * dt + 4 * p4, sko + (8 * g + 4 + q4) * 72 + 16 * dt + 4 * p4);
#pragma unroll
            for (int r = 0; r < 4; ++r) st[dt][r] *= sdc[16 * dt + 4 * g + r];
            st[dt] = mfma16(ak, vb, st[dt]);
        }
    };
    GlaRegs R0, R1, R2, R3, R4, R5;
    loadr(R0, 0); loadr(R1, 1); loadr(R2, 2); loadr(R3, 3); loadr(R4, 4); loadr(R5, 5);
#pragma unroll 1
    for (int c = 0; c < 72; c += 6) {
        storel(R0, 0); __syncthreads(); loadr(R0, c + 6); compute(c);
        storel(R1, 1); __syncthreads(); loadr(R1, c + 7); compute(c + 1);
        storel(R2, 0); __syncthreads(); loadr(R2, c + 8); compute(c + 2);
        storel(R3, 1); __syncthreads(); loadr(R3, c + 9); compute(c + 3);
        storel(R4, 0); __syncthreads(); loadr(R4, c + 10); compute(c + 4);
        storel(R5, 1); __syncthreads(); loadr(R5, c + 11); compute(c + 5);
    }
    __syncthreads();
}

DI void gdn_conv16(const bf16_t* raw, const float* cw, int ti, int cch, float* out) {
#pragma unroll
    for (int e = 0; e < 16; ++e) out[e] = 0.f;
#pragma unroll 1
    for (int j = 0; j < 5; ++j) {
        const bf16_t* rp = raw + (ti + j) * 392 + cch;
        float xv[16];
        unpack8(*(const u32x4*)rp, xv); unpack8(*(const u32x4*)(rp + 8), xv + 8);
        const float* w = cw + j * 384 + cch;
#pragma unroll
        for (int e4 = 0; e4 < 4; ++e4) { const f32x4 wv = *(const f32x4*)(w + 4 * e4);
#pragma unroll
            for (int e = 0; e < 4; ++e) out[4 * e4 + e] += wv[e] * xv[4 * e4 + e]; }
    }
#pragma unroll
    for (int e = 0; e < 16; ++e) out[e] = siluf(out[e]);
}

DI f32x4 mfma4(float a, float b, f32x4 c) { return __builtin_amdgcn_mfma_f32_16x16x4f32(a, b, c, 0, 0, 0); }

DI void gdn_prep_item(const P& p, int l, int item, unsigned char* smem) {
    const int sc = item % 36, bh = item / 36, h = bh & 3, b = bh >> 2;
    constexpr int LS = 68;
    bf16_t* sK = (bf16_t*)smem;
    bf16_t* sKB = sK + 64 * 136;
    bf16_t* sQ = sKB + 64 * 136;
    bf16_t* sVb = sQ + 64 * 136;
    bf16_t* sKEb = sVb + 64 * 136;
    float* sL = (float*)(sKEb + 64 * 136);
    bf16_t* sLb = (bf16_t*)(sL + 64 * LS);
    bf16_t* sTd = sLb + 64 * 72;
    float* sg = (float*)(sTd + 4 * 16 * 24); float* sbeta = sg + 64; float* scum = sbeta + 64;
    const bf16_t* S = (const bf16_t*)(p.ws + WS_SBUF);
    bf16_t* U = (bf16_t*)(p.ws + WS_GDN_U); bf16_t* W = (bf16_t*)(p.ws + WS_GDN_W); bf16_t* QI = (bf16_t*)(p.ws + WS_GDN_QI); bf16_t* KO = (bf16_t*)(p.ws + WS_GDN_KO);
    bf16_t* AT = (bf16_t*)(p.ws + WS_GDN_AT); float* DC = (float*)(p.ws + WS_GDN_DC);
    const int tid = otid(), ti = tid >> 3, sub = tid & 7;
    const int w = __builtin_amdgcn_readfirstlane(tid >> 6), lane = tid & 63, l15 = lane & 15, g = lane >> 4, q4 = l15 >> 2, p4 = l15 & 3;
    int len, base, tlo, nseg, cseg, coff;
    if (sc < 4) { len = CL; base = NLAT + b * CL; cseg = sc; nseg = 4; coff = 0; } else { len = SL; base = b * SL; cseg = sc - 4; nseg = 32; coff = 4; }
    tlo = 64 * cseg;
    const size_t row = (size_t)(base + tlo + ti);
    const float* Gp = (const float*)(p.ws + WS_G) + row * NNAR;
    const float a_raw0 = Gp[G_A + h], a_raw1 = Gp[G_A + 4 + h], b_raw0 = Gp[G_B + h], b_raw1 = Gp[G_B + 4 + h];
    float* sCW = scum + 64;
    bf16_t* raw = (bf16_t*)smem;
    if (tid < 480) { const int j = tid / 96, r = tid % 96, part = r >> 5, e4 = r & 31;
        *(f32x4*)(sCW + j * 384 + part * 128 + 4 * e4) = *(const f32x4*)(p.gdn_conv + ((size_t)l * 5 + j) * 1536 + part * 512 + 128 * h + 4 * e4); }
#pragma unroll
    for (int k = 0; k < 7; ++k) {
        const int e = tid + 512 * k;
        if (e < 68 * 48) {
            const int r = e / 48, pc = e % 48, part = pc >> 4, wi = pc & 15;
            const int tt = tlo - 2 + r;
            u32x4 v = (u32x4){0u, 0u, 0u, 0u};
            if (tt >= 0 && tt < len) v = __builtin_nontemporal_load((const u32x4*)(S + (size_t)(base + tt) * NP + C_GDN_Q + part * 512 + 128 * h + 8 * wi));
            *(u32x4*)(raw + r * 392 + part * 128 + 8 * wi) = v;
        }
    }
    __syncthreads();
    float xq[16], xk[16], xv[16];
    gdn_conv16(raw, sCW, ti, 0 + 16 * sub, xq);
    gdn_conv16(raw, sCW, ti, 128 + 16 * sub, xk);
    gdn_conv16(raw, sCW, ti, 256 + 16 * sub, xv);
    float sq_ = 0.f, sk_ = 0.f;
#pragma unroll
    for (int e = 0; e < 16; ++e) { sq_ += xq[e] * xq[e]; sk_ += xk[e] * xk[e]; }
    sq_ += __shfl_xor(sq_, 1); sq_ += __shfl_xor(sq_, 2); sq_ += __shfl_xor(sq_, 4);
    sk_ += __shfl_xor(sk_, 1); sk_ += __shfl_xor(sk_, 2); sk_ += __shfl_xor(sk_, 4);
    const float rq = rsqrtf(sq_ + 1e-6f) * 0.08838834764831845f, rk = rsqrtf(sk_ + 1e-6f);
#pragma unroll
    for (int e = 0; e < 16; ++e) { xq[e] *= rq; xk[e] *= rk; }
#pragma unroll 1
  for (int dir = 0; dir < 2; ++dir) {
    const int seq = (dir * 4 + b) * 4 + h;
    const int c = coff + (dir ? nseg - 1 - cseg : cseg);
    const int i = dir ? 63 - ti : ti;
    const int pp = 64 * c + i;
    if (sub == 0) {
        const float a_in = dir ? a_raw1 : a_raw0, b_in = dir ? b_raw1 : b_raw0;
        const float A = __expf(p.gdn_alog[(l * 2 + dir) * 4 + h]);
        const float xx = a_in + p.gdn_dtb[(l * 2 + dir) * 4 + h];
        const float sp = fmaxf(xx, 0.f) + log1pf(__expf(-fabsf(xx)));
        sg[i] = -A * sp; sbeta[i] = __builtin_amdgcn_rcpf(1.f + __expf(-b_in));
    }
    __syncthreads();
    if (tid < 64) {
        float v = sg[tid];
#pragma unroll
        for (int o = 1; o < 64; o <<= 1) { const float u = __shfl_up(v, o); if (tid >= o) v += u; }
        scum[tid] = v;
    }
    __syncthreads();
    const float cumi = scum[i], cl = scum[63], bet = sbeta[i], ei = __expf(cumi), eo = __expf(cl - cumi);
    {
        float t1[16], t2[16];
        *(u32x4*)(sK + i * 136 + 16 * sub) = pack8(xk); *(u32x4*)(sK + i * 136 + 16 * sub + 8) = pack8(xk + 8);
        *(u32x4*)(sQ + i * 136 + 16 * sub) = pack8(xq); *(u32x4*)(sQ + i * 136 + 16 * sub + 8) = pack8(xq + 8);
#pragma unroll
        for (int e = 0; e < 16; ++e) { t1[e] = xk[e] * bet; t2[e] = xv[e] * bet; }
        *(u32x4*)(sKB + i * 136 + 16 * sub) = pack8(t1); *(u32x4*)(sKB + i * 136 + 16 * sub + 8) = pack8(t1 + 8);
        *(u32x4*)(sVb + i * 136 + 16 * sub) = pack8(t2); *(u32x4*)(sVb + i * 136 + 16 * sub + 8) = pack8(t2 + 8);
#pragma unroll
        for (int e = 0; e < 16; ++e) t2[e] = t1[e] * ei;
        *(u32x4*)(sKEb + i * 136 + 16 * sub) = pack8(t2); *(u32x4*)(sKEb + i * 136 + 16 * sub + 8) = pack8(t2 + 8);
#pragma unroll
        for (int e = 0; e < 16; ++e) { t1[e] = xq[e] * ei; t2[e] = xk[e] * eo; }
        bf16_t* qd = QI + ((size_t)seq * PT + pp) * 128 + 16 * sub; bf16_t* kd = KO + ((size_t)seq * PT + pp) * 128 + 16 * sub;
        __builtin_nontemporal_store(pack8(t1), (u32x4*)qd); __builtin_nontemporal_store(pack8(t1 + 8), (u32x4*)(qd + 8));
        __builtin_nontemporal_store(pack8(t2), (u32x4*)kd); __builtin_nontemporal_store(pack8(t2 + 8), (u32x4*)(kd + 8));
        if (tid == 0) DC[seq * 36 + c] = __expf(cl);
    }
    __syncthreads();
    {
        const int mt = w >> 1;
#pragma unroll
        for (int n2 = 0; n2 < 2; ++n2) {
            const int nt = 2 * (w & 1) + n2;
            f32x4 aL = (f32x4){0.f, 0.f, 0.f, 0.f}, aA = (f32x4){0.f, 0.f, 0.f, 0.f};
#pragma unroll
            for (int ks = 0; ks < 4; ++ks) {
                const bf16x8 bk = ld8(sK + (16 * nt + l15) * 136 + 32 * ks + 8 * g);
                aL = mfma16(bk, ld8(sKB + (16 * mt + l15) * 136 + 32 * ks + 8 * g), aL);
                aA = mfma16(bk, ld8(sQ + (16 * mt + l15) * 136 + 32 * ks + 8 * g), aA);
            }
            const int ii = 16 * mt + l15, j0 = 16 * nt + 4 * g;
            const f32x4 cj = *(const f32x4*)(scum + j0); const float ci = scum[ii];
            f32x4 lv; float av[4];
#pragma unroll
            for (int r = 0; r < 4; ++r) {
                const float dcy = __expf(fminf(ci - cj[r], 0.f));
                lv[r] = (j0 + r < ii) ? aL[r] * dcy : 0.f;
                av[r] = (j0 + r <= ii) ? aA[r] * dcy : 0.f;
            }
            *(f32x4*)(sL + ii * LS + j0) = lv;
            { u32x2 lb; lb.x = pk2(lv[0], lv[1]); lb.y = pk2(lv[2], lv[3]); *(u32x2*)(sLb + ii * 72 + j0) = lb; }
            { u32x2 ab; ab.x = pk2(av[0], av[1]); ab.y = pk2(av[2], av[3]); *(u32x2*)(AT + (((size_t)seq * 36 + c) * 64 + ii) * 64 + j0) = ab; }
        }
    }
    __syncthreads();
    if (tid < 64) {
        const int I = tid >> 4, cc = tid & 15;
        float tt[16];
#pragma unroll
        for (int r = 0; r < 16; ++r) tt[r] = (r == cc) ? 1.f : 0.f;
#pragma unroll
        for (int j = 0; j < 15; ++j) {
            const float tj = tt[j];
#pragma unroll
            for (int r = j + 1; r < 16; ++r) tt[r] -= sL[(16 * I + r) * LS + 16 * I + j] * tj;
        }
#pragma unroll
        for (int r = 0; r < 16; ++r) sTd[(I * 16 + r) * 24 + cc] = f2bf(tt[r]);
    }
    __syncthreads();
    {
        const bf16_t* Rb = w < 4 ? sVb : sKEb;
        bf16_t* dstb = (w < 4 ? U : W) + ((size_t)seq * PT + 64 * c) * 128;
#pragma unroll
        for (int n2 = 0; n2 < 2; ++n2) {
            const int col0 = 32 * (w & 3) + 16 * n2;
            s16x4 Xb[4];
#pragma unroll
            for (int I = 0; I < 4; ++I) {
                f32x4 accL = (f32x4){0.f, 0.f, 0.f, 0.f};
#pragma unroll
                for (int J = 0; J < I; ++J)
                    accL = __builtin_amdgcn_mfma_f32_16x16x16bf16_1k(*(const s16x4*)(sLb + (16 * I + l15) * 72 + 16 * J + 4 * g), Xb[J], accL, 0, 0, 0);
                f32x4 rhs;
#pragma unroll
                for (int r = 0; r < 4; ++r) rhs[r] = bf2f(Rb[(16 * I + 4 * g + r) * 136 + col0 + l15]) - accL[r];
                u32x2 pb; pb.x = pk2(rhs[0], rhs[1]); pb.y = pk2(rhs[2], rhs[3]);
                const f32x4 X = __builtin_amdgcn_mfma_f32_16x16x16bf16_1k(*(const s16x4*)(sTd + (I * 16 + l15) * 24 + 4 * g), __builtin_bit_cast(s16x4, pb), (f32x4){0.f, 0.f, 0.f, 0.f}, 0, 0, 0);
                u32x2 px; px.x = pk2(X[0], X[1]); px.y = pk2(X[2], X[3]);
                Xb[I] = __builtin_bit_cast(s16x4, px);
#pragma unroll
                for (int r = 0; r < 4; ++r) dstb[(size_t)(16 * I + 4 * g + r) * 128 + col0 + l15] = f2bf(X[r]);
            }
        }
    }
    __syncthreads();
  }
}

struct GdnRegs { u32x4 r[8]; };
DI void gdn_scan_item(const P& p, int item, unsigned char* smem) {
    const int seq = (item & 7) * 4 + (item >> 5), cq = (item >> 3) & 3;
    const int dir = seq >> 4, b = (seq >> 2) & 3, h = seq & 3;
    constexpr int BUFB = 3 * 17408 + 9216 + 5120;
    bf16_t* sVN = (bf16_t*)(smem + 2 * BUFB);
    float* sdec = (float*)(smem + 2 * BUFB + 5120);
    const bf16_t* U = (const bf16_t*)(p.ws + WS_GDN_U); const bf16_t* W = (const bf16_t*)(p.ws + WS_GDN_W); const bf16_t* QI = (const bf16_t*)(p.ws + WS_GDN_QI); const bf16_t* KO = (const bf16_t*)(p.ws + WS_GDN_KO);
    const bf16_t* AT = (const bf16_t*)(p.ws + WS_GDN_AT); const float* DC = (const float*)(p.ws + WS_GDN_DC);
    bf16_t* OG = (bf16_t*)(p.ws + WS_NBUF) + (size_t)(2 + dir) * NROW * 512;
    const int tid = otid(), w = tid >> 6, lane = tid & 63, l15 = lane & 15, g = lane >> 4, q4 = l15 >> 2, p4 = l15 & 3;
    const int mt = w >> 1, nt = w & 1;
    auto loadr = [&](GdnRegs& R, int c) {
        if (c >= 36) return;
        u32x4* rr = R.r;
#pragma unroll
        for (int k = 0; k < 2; ++k) {
            const int e = tid + 512 * k, r = e >> 4, ch = e & 15; const size_t off = ((size_t)seq * PT + 64 * c + r) * 128 + 8 * ch;
            rr[k] = *(const u32x4*)(W + off); rr[2 + k] = *(const u32x4*)(QI + off); rr[4 + k] = *(const u32x4*)(KO + off);
        }
        { const int r = tid >> 3, ch = tid & 7; rr[6] = *(const u32x4*)(AT + (((size_t)seq * 36 + c) * 64 + r) * 64 + 8 * ch); }
        if (tid < 256) { const int r = tid >> 2, ch = tid & 3; rr[7] = __builtin_nontemporal_load((const u32x4*)(U + ((size_t)seq * PT + 64 * c + r) * 128 + 32 * cq + 8 * ch)); }
    };
    auto storel = [&](const GdnRegs& R, int buf) {
        const u32x4* rr = R.r;
        bf16_t* sW = (bf16_t*)(smem + buf * BUFB); bf16_t* sQI = sW + 64 * 136; bf16_t* sKO = sQI + 64 * 136; bf16_t* sAT = sKO + 64 * 136; bf16_t* sU = sAT + 64 * 72;
#pragma unroll
        for (int k = 0; k < 2; ++k) {
            const int e = tid + 512 * k, r = e >> 4, ch = e & 15; const int off = r * 136 + 8 * ch;
            *(u32x4*)(sW + off) = rr[k]; *(u32x4*)(sQI + off) = rr[2 + k]; *(u32x4*)(sKO + off) = rr[4 + k];
        }
        { const int r = tid >> 3, ch = tid & 7; *(u32x4*)(sAT + r * 72 + 8 * ch) = rr[6]; }
        if (tid < 256) { const int r = tid >> 2, ch = tid & 3; *(u32x4*)(sU + r * 40 + 8 * ch) = rr[7]; }
    };
    u32x4* sBS = (u32x4*)(smem + 2 * BUFB + 5120 + 256);
    f32x4 st[2];
    st[0] = (f32x4){0.f, 0.f, 0.f, 0.f}; st[1] = (f32x4){0.f, 0.f, 0.f, 0.f};
    sBS[(nt * 4 + mt) * 64 + lane] = (u32x4){0u, 0u, 0u, 0u};
    if (tid < 36) sdec[tid] = DC[seq * 36 + tid];
    const int sgn = dir ? -1 : 1;
    auto step = [&](GdnRegs& R, int c) {
        storel(R, c & 1);
        __syncthreads();
        loadr(R, c + 3);
        const bf16_t* sW = (const bf16_t*)(smem + (c & 1) * BUFB); const bf16_t* sQI = sW + 64 * 136; const bf16_t* sKO = sQI + 64 * 136; const bf16_t* sAT = sKO + 64 * 136; const bf16_t* sU = sAT + 64 * 72;
        const float dec = sdec[c];
        bf16x8 Bs[4];
#pragma unroll
        for (int ks = 0; ks < 4; ++ks) Bs[ks] = __builtin_bit_cast(bf16x8, sBS[(nt * 4 + ks) * 64 + lane]);
        {
            f32x4 acc = (f32x4){0.f, 0.f, 0.f, 0.f};
#pragma unroll
            for (int ks = 0; ks < 4; ++ks) { const bf16_t* r0 = sW + (16 * mt + l15) * 136 + 32 * ks + 4 * g; acc = mfma16(Bs[ks], ld4x2(r0, r0 + 16), acc); }
            {
                const u32x2 uu = *(const u32x2*)(sU + (16 * mt + l15) * 40 + 16 * nt + 4 * g);
                u32x2 vv; vv.x = pk2(lo16(uu.x) - acc[0], hi16(uu.x) - acc[1]); vv.y = pk2(lo16(uu.y) - acc[2], hi16(uu.y) - acc[3]);
                *(u32x2*)(sVN + (16 * mt + l15) * 40 + 16 * nt + 4 * g) = vv;
            }
        }
        __syncthreads();
        bf16x8 Bv[2];
#pragma unroll
        for (int k2 = 0; k2 < 2; ++k2) Bv[k2] = tr2(sVN + (32 * k2 + 8 * g + q4) * 40 + 16 * nt + 4 * p4, sVN + (32 * k2 + 8 * g + 4 + q4) * 40 + 16 * nt + 4 * p4);
        {
            f32x4 acc = (f32x4){0.f, 0.f, 0.f, 0.f};
#pragma unroll
            for (int ks = 0; ks < 4; ++ks) { const bf16_t* r0 = sQI + (16 * mt + l15) * 136 + 32 * ks + 4 * g; acc = mfma16(Bs[ks], ld4x2(r0, r0 + 16), acc); }
#pragma unroll
            for (int k2 = 0; k2 < 2; ++k2) acc = mfma16(Bv[k2], ld8(sAT + (16 * mt + l15) * 72 + 32 * k2 + 8 * g), acc);
            bf16_t* ob = OG + (size_t)prow(b, dir, 64 * c) * 512 + 128 * h + 32 * cq;
            u32x2 ov; ov.x = pk2(acc[0], acc[1]); ov.y = pk2(acc[2], acc[3]);
            *(u32x2*)(ob + sgn * ((16 * mt + l15) * 512) + 16 * nt + 4 * g) = ov;
        }
#pragma unroll
        for (int j = 0; j < 2; ++j) {
            const int dt = 2 * mt + j;
            st[j] *= dec;
#pragma unroll
            for (int k2 = 0; k2 < 2; ++k2) {
                const bf16x8 ak = tr2(sKO + (32 * k2 + 8 * g + q4) * 136 + 16 * dt + 4 * p4, sKO + (32 * k2 + 8 * g + 4 + q4) * 136 + 16 * dt + 4 * p4);
                st[j] = mfma16(ak, Bv[k2], st[j]);
            }
        }
        sBS[(nt * 4 + mt) * 64 + lane] = __builtin_bit_cast(u32x4, packacc(st[0], st[1]));
    };
    GdnRegs R0, R1, R2;
    loadr(R0, 0); loadr(R1, 1); loadr(R2, 2);
#pragma unroll 1
    for (int c = 0; c < 36; c += 3) { step(R0, c); step(R1, c + 1); step(R2, c + 2); }
    __syncthreads();
}

DI void rope8(float* x1, float* x2, int g8, float posv) {
#pragma unroll
    for (int e = 0; e < 8; ++e) {
        const float inv = exp2f(-(float)(g8 + e) * 0.41524101186092f);
        float s, c; __sincosf(posv * inv, &s, &c);
        const float a = x1[e], bb = x2[e];
        x1[e] = a * c - bb * s; x2[e] = bb * c + a * s;
    }
}

DI void krope_item(const P& p, int r32) {
    const bf16_t* S = (const bf16_t*)(p.ws + WS_SBUF);
    bf16_t* KR = (bf16_t*)(p.ws + WS_KR);
    const int tid = otid(); const int row = r32 * 32 + (tid >> 4), u = tid & 15, hk = u >> 3, hf = (u >> 2) & 1, e8 = (u & 3) * 8;
    const bf16_t* src = S + (size_t)row * NP + C_SWA_K + 128 * hk + 64 * hf + e8;
    float x1[8], x2[8]; unpack8(__builtin_nontemporal_load((const u32x4*)src), x1); unpack8(__builtin_nontemporal_load((const u32x4*)(src + 32)), x2);
    const int kp = row & 2047;
    rope8(x1, x2, e8, (float)(hf == 0 ? (kp >> 6) : (kp & 63)));
    bf16_t* dst = KR + (size_t)row * 256 + 128 * hk + 64 * hf + e8;
    *(u32x4*)dst = pack8(x1); *(u32x4*)(dst + 32) = pack8(x2);
}

struct SwaRegs { u32x4 pr1, pr2, pv1, pv2; };
DI void swa_item(const P& p, int l, int item, unsigned char* smem) {
    bf16_t* sK = (bf16_t*)smem; bf16_t* sV = sK + 64 * 136;
    const bf16_t* S = (const bf16_t*)(p.ws + WS_SBUF);
    const bf16_t* KR = (const bf16_t*)(p.ws + WS_KR);
    bf16_t* Y = (bf16_t*)(p.ws + WS_YBUF);
    bool lat; int b, hk, qb;
    if (item < 256) { lat = true; b = item >> 6; hk = (item >> 5) & 1; qb = item & 31; } else { const int it = item - 256; lat = false; b = it >> 3; hk = (it >> 2) & 1; qb = it & 3; }
    const int tid = otid(), w = tid >> 6, lane = tid & 63, l15 = lane & 15, g = lane >> 4, q4 = l15 >> 2, p4 = l15 & 3;
    const int hq = 2 * hk + (w >> 2);
    const int qpos = 64 * qb + 16 * (w & 3) + l15;
    const size_t qrow = lat ? (size_t)(b * SL + qpos) : (size_t)(NLAT + b * CL + qpos);
    bf16x8 Qf[4];
    {
        float xs[4][8];
#pragma unroll
        for (int ks = 0; ks < 4; ++ks) unpack8(*(const u32x4*)(S + qrow * NP + C_SWA_Q + 128 * hq + 32 * ks + 8 * g), xs[ks]);
        if (lat) { rope8(xs[0], xs[1], 8 * g, (float)(qpos >> 6)); rope8(xs[2], xs[3], 8 * g, (float)(qpos & 63)); }
        const float qs = 0.08838834764831845f * 1.4426950408889634f;
#pragma unroll
        for (int ks = 0; ks < 4; ++ks) {
#pragma unroll
            for (int e = 0; e < 8; ++e) xs[ks][e] *= qs;
            Qf[ks] = __builtin_bit_cast(bf16x8, pack8(xs[ks]));
        }
    }
    float m = p.swa_sink[l * 4 + hq] * 1.4426950408889634f;
    float lsum = (g == 0) ? 1.f : 0.f;
    f32x4 ot[8];
#pragma unroll
    for (int i = 0; i < 8; ++i) ot[i] = (f32x4){0.f, 0.f, 0.f, 0.f};
    int lo = 0, ntl = 0;
    if (lat) { lo = 64 * qb - 128; if (lo < 0) lo = 0; int hi = 64 * qb + 192; if (hi > SL) hi = SL; ntl = (hi - lo) >> 6; }
    const int ntot = ntl + 4;
    const int skey = tid >> 3, ssub = tid & 7, shf = ssub >> 2, se8 = (ssub & 3) * 8;
    auto kvload = [&](SwaRegs& R, int tix) {
        if (tix >= ntot) return;
        const bool loc = tix < ntl;
        const int kpos0 = loc ? lo + 64 * tix : 64 * (tix - ntl);
        const size_t krow0 = loc ? (size_t)(b * SL + kpos0) : (size_t)(NLAT + b * CL + kpos0);
        const bf16_t* src = loc ? KR + (krow0 + skey) * 256 + 128 * hk + 64 * shf + se8 : S + (krow0 + skey) * NP + C_SWA_K + 128 * hk + 64 * shf + se8;
        R.pr1 = *(const u32x4*)src; R.pr2 = *(const u32x4*)(src + 32);
        const bf16_t* vsrc = S + (krow0 + skey) * NP + C_SWA_V + 128 * hk + 16 * ssub;
        R.pv1 = *(const u32x4*)vsrc; R.pv2 = *(const u32x4*)(vsrc + 8);
    };
    auto tile = [&](SwaRegs& R, int tix) {
        const bool loc = tix < ntl;
        const int kpos0 = loc ? lo + 64 * tix : 64 * (tix - ntl);
        __syncthreads();
        {
            const u32x4 r1 = R.pr1, r2 = R.pr2;
            *(u32x4*)(sK + skey * 136 + 64 * shf + se8) = r1; *(u32x4*)(sK + skey * 136 + 64 * shf + 32 + se8) = r2;
            *(u32x4*)(sV + skey * 144 + 16 * ssub) = R.pv1; *(u32x4*)(sV + skey * 144 + 16 * ssub + 8) = R.pv2;
        }
        __syncthreads();
        kvload(R, tix + 2);
        f32x4 sc[4];
#pragma unroll
        for (int kt = 0; kt < 4; ++kt) {
            f32x4 acc = (f32x4){0.f, 0.f, 0.f, 0.f};
#pragma unroll
            for (int ks = 0; ks < 4; ++ks) acc = mfma16(ld8(sK + (16 * kt + l15) * 136 + 32 * ks + 8 * g), Qf[ks], acc);
            sc[kt] = acc;
        }
        if (loc && (kpos0 <= 64 * qb - 128 || kpos0 >= 64 * qb + 128)) {
#pragma unroll
            for (int kt = 0; kt < 4; ++kt)
#pragma unroll
                for (int r = 0; r < 4; ++r) { const int dd = kpos0 + 16 * kt + 4 * g + r - qpos; if (dd > 128 || dd < -128) sc[kt][r] = -1e30f; }
        }
        float tmax = -1e30f;
#pragma unroll
        for (int kt = 0; kt < 4; ++kt)
#pragma unroll
            for (int r = 0; r < 4; ++r) tmax = fmaxf(tmax, sc[kt][r]);
        tmax = fmaxf(tmax, __shfl_xor(tmax, 16)); tmax = fmaxf(tmax, __shfl_xor(tmax, 32));
        const float mn = fmaxf(m, tmax), alpha = __builtin_amdgcn_exp2f(m - mn);
        m = mn;
        float psum = 0.f;
#pragma unroll
        for (int kt = 0; kt < 4; ++kt)
#pragma unroll
            for (int r = 0; r < 4; ++r) { const float pv = __builtin_amdgcn_exp2f(sc[kt][r] - mn); sc[kt][r] = pv; psum += pv; }
        lsum = lsum * alpha + psum;
        bf16x8 Bp[2];
        Bp[0] = packacc(sc[0], sc[1]); Bp[1] = packacc(sc[2], sc[3]);
#pragma unroll
        for (int nt = 0; nt < 8; ++nt) {
            ot[nt] *= alpha;
#pragma unroll
            for (int k2 = 0; k2 < 2; ++k2) {
                const bf16x8 av = tr2(sV + (32 * k2 + 4 * g + q4) * 144 + 16 * nt + 4 * p4, sV + (32 * k2 + 16 + 4 * g + q4) * 144 + 16 * nt + 4 * p4);
                ot[nt] = mfma16(av, Bp[k2], ot[nt]);
            }
        }
    };
    SwaRegs RA, RB;
    kvload(RA, 0); kvload(RB, 1);
#pragma unroll 1
    for (int tix = 0; tix < ntot; tix += 2) { tile(RA, tix); if (tix + 1 < ntot) tile(RB, tix + 1); }
    lsum += __shfl_xor(lsum, 16); lsum += __shfl_xor(lsum, 32);
    const float inv = __builtin_amdgcn_rcpf(lsum);
#pragma unroll
    for (int nt = 0; nt < 8; ++nt) {
        const int dvb = 16 * nt + 4 * g;
        const u32x2 gw = *(const u32x2*)(S + qrow * NP + C_SWA_G + 128 * hq + dvb);
        const float g0 = lo16(gw.x), g1 = hi16(gw.x), g2 = lo16(gw.y), g3 = hi16(gw.y);
        u32x2 o; o.x = pk2(ot[nt][0] * inv * siluf(g0), ot[nt][1] * inv * siluf(g1)); o.y = pk2(ot[nt][2] * inv * siluf(g2), ot[nt][3] * inv * siluf(g3));
        *(u32x2*)(Y + qrow * DM + 1536 + 128 * hq + dvb) = o;
    }
}


#define XB_TMO      128
#define XB_XCNT(j)  (256  + 64 * (j))
#define XB_XSUB(j)  (1280 + 64 * (j))
#define XB_XGEN(j)  (2304 + 64 * (j))
#define XB_TOP      3328
#define XB_TOPGEN   3392
#define XCD_BAR_WORDS 3456
#define XB_SPIN_CAP (1u << 18)
DI unsigned xb_ld(unsigned* p)              { return __hip_atomic_load(p, __ATOMIC_RELAXED, __HIP_MEMORY_SCOPE_AGENT); }
DI unsigned xb_add(unsigned* p, unsigned v) { return __hip_atomic_fetch_add(p, v, __ATOMIC_RELAXED, __HIP_MEMORY_SCOPE_AGENT); }
DI unsigned xb_xcc_id() { return (unsigned)__builtin_amdgcn_s_getreg((3 << 11) | 20) & 0xFu; }
#define XB_SPIN(cond, bar) do { unsigned _sp = 0; while (cond) { __builtin_amdgcn_s_sleep(1); \
    if ((++_sp & 255u) == 0u) { if (xb_ld(&(bar)[XB_TMO])) break; if (_sp > XB_SPIN_CAP) { atomicAdd(&(bar)[XB_TMO], 1u); break; } } } } while (0)
struct XcdBarrier { unsigned* bar; unsigned x; volatile LAS unsigned* st; };
DI XcdBarrier xcd_barrier_post(unsigned* bar, volatile LAS unsigned* st) {
    XcdBarrier b; b.bar = bar; b.x = xb_xcc_id(); b.st = st;
    if (threadIdx.x == 0) (void)xb_add(&bar[XB_XCNT(b.x)], 1u);
    return b;
}
DI void xcd_barrier_complete(unsigned* bar, unsigned x, unsigned& nloc, unsigned& nx) {
    const unsigned G = gridDim.x * gridDim.y * gridDim.z;
    unsigned sum, cnt, mine, sp = 0u;
    for (;;) {
        sum = 0u; cnt = 0u; mine = 0u;
#pragma unroll
        for (unsigned j = 0; j < 16; ++j) { const unsigned c = xb_ld(&bar[XB_XCNT(j)]); sum += c; cnt += (c > 0u) ? 1u : 0u; mine = (j == x) ? c : mine; }
        if (sum == G) break;
        __builtin_amdgcn_s_sleep(1);
        if ((++sp & 255u) == 0u) { if (xb_ld(&bar[XB_TMO])) break; if (sp > XB_SPIN_CAP) { atomicAdd(&bar[XB_TMO], 1u); break; } }
    }
    nloc = mine > 0u ? mine : 1u; nx = cnt > 0u ? cnt : 1u;
}
DI void xcd_barrier(const XcdBarrier& b) {
    asm volatile("s_waitcnt vmcnt(0)" ::: "memory");
    __syncthreads();
    if (threadIdx.x == 0) {
        unsigned* bar = b.bar;
        __builtin_amdgcn_s_waitcnt(0);
        unsigned nloc = b.st[0], nx = b.st[1];
        if (nloc == 0u) { xcd_barrier_complete(bar, b.x, nloc, nx); b.st[0] = nloc; b.st[1] = nx; }
        const unsigned old = xb_add(&bar[XB_XSUB(b.x)], 1u);
        const unsigned gen = old / nloc;
        if (old + 1u == (gen + 1u) * nloc) {
            __builtin_amdgcn_fence(__ATOMIC_RELEASE, "agent");
            asm volatile("s_waitcnt vmcnt(0)" ::: "memory");
            const unsigned og = xb_add(&bar[XB_TOP], 1u);
            const unsigned tg = og / nx;
            if (og + 1u == (tg + 1u) * nx) xb_add(&bar[XB_TOPGEN], 1u);
            else XB_SPIN(xb_ld(&bar[XB_TOPGEN]) == tg, bar);
            __builtin_amdgcn_fence(__ATOMIC_ACQUIRE, "agent");
            xb_add(&bar[XB_XGEN(b.x)], 1u);
            asm volatile("s_waitcnt vmcnt(0)" ::: "memory");
        } else {
            XB_SPIN(xb_ld(&bar[XB_XGEN(b.x)]) == gen, bar);
            __builtin_amdgcn_fence(__ATOMIC_ACQUIRE, "agent");
            asm volatile("s_waitcnt vmcnt(0)" ::: "memory");
        }
    }
    __syncthreads();
}

DI void weight_prep_item(const P& q, int l, int it, unsigned char* sm) {
    if (it < 96) adaln_item(q, l * 96 + it, sm);
    else if (it < 96 + 896) { const int r = it - 96, kt = r / 28, nt = r % 28;
        const int n0 = nt * 256, srcoff = n0 < 1024 ? 0 : (n0 < 3072 ? 32 : 48);
        transpose_item(q.w_in + (size_t)l * DM * INW, INW, srcoff, (bf16_t*)(q.ws + WS_WINT) + (size_t)l * NP * DM, kt, nt, sm); }
    else if (it < 96 + 896 + 256) { const int r = it - 96 - 896, kt = r / 8, nt = r % 8;
        transpose_item(q.w_out + (size_t)l * DM * DM, DM, 0, (bf16_t*)(q.ws + WS_WOUTT) + (size_t)l * DM * DM, kt, nt, sm); }
    else { const int kt = it - 96 - 896 - 256;
        narrow_item(q.w_in + (size_t)l * DM * INW, (bf16_t*)(q.ws + WS_WNT) + (size_t)l * NNAR * DM, kt); }
}

#define ITEM_BEGIN { size_t z_ = 0; asm volatile("" : "+s"(z_)); q.ws = p.ws + z_; sm = smem + osgpr(0); }
#define PHASE_BEGIN P q = p; { size_t z_ = 0; asm volatile("" : "+s"(z_)); q.ws = p.ws + z_; } unsigned char* sm = smem + osgpr(0); const int b1 = osgpr(bid); (void)sm; (void)b1;
__global__ __launch_bounds__(512, 2) void mega(P p) {
    extern __shared__ __attribute__((aligned(16))) unsigned char smem[];
    cg::grid_group grid = cg::this_grid();
    const int bid = blockIdx.x, nb = gridDim.x;
    volatile LAS unsigned* xst = (volatile LAS unsigned*)(smem + LDS_BYTES - 16);
    if (threadIdx.x < 4) xst[threadIdx.x] = 0u;
    __syncthreads();
    const XcdBarrier xb = xcd_barrier_post((unsigned*)(p.ws + WS_BAR), xst);
    if (p.ws == nullptr) grid.sync();
    for (int rep = 0; rep < REP_P0; ++rep) {
        PHASE_BEGIN
        for (int it = b1; it < 2560; it += nb) { ITEM_BEGIN weight_prep_item(q, it & 1, it >> 1, sm); }
    }
    xcd_barrier(xb);
    { PHASE_BEGIN norm0_phase(q, sm); }
    xcd_barrier(xb);
#pragma unroll 1
    for (int l0 = 0; l0 < 2; ++l0) {
        const int l = osgpr(l0);
        for (int rep = 0; rep < REP_G1; ++rep) {
            if (rep) xcd_barrier(xb);
            PHASE_BEGIN
            pg8::Gemm g{(const bf16_t*)(q.ws + WS_NBUF), (const bf16_t*)(q.ws + WS_WINT) + (size_t)l * NP * DM, NROW, NP, DM};
            pg8::StaticOrder so; so.init(g.M, g.N, nb, b1);
            pg8::EpiBf16 e{(bf16_t*)(q.ws + WS_SBUF), NP};
            pg8::gemm_phase((LAS unsigned char*)sm, g, so, e);
        }
        xcd_barrier(xb);
        for (int rep = 0; rep < REP_PREP; ++rep) {
            if (rep) xcd_barrier(xb);
            PHASE_BEGIN
            const int nconv = (l == 0 ? NROW : NLAT) / 32;
            const int ntot = 576 + 576 + nconv + 256;
            unsigned* qctr = xb.bar + 1 + l;
            volatile LAS unsigned* qw = xst + 2;
            unsigned nxt = 0u;
            if (threadIdx.x == 0) qw[0] = xb_add(qctr, 1u);
            __syncthreads();
            int it = (int)qw[0];
            __syncthreads();
            while (it < ntot) {
                ITEM_BEGIN
                if (threadIdx.x == 0) nxt = xb_add(qctr, 1u);
                if (it < 576) { for (int r2 = 0; r2 < REP_GDNP; ++r2) gdn_prep_item(q, l, it, sm); }
                else if (it < 576 + 576) { for (int r2 = 0; r2 < REP_GLAP; ++r2) gla_prep_item(q, l, it - 576, sm); }
                else if (it < 576 + 576 + nconv) conv_item(q, l, it - 576 - 576);
                else krope_item(q, it - 576 - 576 - nconv);
                if (threadIdx.x == 0) qw[0] = nxt;
                __syncthreads();
                it = (int)qw[0];
                __syncthreads();
            }
        }
        xcd_barrier(xb);
        for (int rep = 0; rep < REP_SCAN; ++rep) {
            if (rep) xcd_barrier(xb);
            PHASE_BEGIN
            if (b1 < 32) { for (int r2 = 0; r2 < REP_GLAS; ++r2) gla_scan_item(q, b1, sm); }
            else if (b1 < 160) { for (int r2 = 0; r2 < REP_GDNS; ++r2) gdn_scan_item(q, b1 - 32, sm); }
            else if (nb == 256) {
                const int j = b1 - 160, x = j & 7, slot = j >> 3, nloc = l == 0 ? 36 : 32;
                for (int li = slot; li < nloc; li += 12) { ITEM_BEGIN
                    const int it = li < 32 ? ((x >> 1) * 64 + (x & 1) * 32 + li) : (256 + (x >> 1) * 8 + (x & 1) * 4 + (li - 32));
                    for (int r2 = 0; r2 < REP_SWA; ++r2) swa_item(q, l, it, sm); }
            }
            else { const int nsw = l == 0 ? 288 : 256; for (int it = b1 - 160; it < nsw; it += nb - 160) { ITEM_BEGIN for (int r2 = 0; r2 < REP_SWA; ++r2) swa_item(q, l, it, sm); } }
        }
        xcd_barrier(xb);
        { PHASE_BEGIN const int nf = (l == 0 ? NROW : NLAT) / 16; for (int it = b1; it < nf; it += nb) { ITEM_BEGIN finish_item(q, l, it); } }
        xcd_barrier(xb);
        for (int rep = 0; rep < REP_G2; ++rep) {
            if (rep) xcd_barrier(xb);
            PHASE_BEGIN
            pg8::Gemm g{(const bf16_t*)(q.ws + WS_YBUF), (const bf16_t*)(q.ws + WS_WOUTT) + (size_t)l * DM * DM, NLAT, DM, DM};
            pg8::StaticOrder so; so.init(g.M, g.N, nb, b1);
            pg8::EpiBf16 e{(bf16_t*)(q.ws + WS_SBUF), DM};
            pg8::gemm_phase((LAS unsigned char*)sm, g, so, e);
        }
        xcd_barrier(xb);
        if (l == 0) {
            {
                PHASE_BEGIN
                if (b1 < 32) {
                    pg8::Gemm g{(const bf16_t*)(q.ws + WS_YBUF) + (size_t)NLAT * DM, (const bf16_t*)(q.ws + WS_WOUTT), NROW - NLAT, DM, DM};
                    pg8::StaticOrder so; so.init(g.M, g.N, 32, b1);
                    pg8::EpiBf16 e{(bf16_t*)(q.ws + WS_SBUF) + (size_t)NLAT * DM, DM};
                    pg8::gemm_phase((LAS unsigned char*)sm, g, so, e);
                } else post_phase(q, 0, sm, 0, NLAT / 16, b1 - 32, nb - 32);
            }
            xcd_barrier(xb);
            { PHASE_BEGIN post_phase(q, 0, sm, NLAT / 16, NROW / 16, b1, nb); }
            xcd_barrier(xb);
        } else {
            PHASE_BEGIN post_phase(q, 1, sm, 0, NLAT / 16, b1, nb);
        }
    }
}

extern "C" void kernel_launch(void* const* d_in, const int* in_sizes, int n_in, void* d_out, int out_size, void* d_ws, size_t ws_size, hipStream_t stream) {
    static int grid = 0;
    if (grid == 0) {
        if (n_in != 19 || ws_size < WS_END) { fprintf(stderr, "kernel_launch: unexpected n_in %d / ws_size %zu (need %zu)\n", n_in, ws_size, (size_t)WS_END); grid = -1; return; }
        int dev = 0, cus = 0, per_cu = 0;
        hipGetDevice(&dev);
        hipDeviceGetAttribute(&cus, hipDeviceAttributeMultiprocessorCount, dev);
        hipFuncSetAttribute((const void*)mega, hipFuncAttributeMaxDynamicSharedMemorySize, LDS_BYTES);
        hipOccupancyMaxActiveBlocksPerMultiprocessor(&per_cu, (const void*)mega, 512, LDS_BYTES);
        if (per_cu < 1) per_cu = 1;
        grid = cus * per_cu;
        fprintf(stderr, "kernel_launch: cus %d per_cu %d grid %d ws %zu need %zu\n", cus, per_cu, grid, ws_size, (size_t)WS_END);
    }
    if (grid < 0) return;
    P p{};
    const float** f = (const float**)&p;
    for (int i = 0; i < 19; ++i) f[i] = (const float*)d_in[i];
    p.out = (float*)d_out; p.ws = (unsigned char*)d_ws;
    (void)hipMemsetAsync((unsigned char*)d_ws + WS_BAR, 0, 3456 * 4, stream);
    void* args[] = {&p};
    hipError_t e = hipLaunchCooperativeKernel((const void*)mega, dim3(grid), dim3(512), args, LDS_BYTES, stream);
    if (e != hipSuccess) fprintf(stderr, "cooperative launch failed: %s (grid %d)\n", hipGetErrorString(e), grid);
}
```

```cpp
#include <hip/hip_runtime.h>
#include <hip/hip_cooperative_groups.h>
#include <cstdio>
namespace cg = cooperative_groups;

#define DI __device__ __forceinline__
#define LAS __attribute__((address_space(3)))
typedef unsigned short bf16_t;
typedef short bf16x8 __attribute__((ext_vector_type(8)));
typedef short s16x4 __attribute__((ext_vector_type(4)));
typedef float f32x4 __attribute__((ext_vector_type(4)));
typedef unsigned u32x4 __attribute__((ext_vector_type(4)));
typedef unsigned u32x2 __attribute__((ext_vector_type(2)));

constexpr int DM = 2048, NBATCH = 4, SL = 2048, CL = 256, NROW = 9216, NLAT = 8192, INW = 7216, NP = 7168, PT = 2304, NNAR = 48;
constexpr int C_GLA_Q = 0, C_GLA_K = 256, C_GLA_V = 512, C_GLA_G = 1024, C_GDN_Q = 1536, C_GDN_K = 2048, C_GDN_V = 2560,
              C_GDN_G = 3072, C_SC_B = 3584, C_SC_C = 4096, C_SC_H = 4608, C_SC_G = 5120, C_SWA_Q = 5632,
              C_SWA_K = 6144, C_SWA_V = 6400, C_SWA_G = 6656;
constexpr int G_LR = 0, G_A = 32, G_B = 40;
constexpr int LDS_BYTES = 147456;
#ifndef REP_P0
#define REP_P0 1
#endif
#ifndef REP_G1
#define REP_G1 1
#endif
#ifndef REP_PREP
#define REP_PREP 1
#endif
#ifndef REP_SCAN
#define REP_SCAN 1
#endif
#ifndef REP_GDNP
#define REP_GDNP 1
#endif
#ifndef REP_GLAP
#define REP_GLAP 1
#endif
#ifndef REP_GLAS
#define REP_GLAS 1
#endif
#ifndef REP_GDNS
#define REP_GDNS 1
#endif
#ifndef REP_SWA
#define REP_SWA 1
#endif
#ifndef REP_G2
#define REP_G2 1
#endif

constexpr size_t al256(size_t x) { return (x + 255) & ~(size_t)255; }
constexpr size_t WS_WINT = 0;
constexpr size_t WS_WOUTT = WS_WINT + al256((size_t)2 * NP * DM * 2);
constexpr size_t WS_MOD = WS_WOUTT + al256((size_t)2 * DM * DM * 2);
constexpr size_t WS_NBUF = WS_MOD + al256((size_t)2 * 5 * 6144 * 4);
constexpr size_t WS_SBUF = WS_NBUF + al256((size_t)NROW * DM * 2);
constexpr size_t WS_YBUF = WS_SBUF + al256((size_t)NROW * NP * 2);
constexpr size_t WS_HC = WS_YBUF + al256((size_t)NROW * DM * 2);
constexpr size_t WS_GLA_QT = WS_HC + al256((size_t)1024 * DM * 4);
constexpr size_t WS_GLA_KO = WS_GLA_QT + al256((size_t)32 * PT * 64 * 2);
constexpr size_t WS_GLA_AT = WS_GLA_KO + al256((size_t)32 * PT * 64 * 2);
constexpr size_t WS_GLA_DC = WS_GLA_AT + al256((size_t)32 * 72 * 32 * 32 * 2);
constexpr size_t WS_GDN_U = WS_GLA_DC + al256((size_t)32 * 72 * 64 * 4);
constexpr size_t WS_GDN_W = WS_GDN_U + al256((size_t)32 * PT * 128 * 2);
constexpr size_t WS_GDN_QI = WS_GDN_W + al256((size_t)32 * PT * 128 * 2);
constexpr size_t WS_GDN_KO = WS_GDN_QI + al256((size_t)32 * PT * 128 * 2);
constexpr size_t WS_GDN_AT = WS_GDN_KO + al256((size_t)32 * PT * 128 * 2);
constexpr size_t WS_GDN_DC = WS_GDN_AT + al256((size_t)32 * 36 * 64 * 64 * 2);
constexpr size_t WS_WNT = WS_GDN_DC + al256((size_t)32 * 36 * 4);
constexpr size_t WS_G = WS_WNT + al256((size_t)2 * NNAR * DM * 2);
constexpr size_t WS_KR = WS_G + al256((size_t)NROW * NNAR * 4);
constexpr size_t WS_BAR = WS_KR + al256((size_t)NLAT * 256 * 2);
constexpr size_t WS_END = WS_BAR + al256((size_t)3456 * 4);

struct P {
    const float *x, *c, *ctx, *c_ctx, *ada_w, *ada_b, *norm_pre, *norm_post, *w_in, *w_out, *gla_wd, *gla_bd, *gla_norm, *gdn_conv, *gdn_alog,
        *gdn_dtb, *gdn_norm, *sc_conv, *swa_sink;
    float* out;
    unsigned char* ws;
};

typedef __bf16 bf16v2 __attribute__((ext_vector_type(2)));
DI bf16_t f2bf(float f) { return __builtin_bit_cast(bf16_t, (__bf16)f); }
DI float bf2f(bf16_t b) { return __uint_as_float(((unsigned)b) << 16); }
DI unsigned pk2(float lo, float hi) { bf16v2 v = {(__bf16)lo, (__bf16)hi}; return __builtin_bit_cast(unsigned, v); }
DI float lo16(unsigned u) { return __uint_as_float(u << 16); }
DI float hi16(unsigned u) { return __uint_as_float(u & 0xFFFF0000u); }
DI void unpack8(u32x4 v, float* o) { o[0] = lo16(v.x); o[1] = hi16(v.x); o[2] = lo16(v.y); o[3] = hi16(v.y); o[4] = lo16(v.z); o[5] = hi16(v.z); o[6] = lo16(v.w); o[7] = hi16(v.w); }
DI u32x4 pack8(const float* o) { u32x4 r; r.x = pk2(o[0], o[1]); r.y = pk2(o[2], o[3]); r.z = pk2(o[4], o[5]); r.w = pk2(o[6], o[7]); return r; }
DI float siluf(float x) { return x * __builtin_amdgcn_rcpf(1.f + __expf(-x)); }
DI bf16x8 ld8(const bf16_t* p) { return *(const bf16x8*)p; }
DI bf16x8 ld4x2(const bf16_t* p0, const bf16_t* p1) {
    s16x4 a = *(const s16x4*)p0, b = *(const s16x4*)p1;
    return __builtin_shufflevector(a, b, 0, 1, 2, 3, 4, 5, 6, 7);
}
DI s16x4 trread(const bf16_t* p) { return __builtin_amdgcn_ds_read_tr16_b64_v4i16((LAS s16x4*)p); }
DI bf16x8 tr2(const bf16_t* p0, const bf16_t* p1) { s16x4 a = trread(p0), b = trread(p1); return __builtin_shufflevector(a, b, 0, 1, 2, 3, 4, 5, 6, 7); }
DI bf16x8 packacc(f32x4 a, f32x4 b) {
    u32x4 r; r.x = pk2(a[0], a[1]); r.y = pk2(a[2], a[3]); r.z = pk2(b[0], b[1]); r.w = pk2(b[2], b[3]);
    return __builtin_bit_cast(bf16x8, r);
}
DI f32x4 mfma16(bf16x8 a, bf16x8 b, f32x4 c) { return __builtin_amdgcn_mfma_f32_16x16x32_bf16(a, b, c, 0, 0, 0); }
DI float wave_sum(float v) {
#pragma unroll
    for (int o = 32; o >= 1; o >>= 1) v += __shfl_xor(v, o);
    return v;
}
DI int otid() { int t = threadIdx.x; asm volatile("" : "+v"(t)); return t; }
DI int osgpr(int v) { asm volatile("" : "+s"(v)); return v; }
DI int prow(int b, int dir, int p) {
    if (p < CL) { const int t = dir ? (CL - 1 - p) : p; return NLAT + b * CL + t; }
    const int q = p - CL; const int t = dir ? (SL - 1 - q) : q; return b * SL + t;
}

namespace pg8 {
constexpr int BM = 256, BK = 64, HALF = 128, HTB = HALF * BK * 2, NXCD = 8, WGM = 4;
DI int lds_byte(int r, int c) { const int st = (r >> 4) * 2 + (c >> 5), rr = r & 15, cc = c & 31, ob = rr * 64 + cc * 2; return st * 1024 + (ob ^ (((ob >> 9) & 1) << 5)); }
DI void stage_rc(int b, int& R, int& C) { const int st = b / 1024, sb = b % 1024, swz = sb ^ (((sb >> 9) & 1) << 5); R = (st >> 1) * 16 + swz / 64; C = (st & 1) * 32 + (swz % 64) / 2; }
DI int perm32(int rho) { const int n = rho >> 4, i = rho & 15; return 8 * (i >> 2) + 4 * n + (i & 3); }
struct Unit { int pm, pn; };
struct Gemm { const bf16_t* A; const bf16_t* Bt; int M, N, K; };
struct StaticOrder {
    int nM, nN, nwg, G, c;
    DI void init(int M, int N, int G_, int c_) { nM = M / BM; nN = N / BM; nwg = nM * nN; G = G_; c = c_; }
    DI bool next(int i, Unit& u) const {
        const long L = (long)i * G + c; if (L >= nwg) return false;
        int wgid = (int)L; { const int q = nwg / NXCD, r = nwg % NXCD, xcd = wgid % NXCD, off = wgid / NXCD; wgid = (xcd < r ? xcd * (q + 1) : r * (q + 1) + (xcd - r) * q) + off; }
        const int nig = WGM * nN, gid = wgid / nig, fm = gid * WGM, gsz = (nM - fm) < WGM ? (nM - fm) : WGM;
        u.pm = fm + ((wgid % nig) % gsz); u.pn = (wgid % nig) / gsz; return true;
    }
};
struct EpiBf16 {
    bf16_t* O; int ldc;
    DI void operator()(const f32x4 (&acc)[2][2][4][2], const Unit& u, int wr, int wc, int fr, int fq) const {
        const int row0 = u.pm * BM + wr * 64 + fr; const int col0 = u.pn * BM + wc * 32 + 8 * fq;
#pragma unroll
        for (int ai = 0; ai < 2; ++ai)
#pragma unroll
            for (int m = 0; m < 4; ++m) { bf16_t* rowp = O + (size_t)(row0 + ai * HALF + m * 16) * ldc + col0;
#pragma unroll
                for (int bj = 0; bj < 2; ++bj) { const f32x4 v0 = acc[ai][bj][m][0], v1 = acc[ai][bj][m][1];
                    u32x4 w; w.x = pk2(v0[0], v0[1]); w.y = pk2(v0[2], v0[3]); w.z = pk2(v1[0], v1[1]); w.w = pk2(v1[2], v1[3]);
                    *(u32x4*)(rowp + bj * HALF) = w; } }
    }
};

DI void gemm_phase(LAS unsigned char* lds, const Gemm g, const StaticOrder& S, const EpiBf16& E) {
    const int tid = otid(), wid = __builtin_amdgcn_readfirstlane(tid >> 6), lane = tid & 63, wr = wid >> 2, wc = wid & 3, fr = lane & 15, fq = lane >> 4;
    const int K = g.K, nt = K / BK;
    unsigned voffA[2], voffB[2];
#pragma unroll
    for (int i = 0; i < 2; ++i) { int R, C; stage_rc(tid * 16 + i * 8192, R, C); const int Rb = (R & ~31) + perm32(R & 31);
        voffA[i] = (unsigned)(R * K + C) * 2u; voffB[i] = (unsigned)(Rb * K + C) * 2u; }
    const size_t kstep = (size_t)(BK * 2);
    const size_t hstep = (size_t)HALF * K * 2;
    const size_t tstep = 2 * hstep;
    const unsigned ldsw = (unsigned)wid * 1024u;
    const int aoff = lds_byte(wr * 64 + fr, fq * 8), boff = lds_byte(wc * 32 + fr, fq * 8);
#define PG8_SA(b, h) (((b) * 2 + (h)) * HTB)
#define PG8_SB(b, h) ((4 + (b) * 2 + (h)) * HTB)
#define PG8_STAGE(bufoff, gbase, voff) do { _Pragma("unroll") for (int _i = 0; _i < 2; ++_i) \
        __builtin_amdgcn_global_load_lds((const unsigned*)((const char*)(gbase) + (voff)[_i]), (LAS unsigned*)(lds + (bufoff) + ldsw + _i * 8192), 16, 0, 0); } while (0)
#define PG8_LDA(dst, b, h) do { _Pragma("unroll") for (int m = 0; m < 4; ++m) _Pragma("unroll") for (int k = 0; k < 2; ++k) dst[m][k] = *(const LAS bf16x8*)(lds + PG8_SA(b, h) + aoff + m * 2048 + k * 1024); } while (0)
#define PG8_LDB(dst, b, h) do { _Pragma("unroll") for (int n = 0; n < 2; ++n) _Pragma("unroll") for (int k = 0; k < 2; ++k) dst[n][k] = *(const LAS bf16x8*)(lds + PG8_SB(b, h) + boff + n * 2048 + k * 1024); } while (0)
#define PG8_MMA(ai, bj, At, Bt) do { __builtin_amdgcn_s_setprio(1); _Pragma("unroll") for (int m = 0; m < 4; ++m) _Pragma("unroll") for (int n = 0; n < 2; ++n) _Pragma("unroll") for (int k = 0; k < 2; ++k) \
        acc[ai][bj][m][n] = __builtin_amdgcn_mfma_f32_16x16x32_bf16(Bt[n][k], At[m][k], acc[ai][bj][m][n], 0, 0, 0); __builtin_amdgcn_s_setprio(0); } while (0)
#define PG8_WAIT_V(n) asm volatile("s_waitcnt vmcnt(" #n ")" ::: "memory")
#define PG8_WAIT_L(n) asm volatile("s_waitcnt lgkmcnt(" #n ")" ::: "memory")
#define PG8_BAR __builtin_amdgcn_s_barrier()
#define PG8_SCHED __builtin_amdgcn_sched_barrier(0)
    Unit cur, nxt; int ui = 0;
    if (!S.next(0, cur)) return;
    f32x4 acc[2][2][4][2];
#pragma unroll
    for (int a = 0; a < 2; ++a)
#pragma unroll
        for (int b = 0; b < 2; ++b)
#pragma unroll
            for (int m = 0; m < 4; ++m)
#pragma unroll
                for (int n = 0; n < 2; ++n) acc[a][b][m][n] = (f32x4){0.f, 0.f, 0.f, 0.f};
    bf16x8 At[4][2], B0[2][2], B1[2][2];
    const char* cA = (const char*)g.A + (size_t)cur.pm * tstep; const char* cB = (const char*)g.Bt + (size_t)cur.pn * tstep;
    PG8_STAGE(PG8_SB(0, 0), cB, voffB); PG8_STAGE(PG8_SA(0, 0), cA, voffA); PG8_STAGE(PG8_SB(0, 1), cB + hstep, voffB); PG8_STAGE(PG8_SA(0, 1), cA + hstep, voffA);
    if (wr == 1) PG8_BAR;
    PG8_WAIT_V(4); PG8_BAR;
    PG8_STAGE(PG8_SB(1, 0), cB + kstep, voffB); PG8_STAGE(PG8_SA(1, 0), cA + kstep, voffA); PG8_STAGE(PG8_SB(1, 1), cB + hstep + kstep, voffB);
    PG8_WAIT_V(6); PG8_BAR;
    for (;;) {
        const bool has_next = S.next(ui + 1, nxt);
        const char* nA = has_next ? (const char*)g.A + (size_t)nxt.pm * tstep : cA; const char* nB = has_next ? (const char*)g.Bt + (size_t)nxt.pn * tstep : cB;
        for (int t = 0; t < nt; t += 2) {
            const bool last = (t == nt - 2);
            const char* a1 = cA + (size_t)(t + 1) * kstep;
            const char* a2 = last ? nA : cA + (size_t)(t + 2) * kstep; const char* b2 = last ? nB : cB + (size_t)(t + 2) * kstep;
            const char* a3 = a2 + kstep; const char* b3 = b2 + kstep;
            PG8_LDB(B0, 0, 0); PG8_SCHED; PG8_LDA(At, 0, 0); PG8_STAGE(PG8_SA(1, 1), a1 + hstep, voffA);
            PG8_WAIT_L(8); PG8_BAR; PG8_WAIT_L(0); PG8_MMA(0, 0, At, B0); PG8_BAR; PG8_SCHED;
            PG8_LDB(B1, 0, 1); PG8_STAGE(PG8_SB(0, 0), b2, voffB);
            PG8_BAR; PG8_WAIT_L(0); PG8_MMA(0, 1, At, B1); PG8_BAR;
            PG8_LDA(At, 0, 1); PG8_STAGE(PG8_SA(0, 0), a2, voffA);
            PG8_BAR; PG8_WAIT_L(0); PG8_MMA(1, 0, At, B0); PG8_BAR; PG8_SCHED;
            PG8_STAGE(PG8_SB(0, 1), b2 + hstep, voffB);
            PG8_WAIT_V(6); PG8_BAR; PG8_MMA(1, 1, At, B1); PG8_BAR;
            PG8_LDB(B0, 1, 0); PG8_SCHED; PG8_LDA(At, 1, 0); PG8_STAGE(PG8_SA(0, 1), a2 + hstep, voffA);
            PG8_WAIT_L(8); PG8_BAR; PG8_WAIT_L(0); PG8_MMA(0, 0, At, B0); PG8_BAR; PG8_SCHED;
            PG8_LDB(B1, 1, 1); PG8_STAGE(PG8_SB(1, 0), b3, voffB);
            PG8_BAR; PG8_WAIT_L(0); PG8_MMA(0, 1, At, B1); PG8_BAR;
            PG8_LDA(At, 1, 1); PG8_STAGE(PG8_SA(1, 0), a3, voffA);
            PG8_BAR; PG8_WAIT_L(0); PG8_MMA(1, 0, At, B0); PG8_BAR; PG8_SCHED;
            PG8_STAGE(PG8_SB(1, 1), b3 + hstep, voffB);
            PG8_WAIT_V(6); PG8_BAR; PG8_MMA(1, 1, At, B1); PG8_BAR;
        }
        E(acc, cur, wr, wc, fr, fq);
        if (!has_next) break;
#pragma unroll
        for (int a = 0; a < 2; ++a)
#pragma unroll
            for (int b = 0; b < 2; ++b)
#pragma unroll
                for (int m = 0; m < 4; ++m)
#pragma unroll
                    for (int n = 0; n < 2; ++n) acc[a][b][m][n] = (f32x4){0.f, 0.f, 0.f, 0.f};
        cur = nxt; cA = nA; cB = nB; ++ui;
    }
    PG8_WAIT_V(0);
    if (wr == 0) PG8_BAR;
    PG8_BAR;
#undef PG8_SA
#undef PG8_SB
#undef PG8_STAGE
#undef PG8_LDA
#undef PG8_LDB
#undef PG8_MMA
#undef PG8_WAIT_V
#undef PG8_WAIT_L
#undef PG8_BAR
#undef PG8_SCHED
}
}

DI void adaln_item(const P& p, int a, unsigned char* smem) {
    float* sc = (float*)smem;
    float* red = sc + 5 * 2048;
    float* mod = (float*)(p.ws + WS_MOD);
    const int tid = otid();
    for (int e = tid; e < 5 * 2048; e += 512) { const int r = e >> 11, k = e & 2047; const float v = r < 4 ? p.c[r * 2048 + k] : p.c_ctx[k]; sc[e] = siluf(v); }
    __syncthreads();
    const int l = a / 96, j0 = (a % 96) * 64, cg4 = (tid & 15) * 4, kg = tid >> 4;
    const float* w = p.ada_w + (size_t)l * 2048 * 6144 + j0 + cg4;
    f32x4 acc[5];
#pragma unroll
    for (int r = 0; r < 5; ++r) acc[r] = (f32x4){0.f, 0.f, 0.f, 0.f};
#pragma unroll 1
    for (int i0 = 0; i0 < 64; i0 += 16) {
        f32x4 wv[16];
#pragma unroll
        for (int i = 0; i < 16; ++i) wv[i] = __builtin_nontemporal_load((const f32x4*)(w + (size_t)(kg + 32 * (i0 + i)) * 6144));
#pragma unroll
        for (int i = 0; i < 16; ++i) {
            const int k = kg + 32 * (i0 + i);
#pragma unroll
            for (int r = 0; r < 5; ++r) acc[r] += wv[i] * sc[r * 2048 + k];
        }
    }
#pragma unroll
    for (int r = 0; r < 5; ++r) *(f32x4*)(red + (kg * 5 + r) * 64 + cg4) = acc[r];
    __syncthreads();
    if (tid < 320) {
        const int r = tid >> 6, tx = tid & 63; float sum = 0.f;
#pragma unroll
        for (int k2 = 0; k2 < 32; ++k2) sum += red[(k2 * 5 + r) * 64 + tx];
        mod[(l * 5 + r) * 6144 + j0 + tx] = sum + p.ada_b[l * 6144 + j0 + tx];
    }
    __syncthreads();
}

DI void transpose_item(const float* src, int ld, int srcoff, bf16_t* dst, int kt, int nt, unsigned char* smem) {
    float* tile = (float*)smem;
    const int tid = otid();
#pragma unroll
    for (int i = 0; i < 8; ++i) {
        const int kr = (tid >> 6) + 8 * i, nc = (tid & 63) * 4;
        const f32x4 v = __builtin_nontemporal_load((const f32x4*)(src + (size_t)(kt * 64 + kr) * ld + srcoff + nt * 256 + nc));
        tile[kr * 257 + nc + 0] = v[0]; tile[kr * 257 + nc + 1] = v[1]; tile[kr * 257 + nc + 2] = v[2]; tile[kr * 257 + nc + 3] = v[3];
    }
    __syncthreads();
    {
        const int n = tid >> 1, k0 = (tid & 1) * 32;
#pragma unroll
        for (int k8 = 0; k8 < 4; ++k8) {
            float o[8];
#pragma unroll
            for (int j = 0; j < 8; ++j) o[j] = tile[(k0 + 8 * k8 + j) * 257 + n];
            *(u32x4*)(dst + (size_t)(nt * 256 + n) * 2048 + kt * 64 + k0 + 8 * k8) = pack8(o);
        }
    }
    __syncthreads();
}
DI void narrow_item(const float* src, bf16_t* dst, int kt) {
    const int tid = otid();
#pragma unroll
    for (int j = 0; j < 6; ++j) {
        const int e = tid + 512 * j, kr = e / 48, cn = e % 48;
        const int sc = cn < 32 ? 1024 + cn : 3104 + (cn - 32);
        dst[(size_t)cn * 2048 + kt * 64 + kr] = f2bf(src[(size_t)(kt * 64 + kr) * INW + sc]);
    }
}
DI void skinny_tile(const P& p, int l, int r0, float* red) {
    const bf16_t* A = (const bf16_t*)(p.ws + WS_NBUF);
    const bf16_t* Bt = (const bf16_t*)(p.ws + WS_WNT) + (size_t)l * NNAR * DM;
    float* G = (float*)(p.ws + WS_G);
    const int tid = otid(), w = tid >> 6, lane = tid & 63, l15 = lane & 15, g = lane >> 4;
    f32x4 acc[3];
#pragma unroll
    for (int n = 0; n < 3; ++n) acc[n] = (f32x4){0.f, 0.f, 0.f, 0.f};
    const bf16_t* ap = A + (size_t)(r0 + l15) * DM + 256 * w + 8 * g;
    const bf16_t* bp = Bt + (size_t)l15 * DM + 256 * w + 8 * g;
#pragma unroll
    for (int ks = 0; ks < 8; ++ks) {
        const bf16x8 a0 = *(const bf16x8*)(ap + 32 * ks);
#pragma unroll
        for (int n = 0; n < 3; ++n) acc[n] = mfma16(a0, *(const bf16x8*)(bp + (size_t)16 * n * DM + 32 * ks), acc[n]);
    }
#pragma unroll
    for (int n = 0; n < 3; ++n)
#pragma unroll
        for (int r = 0; r < 4; ++r) red[w * 768 + (4 * g + r) * 48 + 16 * n + l15] = acc[n][r];
    __syncthreads();
    for (int e = tid; e < 768; e += 512) {
        float sum = 0.f;
#pragma unroll
        for (int k = 0; k < 8; ++k) sum += red[k * 768 + e];
        G[(size_t)r0 * NNAR + e] = sum;
    }
    __syncthreads();
}

DI void norm0_phase(const P& p, unsigned char* smem) {
    const int tid = otid(); const int wave = tid >> 6, lane = tid & 63;
    const float* mod = (const float*)(p.ws + WS_MOD);
    bf16_t* nb = (bf16_t*)(p.ws + WS_NBUF);
    for (int rt = osgpr(blockIdx.x); rt < NROW / 16; rt += gridDim.x) {
      for (int rr = 0; rr < 2; ++rr) {
        const int row = rt * 16 + wave * 2 + rr;
        const float* h = row < NLAT ? p.x + (size_t)row * DM : p.ctx + (size_t)(row - NLAT) * DM;
        const int mr = row < NLAT ? (row >> 11) : 4;
        f32x4 v[8]; float ss = 0.f;
#pragma unroll
        for (int i = 0; i < 8; ++i) { v[i] = __builtin_nontemporal_load((const f32x4*)(h + i * 256 + lane * 4)); ss += v[i][0] * v[i][0] + v[i][1] * v[i][1] + v[i][2] * v[i][2] + v[i][3] * v[i][3]; }
        ss = wave_sum(ss);
        const float rstd = rsqrtf(ss * (1.f / 2048.f) + 1e-6f);
        const float* md = mod + (size_t)mr * 6144;
#pragma unroll
        for (int i = 0; i < 8; ++i) {
            const int j = i * 256 + lane * 4;
            const f32x4 gw = *(const f32x4*)(p.norm_pre + j), sh = *(const f32x4*)(md + j), scl = *(const f32x4*)(md + 2048 + j);
            float o[4];
#pragma unroll
            for (int e = 0; e < 4; ++e) o[e] = v[i][e] * rstd * gw[e] * (1.f + scl[e]) + sh[e];
            u32x2 w; w.x = pk2(o[0], o[1]); w.y = pk2(o[2], o[3]);
            *(u32x2*)(nb + (size_t)row * DM + j) = w;
        }
      }
      asm volatile("s_waitcnt vmcnt(0)" ::: "memory"); __syncthreads();
      skinny_tile(p, 0, rt * 16, (float*)smem);
    }
}

DI void post_phase(const P& p, int l, unsigned char* smem, int t0, int t1, int bstart, int bstride) {
    const int tid = otid(); const int wave = tid >> 6, lane = tid & 63;
    const float* mod = (const float*)(p.ws + WS_MOD);
    bf16_t* nb = (bf16_t*)(p.ws + WS_NBUF);
    const bf16_t* yo = (const bf16_t*)(p.ws + WS_SBUF);
    float* hc = (float*)(p.ws + WS_HC);
    for (int rt = t0 + osgpr(bstart); rt < t1; rt += bstride) {
      for (int rr = 0; rr < 2; ++rr) {
        const int row = rt * 16 + wave * 2 + rr;
        const int mr = row < NLAT ? (row >> 11) : 4;
        const float* h = l == 0 ? (row < NLAT ? p.x + (size_t)row * DM : p.ctx + (size_t)(row - NLAT) * DM) : p.out + (size_t)row * DM;
        float* hdst = row < NLAT ? p.out + (size_t)row * DM : hc + (size_t)(row - NLAT) * DM;
        f32x4 y[8]; float ss = 0.f;
#pragma unroll
        for (int i = 0; i < 8; ++i) {
            const u32x2 w = __builtin_nontemporal_load((const u32x2*)(yo + (size_t)row * DM + i * 256 + lane * 4));
            y[i] = (f32x4){lo16(w.x), hi16(w.x), lo16(w.y), hi16(w.y)};
            ss += y[i][0] * y[i][0] + y[i][1] * y[i][1] + y[i][2] * y[i][2] + y[i][3] * y[i][3];
        }
        ss = wave_sum(ss);
        const float rstd = rsqrtf(ss * (1.f / 2048.f) + 1e-6f);
        const float* md = mod + (size_t)(l * 5 + mr) * 6144;
        float ss2 = 0.f;
#pragma unroll
        for (int i = 0; i < 8; ++i) {
            const int j = i * 256 + lane * 4;
            const f32x4 hv = __builtin_nontemporal_load((const f32x4*)(h + j)), gt = *(const f32x4*)(md + 4096 + j), nw = *(const f32x4*)(p.norm_post + l * DM + j);
#pragma unroll
            for (int e = 0; e < 4; ++e) { y[i][e] = hv[e] + gt[e] * (y[i][e] * rstd * nw[e]); ss2 += y[i][e] * y[i][e]; }
            __builtin_nontemporal_store(y[i], (f32x4*)(hdst + j));
        }
        if (l == 0) {
            ss2 = wave_sum(ss2);
            const float rstd2 = rsqrtf(ss2 * (1.f / 2048.f) + 1e-6f);
            const float* md1 = mod + (size_t)(5 + mr) * 6144;
#pragma unroll
            for (int i = 0; i < 8; ++i) {
                const int j = i * 256 + lane * 4;
                const f32x4 gw = *(const f32x4*)(p.norm_pre + DM + j), sh = *(const f32x4*)(md1 + j), scl = *(const f32x4*)(md1 + 2048 + j);
                float o[4];
#pragma unroll
                for (int e = 0; e < 4; ++e) o[e] = y[i][e] * rstd2 * gw[e] * (1.f + scl[e]) + sh[e];
                u32x2 w; w.x = pk2(o[0], o[1]); w.y = pk2(o[2], o[3]);
                *(u32x2*)(nb + (size_t)row * DM + j) = w;
            }
        }
      }
      if (l == 0) { asm volatile("s_waitcnt vmcnt(0)" ::: "memory"); __syncthreads(); skinny_tile(p, 1, rt * 16, (float*)smem); }
    }
}

DI void conv_item(const P& p, int l, int r32) {
    const bf16_t* S = (const bf16_t*)(p.ws + WS_SBUF);
    bf16_t* Y = (bf16_t*)(p.ws + WS_YBUF);
    const int tid = otid(); const int row0 = r32 * 32 + (tid >> 6) * 4, ch = (tid & 63) * 8;
    int t0, len;
    if (row0 < NLAT) { t0 = row0 & 2047; len = SL; } else { t0 = (row0 - NLAT) & 255; len = CL; }
    u32x4 rc[6], rh[6], rb[4], rg[4];
#pragma unroll
    for (int k = 0; k < 6; ++k) {
        int tt = t0 + k - 1; const int tcl = tt < 0 ? 0 : (tt >= len ? len - 1 : tt);
        const bf16_t* rp = S + (size_t)(row0 + (tcl - t0)) * NP;
        rc[k] = __builtin_nontemporal_load((const u32x4*)(rp + C_SC_C + ch)); rh[k] = __builtin_nontemporal_load((const u32x4*)(rp + C_SC_H + ch));
    }
#pragma unroll
    for (int k = 0; k < 4; ++k) { const bf16_t* rp = S + (size_t)(row0 + k) * NP; rb[k] = __builtin_nontemporal_load((const u32x4*)(rp + C_SC_B + ch)); rg[k] = __builtin_nontemporal_load((const u32x4*)(rp + C_SC_G + ch)); }
    f32x4 w0[3], w1[3];
#pragma unroll
    for (int j = 0; j < 3; ++j) { const float* w = p.sc_conv + (size_t)(l * 3 + j) * 512 + ch; w0[j] = *(const f32x4*)w; w1[j] = *(const f32x4*)(w + 4); }
    float prod[6][8];
#pragma unroll
    for (int k = 0; k < 6; ++k) {
        const int tt = t0 + k - 1; const float msk = (tt >= 0 && tt < len) ? 1.f : 0.f;
        float cc[8], hh[8]; unpack8(rc[k], cc); unpack8(rh[k], hh);
#pragma unroll
        for (int e = 0; e < 8; ++e) prod[k][e] = cc[e] * hh[e] * msk;
    }
#pragma unroll
    for (int k = 0; k < 4; ++k) {
        float bb[8], gg[8], o[8]; unpack8(rb[k], bb); unpack8(rg[k], gg);
#pragma unroll
        for (int e = 0; e < 8; ++e) {
            const float wa = e < 4 ? w0[0][e & 3] : w1[0][e & 3], wb = e < 4 ? w0[1][e & 3] : w1[1][e & 3], wc = e < 4 ? w0[2][e & 3] : w1[2][e & 3];
            const float acc = wa * prod[k][e] + wb * prod[k + 1][e] + wc * prod[k + 2][e];
            o[e] = bb[e] * acc * siluf(gg[e]);
        }
        *(u32x4*)(Y + (size_t)(row0 + k) * DM + 1024 + ch) = pack8(o);
    }
}

DI void finish_item(const P& p, int l, int r16) {
    const bf16_t* S = (const bf16_t*)(p.ws + WS_SBUF);
    bf16_t* Y = (bf16_t*)(p.ws + WS_YBUF);
    const bf16_t* O = (const bf16_t*)(p.ws + WS_NBUF);
    const int tid = otid(); const int row0 = r16 * 16 + (tid >> 7) * 4, u = tid & 127, mx = u >> 6, hh = (u >> 4) & 3, sub = u & 15;
    const int chn = 128 * hh + 8 * sub;
    u32x4 ra[4], rb[4], rg[4];
#pragma unroll
    for (int k = 0; k < 4; ++k) {
        ra[k] = __builtin_nontemporal_load((const u32x4*)(O + ((size_t)(mx * 2 + 0) * NROW + row0 + k) * 512 + chn));
        rb[k] = __builtin_nontemporal_load((const u32x4*)(O + ((size_t)(mx * 2 + 1) * NROW + row0 + k) * 512 + chn));
        rg[k] = __builtin_nontemporal_load((const u32x4*)(S + (size_t)(row0 + k) * NP + (mx ? C_GDN_G : C_GLA_G) + chn));
    }
    const float* nwp = (mx ? p.gdn_norm : p.gla_norm) + l * 128 + 8 * sub;
    const f32x4 nw0 = *(const f32x4*)nwp, nw1 = *(const f32x4*)(nwp + 4);
#pragma unroll
    for (int k = 0; k < 4; ++k) {
        float a[8], b[8], o[8], gt[8];
        unpack8(ra[k], a); unpack8(rb[k], b); unpack8(rg[k], gt);
        float ss = 0.f;
#pragma unroll
        for (int e = 0; e < 8; ++e) { o[e] = a[e] + b[e]; ss += o[e] * o[e]; }
        ss += __shfl_xor(ss, 1); ss += __shfl_xor(ss, 2); ss += __shfl_xor(ss, 4); ss += __shfl_xor(ss, 8);
        const float rstd = rsqrtf(ss * (1.f / 128.f) + 1e-6f);
#pragma unroll
        for (int e = 0; e < 8; ++e) o[e] = o[e] * rstd * (e < 4 ? nw0[e & 3] : nw1[e & 3]) * siluf(gt[e]);
        *(u32x4*)(Y + (size_t)(row0 + k) * DM + 512 * mx + chn) = pack8(o);
    }
}

DI void gla_prep_item(const P& p, int l, int item, unsigned char* smem) {
    const int c = item % 72, bd = item / 72, dir = bd & 1, b = bd >> 1;
    float* slr = (float*)smem;
    float* stot = slr + 512;
    float* slast = stot + 256;
    bf16_t* sq = (bf16_t*)(slast + 256);
    bf16_t* sk = sq + 4 * 32 * 72;
    const bf16_t* S = (const bf16_t*)(p.ws + WS_SBUF);
    bf16_t* QT = (bf16_t*)(p.ws + WS_GLA_QT); bf16_t* KO = (bf16_t*)(p.ws + WS_GLA_KO); bf16_t* AT = (bf16_t*)(p.ws + WS_GLA_AT); float* DC = (float*)(p.ws + WS_GLA_DC);
    const int tid = otid();
    { const int i = tid >> 4, r = tid & 15; slr[i * 16 + r] = ((const float*)(p.ws + WS_G))[(size_t)prow(b, dir, 32 * c + i) * NNAR + G_LR + 16 * dir + r]; }
    __syncthreads();
    const int cch = tid & 255, half = tid >> 8, h = cch >> 6, d = cch & 63;
    bf16_t qraw[16], kraw[16];
#pragma unroll
    for (int ii = 0; ii < 16; ++ii) { const size_t row = (size_t)prow(b, dir, 32 * c + 16 * half + ii); qraw[ii] = S[row * NP + C_GLA_Q + cch]; kraw[ii] = S[row * NP + C_GLA_K + cch]; }
    float wd[16];
#pragma unroll
    for (int r = 0; r < 16; ++r) wd[r] = p.gla_wd[((size_t)(l * 2 + dir) * 16 + r) * 256 + cch];
    const float bdv = p.gla_bd[(l * 2 + dir) * 256 + cch];
    float cum[16]; float run = 0.f;
#pragma unroll
    for (int ii = 0; ii < 16; ++ii) {
        const int i = 16 * half + ii; float z = bdv;
#pragma unroll
        for (int r = 0; r < 16; ++r) z += slr[i * 16 + r] * wd[r];
        const float ls = fminf(z, 0.f) - __logf(1.f + __expf(-fabsf(z)));
        run += ls * (1.f / 16.f); cum[ii] = run;
    }
    if (half == 0) stot[cch] = run;
    __syncthreads();
    if (half == 1) { const float t = stot[cch];
#pragma unroll
        for (int ii = 0; ii < 16; ++ii) cum[ii] += t;
        slast[cch] = cum[15]; }
    __syncthreads();
    const float cl = slast[cch];
    const int seq = (dir * 4 + b) * 4 + h;
#pragma unroll
    for (int ii = 0; ii < 16; ++ii) {
        const int i = 16 * half + ii, pp = 32 * c + i;
        const float q = bf2f(qraw[ii]) * 0.125f, k = bf2f(kraw[ii]);
        const float qt = q * __expf(cum[ii]), kt = k * __expf(-cum[ii]), ko = k * __expf(cl - cum[ii]);
        QT[((size_t)seq * PT + pp) * 64 + d] = f2bf(qt); KO[((size_t)seq * PT + pp) * 64 + d] = f2bf(ko);
        sq[(h * 32 + i) * 72 + d] = f2bf(qt); sk[(h * 32 + i) * 72 + d] = f2bf(kt);
    }
    if (half == 0) DC[((size_t)seq * 72 + c) * 64 + d] = __expf(cl);
    __syncthreads();
    {
        const int w = tid >> 6, lane = tid & 63, l15 = lane & 15, g = lane >> 4, hh = w >> 1, mt = w & 1;
        const int seqh = (dir * 4 + b) * 4 + hh;
#pragma unroll
        for (int nt = 0; nt < 2; ++nt) {
            f32x4 acc = (f32x4){0.f, 0.f, 0.f, 0.f};
#pragma unroll
            for (int ks = 0; ks < 2; ++ks) {
                const bf16x8 a = ld8(sq + (hh * 32 + 16 * mt + l15) * 72 + 32 * ks + 8 * g), bb = ld8(sk + (hh * 32 + 16 * nt + l15) * 72 + 32 * ks + 8 * g);
                acc = mfma16(bb, a, acc);
            }
            const int i = 16 * mt + l15, j0 = 16 * nt + 4 * g;
            u32x2 ov; ov.x = pk2(j0 <= i ? acc[0] : 0.f, j0 + 1 <= i ? acc[1] : 0.f); ov.y = pk2(j0 + 2 <= i ? acc[2] : 0.f, j0 + 3 <= i ? acc[3] : 0.f);
            *(u32x2*)(AT + (((size_t)seqh * 72 + c) * 32 + i) * 32 + j0) = ov;
        }
    }
    __syncthreads();
}

struct GlaRegs { u32x4 rv, rq, ra; float rd; };
DI void gla_scan_item(const P& p, int seq, unsigned char* smem) {
    const int dir = seq >> 4, b = (seq >> 2) & 3, h = seq & 3;
    constexpr int BUFB = 20736;
    const bf16_t* S = (const bf16_t*)(p.ws + WS_SBUF);
    const bf16_t* QT = (const bf16_t*)(p.ws + WS_GLA_QT); const bf16_t* KO = (const bf16_t*)(p.ws + WS_GLA_KO); const bf16_t* AT = (const bf16_t*)(p.ws + WS_GLA_AT); const float* DC = (const float*)(p.ws + WS_GLA_DC);
    bf16_t* OG = (bf16_t*)(p.ws + WS_NBUF) + (size_t)dir * NROW * 512;
    const int tid = otid(), w = tid >> 6, lane = tid & 63, l15 = lane & 15, g = lane >> 4, q4 = l15 >> 2, p4 = l15 & 3;
    auto loadr = [&](GlaRegs& R, int c) {
        if (c >= 72) return;
        { const int pos = tid >> 4, ch = tid & 15; R.rv = *(const u32x4*)(S + (size_t)prow(b, dir, 32 * c + pos) * NP + C_GLA_V + 128 * h + 8 * ch); }
        { const int t2 = tid & 255, pos = t2 >> 3, ch = t2 & 7; const bf16_t* src = (tid < 256 ? QT : KO) + ((size_t)seq * PT + 32 * c + pos) * 64 + 8 * ch; R.rq = __builtin_nontemporal_load((const u32x4*)src); }
        if (tid < 128) { const int i = tid >> 2, ch = tid & 3; R.ra = __builtin_nontemporal_load((const u32x4*)(AT + (((size_t)seq * 72 + c) * 32 + i) * 32 + 8 * ch)); }
        if (tid >= 128 && tid < 192) R.rd = DC[((size_t)seq * 72 + c) * 64 + (tid - 128)];
    };
    auto storel = [&](const GlaRegs& R, int buf) {
        unsigned char* base = smem + buf * BUFB;
        bf16_t* sat = (bf16_t*)base; bf16_t* sqt = (bf16_t*)(base + 2560); bf16_t* sko = (bf16_t*)(base + 2560 + 4608); bf16_t* sv = (bf16_t*)(base + 2560 + 9216); float* sdc = (float*)(base + 2560 + 9216 + 8704);
        { const int pos = tid >> 4, ch = tid & 15; *(u32x4*)(sv + pos * 136 + 8 * ch) = R.rv; }
        { const int t2 = tid & 255, pos = t2 >> 3, ch = t2 & 7; *(u32x4*)((tid < 256 ? sqt : sko) + pos * 72 + 8 * ch) = R.rq; }
        if (tid < 128) { const int i = tid >> 2, ch = tid & 3; *(u32x4*)(sat + i * 40 + 8 * ch) = R.ra; }
        if (tid >= 128 && tid < 192) sdc[tid - 128] = R.rd;
    };
    f32x4 st[4];
#pragma unroll
    for (int i = 0; i < 4; ++i) st[i] = (f32x4){0.f, 0.f, 0.f, 0.f};
    const int sgn = dir ? -1 : 1;
    auto compute = [&](int c) {
        const unsigned char* base = smem + (c & 1) * BUFB;
        const bf16_t* sat = (const bf16_t*)base; const bf16_t* sqt = (const bf16_t*)(base + 2560); const bf16_t* sko = (const bf16_t*)(base + 2560 + 4608); const bf16_t* sv = (const bf16_t*)(base + 2560 + 9216); const float* sdc = (const float*)(base + 2560 + 9216 + 8704);
        const int dv0 = 16 * w;
        const bf16x8 vb = tr2(sv + (8 * g + q4) * 136 + dv0 + 4 * p4, sv + (8 * g + 4 + q4) * 136 + dv0 + 4 * p4);
        bf16x8 bs[2];
        bs[0] = packacc(st[0], st[1]); bs[1] = packacc(st[2], st[3]);
#pragma unroll
        for (int mt = 0; mt < 2; ++mt) {
            f32x4 acc = (f32x4){0.f, 0.f, 0.f, 0.f};
            acc = mfma16(vb, ld8(sat + (16 * mt + l15) * 40 + 8 * g), acc);
#pragma unroll
            for (int ks = 0; ks < 2; ++ks) {
                const bf16_t* r0 = sqt + (16 * mt + l15) * 72 + 32 * ks + 4 * g;
                acc = mfma16(bs[ks], ld4x2(r0, r0 + 16), acc);
            }
            bf16_t* ob = OG + (size_t)prow(b, dir, 32 * c) * 512 + 128 * h;
            u32x2 ov; ov.x = pk2(acc[0], acc[1]); ov.y = pk2(acc[2], acc[3]);
            *(u32x2*)(ob + sgn * ((16 * mt + l15) * 512) + dv0 + 4 * g) = ov;
        }
#pragma unroll
        for (int dt = 0; dt < 4; ++dt) {
            const bf16x8 ak = tr2(sko + (8 * g + q4) * 72 + 16 * dt + 4 * p4, sko + (8 * g + 4 + q4) * 72 + 16 * dt + 4 * p4);
#pragma unroll
            for (int r = 0; r < 4; ++r) st[dt][r] *= sdc[16 * dt + 4 * g + r];
            st[dt] = mfma16(ak, vb, st[dt]);
        }
    };
    GlaRegs R0, R1, R2, R3, R4, R5;
    loadr(R0, 0); loadr(R1, 1); loadr(R2, 2); loadr(R3, 3); loadr(R4, 4); loadr(R5, 5);
#pragma unroll 1
    for (int c = 0; c < 72; c += 6) {
        storel(R0, 0); __syncthreads(); loadr(R0, c + 6); compute(c);
        storel(R1, 1); __syncthreads(); loadr(R1, c + 7); compute(c + 1);
        storel(R2, 0); __syncthreads(); loadr(R2, c + 8); compute(c + 2);
        storel(R3, 1); __syncthreads(); loadr(R3, c + 9); compute(c + 3);
        storel(R4, 0); __syncthreads(); loadr(R4, c + 10); compute(c + 4);
        storel(R5, 1); __syncthreads(); loadr(R5, c + 11); compute(c + 5);
    }
    __syncthreads();
}

DI void gdn_conv16(const bf16_t* raw, const float* cw, int ti, int cch, float* out) {
#pragma unroll
    for (int e = 0; e < 16; ++e) out[e] = 0.f;
#pragma unroll 1
    for (int j = 0; j < 5; ++j) {
        const bf16_t* rp = raw + (ti + j) * 392 + cch;
        float xv[16];
        unpack8(*(const u32x4*)rp, xv); unpack8(*(const u32x4*)(rp + 8), xv + 8);
        const float* w = cw + j * 384 + cch;
#pragma unroll
        for (int e4 = 0; e4 < 4; ++e4) { const f32x4 wv = *(const f32x4*)(w + 4 * e4);
#pragma unroll
            for (int e = 0; e < 4; ++e) out[4 * e4 + e] += wv[e] * xv[4 * e4 + e]; }
    }
#pragma unroll
    for (int e = 0; e < 16; ++e) out[e] = siluf(out[e]);
}

DI f32x4 mfma4(float a, float b, f32x4 c) { return __builtin_amdgcn_mfma_f32_16x16x4f32(a, b, c, 0, 0, 0); }

DI void gdn_prep_item(const P& p, int l, int item, unsigned char* smem) {
    const int sc = item % 36, bh = item / 36, h = bh & 3, b = bh >> 2;
    constexpr int LS = 68;
    bf16_t* sK = (bf16_t*)smem;
    bf16_t* sKB = sK + 64 * 136;
    bf16_t* sQ = sKB + 64 * 136;
    bf16_t* sVb = sQ + 64 * 136;
    bf16_t* sKEb = sVb + 64 * 136;
    float* sL = (float*)(sKEb + 64 * 136);
    bf16_t* sLb = (bf16_t*)(sL + 64 * LS);
    bf16_t* sTd = sLb + 64 * 72;
    float* sg = (float*)(sTd + 4 * 16 * 24); float* sbeta = sg + 64; float* scum = sbeta + 64;
    const bf16_t* S = (const bf16_t*)(p.ws + WS_SBUF);
    bf16_t* U = (bf16_t*)(p.ws + WS_GDN_U); bf16_t* W = (bf16_t*)(p.ws + WS_GDN_W); bf16_t* QI = (bf16_t*)(p.ws + WS_GDN_QI); bf16_t* KO = (bf16_t*)(p.ws + WS_GDN_KO);
    bf16_t* AT = (bf16_t*)(p.ws + WS_GDN_AT); float* DC = (float*)(p.ws + WS_GDN_DC);
    const int tid = otid(), ti = tid >> 3, sub = tid & 7;
    const int w = __builtin_amdgcn_readfirstlane(tid >> 6), lane = tid & 63, l15 = lane & 15, g = lane >> 4, q4 = l15 >> 2, p4 = l15 & 3;
    int len, base, tlo, nseg, cseg, coff;
    if (sc < 4) { len = CL; base = NLAT + b * CL; cseg = sc; nseg = 4; coff = 0; } else { len = SL; base = b * SL; cseg = sc - 4; nseg = 32; coff = 4; }
    tlo = 64 * cseg;
    const size_t row = (size_t)(base + tlo + ti);
    const float* Gp = (const float*)(p.ws + WS_G) + row * NNAR;
    const float a_raw0 = Gp[G_A + h], a_raw1 = Gp[G_A + 4 + h], b_raw0 = Gp[G_B + h], b_raw1 = Gp[G_B + 4 + h];
    float* sCW = scum + 64;
    bf16_t* raw = (bf16_t*)smem;
    if (tid < 480) { const int j = tid / 96, r = tid % 96, part = r >> 5, e4 = r & 31;
        *(f32x4*)(sCW + j * 384 + part * 128 + 4 * e4) = *(const f32x4*)(p.gdn_conv + ((size_t)l * 5 + j) * 1536 + part * 512 + 128 * h + 4 * e4); }
#pragma unroll
    for (int k = 0; k < 7; ++k) {
        const int e = tid + 512 * k;
        if (e < 68 * 48) {
            const int r = e / 48, pc = e % 48, part = pc >> 4, wi = pc & 15;
            const int tt = tlo - 2 + r;
            u32x4 v = (u32x4){0u, 0u, 0u, 0u};
            if (tt >= 0 && tt < len) v = __builtin_nontemporal_load((const u32x4*)(S + (size_t)(base + tt) * NP + C_GDN_Q + part * 512 + 128 * h + 8 * wi));
            *(u32x4*)(raw + r * 392 + part * 128 + 8 * wi) = v;
        }
    }
    __syncthreads();
    float xq[16], xk[16], xv[16];
    gdn_conv16(raw, sCW, ti, 0 + 16 * sub, xq);
    gdn_conv16(raw, sCW, ti, 128 + 16 * sub, xk);
    gdn_conv16(raw, sCW, ti, 256 + 16 * sub, xv);
    float sq_ = 0.f, sk_ = 0.f;
#pragma unroll
    for (int e = 0; e < 16; ++e) { sq_ += xq[e] * xq[e]; sk_ += xk[e] * xk[e]; }
    sq_ += __shfl_xor(sq_, 1); sq_ += __shfl_xor(sq_, 2); sq_ += __shfl_xor(sq_, 4);
    sk_ += __shfl_xor(sk_, 1); sk_ += __shfl_xor(sk_, 2); sk_ += __shfl_xor(sk_, 4);
    const float rq = rsqrtf(sq_ + 1e-6f) * 0.08838834764831845f, rk = rsqrtf(sk_ + 1e-6f);
#pragma unroll
    for (int e = 0; e < 16; ++e) { xq[e] *= rq; xk[e] *= rk; }
#pragma unroll 1
  for (int dir = 0; dir < 2; ++dir) {
    const int seq = (dir * 4 + b) * 4 + h;
    const int c = coff + (dir ? nseg - 1 - cseg : cseg);
    const int i = dir ? 63 - ti : ti;
    const int pp = 64 * c + i;
    if (sub == 0) {
        const float a_in = dir ? a_raw1 : a_raw0, b_in = dir ? b_raw1 : b_raw0;
        const float A = __expf(p.gdn_alog[(l * 2 + dir) * 4 + h]);
        const float xx = a_in + p.gdn_dtb[(l * 2 + dir) * 4 + h];
        const float sp = fmaxf(xx, 0.f) + log1pf(__expf(-fabsf(xx)));
        sg[i] = -A * sp; sbeta[i] = __builtin_amdgcn_rcpf(1.f + __expf(-b_in));
    }
    __syncthreads();
    if (tid < 64) {
        float v = sg[tid];
#pragma unroll
        for (int o = 1; o < 64; o <<= 1) { const float u = __shfl_up(v, o); if (tid >= o) v += u; }
        scum[tid] = v;
    }
    __syncthreads();
    const float cumi = scum[i], cl = scum[63], bet = sbeta[i], ei = __expf(cumi), eo = __expf(cl - cumi);
    {
        float t1[16], t2[16];
        *(u32x4*)(sK + i * 136 + 16 * sub) = pack8(xk); *(u32x4*)(sK + i * 136 + 16 * sub + 8) = pack8(xk + 8);
        *(u32x4*)(sQ + i * 136 + 16 * sub) = pack8(xq); *(u32x4*)(sQ + i * 136 + 16 * sub + 8) = pack8(xq + 8);
#pragma unroll
        for (int e = 0; e < 16; ++e) { t1[e] = xk[e] * bet; t2[e] = xv[e] * bet; }
        *(u32x4*)(sKB + i * 136 + 16 * sub) = pack8(t1); *(u32x4*)(sKB + i * 136 + 16 * sub + 8) = pack8(t1 + 8);
        *(u32x4*)(sVb + i * 136 + 16 * sub) = pack8(t2); *(u32x4*)(sVb + i * 136 + 16 * sub + 8) = pack8(t2 + 8);
#pragma unroll
        for (int e = 0; e < 16; ++e) t2[e] = t1[e] * ei;
        *(u32x4*)(sKEb + i * 136 + 16 * sub) = pack8(t2); *(u32x4*)(sKEb + i * 136 + 16 * sub + 8) = pack8(t2 + 8);
#pragma unroll
        for (int e = 0; e < 16; ++e) { t1[e] = xq[e] * ei; t2[e] = xk[e] * eo; }
        bf16_t* qd = QI + ((size_t)seq * PT + pp) * 128 + 16 * sub; bf16_t* kd = KO + ((size_t)seq * PT + pp) * 128 + 16 * sub;
        __builtin_nontemporal_store(pack8(t1), (u32x4*)qd); __builtin_nontemporal_store(pack8(t1 + 8), (u32x4*)(qd + 8));
        __builtin_nontemporal_store(pack8(t2), (u32x4*)kd); __builtin_nontemporal_store(pack8(t2 + 8), (u32x4*)(kd + 8));
        if (tid == 0) DC[seq * 36 + c] = __expf(cl);
    }
    __syncthreads();
    {
        const int mt = w >> 1;
#pragma unroll
        for (int n2 = 0; n2 < 2; ++n2) {
            const int nt = 2 * (w & 1) + n2;
            f32x4 aL = (f32x4){0.f, 0.f, 0.f, 0.f}, aA = (f32x4){0.f, 0.f, 0.f, 0.f};
#pragma unroll
            for (int ks = 0; ks < 4; ++ks) {
                const bf16x8 bk = ld8(sK + (16 * nt + l15) * 136 + 32 * ks + 8 * g);
                aL = mfma16(bk, ld8(sKB + (16 * mt + l15) * 136 + 32 * ks + 8 * g), aL);
                aA = mfma16(bk, ld8(sQ + (16 * mt + l15) * 136 + 32 * ks + 8 * g), aA);
            }
            const int ii = 16 * mt + l15, j0 = 16 * nt + 4 * g;
            const f32x4 cj = *(const f32x4*)(scum + j0); const float ci = scum[ii];
            f32x4 lv; float av[4];
#pragma unroll
            for (int r = 0; r < 4; ++r) {
                const float dcy = __expf(fminf(ci - cj[r], 0.f));
                lv[r] = (j0 + r < ii) ? aL[r] * dcy : 0.f;
                av[r] = (j0 + r <= ii) ? aA[r] * dcy : 0.f;
            }
            *(f32x4*)(sL + ii * LS + j0) = lv;
            { u32x2 lb; lb.x = pk2(lv[0], lv[1]); lb.y = pk2(lv[2], lv[3]); *(u32x2*)(sLb + ii * 72 + j0) = lb; }
            { u32x2 ab; ab.x = pk2(av[0], av[1]); ab.y = pk2(av[2], av[3]); *(u32x2*)(AT + (((size_t)seq * 36 + c) * 64 + ii) * 64 + j0) = ab; }
        }
    }
    __syncthreads();
    if (tid < 64) {
        const int I = tid >> 4, cc = tid & 15;
        float tt[16];
#pragma unroll
        for (int r = 0; r < 16; ++r) tt[r] = (r == cc) ? 1.f : 0.f;
#pragma unroll
        for (int j = 0; j < 15; ++j) {
            const float tj = tt[j];
#pragma unroll
            for (int r = j + 1; r < 16; ++r) tt[r] -= sL[(16 * I + r) * LS + 16 * I + j] * tj;
        }
#pragma unroll
        for (int r = 0; r < 16; ++r) sTd[(I * 16 + r) * 24 + cc] = f2bf(tt[r]);
    }
    __syncthreads();
    {
        const bf16_t* Rb = w < 4 ? sVb : sKEb;
        bf16_t* dstb = (w < 4 ? U : W) + ((size_t)seq * PT + 64 * c) * 128;
#pragma unroll
        for (int n2 = 0; n2 < 2; ++n2) {
            const int col0 = 32 * (w & 3) + 16 * n2;
            s16x4 Xb[4];
#pragma unroll
            for (int I = 0; I < 4; ++I) {
                f32x4 accL = (f32x4){0.f, 0.f, 0.f, 0.f};
#pragma unroll
                for (int J = 0; J < I; ++J)
                    accL = __builtin_amdgcn_mfma_f32_16x16x16bf16_1k(*(const s16x4*)(sLb + (16 * I + l15) * 72 + 16 * J + 4 * g), Xb[J], accL, 0, 0, 0);
                f32x4 rhs;
#pragma unroll
                for (int r = 0; r < 4; ++r) rhs[r] = bf2f(Rb[(16 * I + 4 * g + r) * 136 + col0 + l15]) - accL[r];
                u32x2 pb; pb.x = pk2(rhs[0], rhs[1]); pb.y = pk2(rhs[2], rhs[3]);
                const f32x4 X = __builtin_amdgcn_mfma_f32_16x16x16bf16_1k(*(const s16x4*)(sTd + (I * 16 + l15) * 24 + 4 * g), __builtin_bit_cast(s16x4, pb), (f32x4){0.f, 0.f, 0.f, 0.f}, 0, 0, 0);
                u32x2 px; px.x = pk2(X[0], X[1]); px.y = pk2(X[2], X[3]);
                Xb[I] = __builtin_bit_cast(s16x4, px);
#pragma unroll
                for (int r = 0; r < 4; ++r) dstb[(size_t)(16 * I + 4 * g + r) * 128 + col0 + l15] = f2bf(X[r]);
            }
        }
    }
    __syncthreads();
  }
}

struct GdnRegs { u32x4 r[8]; };
DI void gdn_scan_item(const P& p, int item, unsigned char* smem) {
    const int seq = (item & 7) * 4 + (item >> 5), cq = (item >> 3) & 3;
    const int dir = seq >> 4, b = (seq >> 2) & 3, h = seq & 3;
    constexpr int BUFB = 3 * 17408 + 9216 + 5120;
    bf16_t* sVN = (bf16_t*)(smem + 2 * BUFB);
    float* sdec = (float*)(smem + 2 * BUFB + 5120);
    const bf16_t* U = (const bf16_t*)(p.ws + WS_GDN_U); const bf16_t* W = (const bf16_t*)(p.ws + WS_GDN_W); const bf16_t* QI = (const bf16_t*)(p.ws + WS_GDN_QI); const bf16_t* KO = (const bf16_t*)(p.ws + WS_GDN_KO);
    const bf16_t* AT = (const bf16_t*)(p.ws + WS_GDN_AT); const float* DC = (const float*)(p.ws + WS_GDN_DC);
    bf16_t* OG = (bf16_t*)(p.ws + WS_NBUF) + (size_t)(2 + dir) * NROW * 512;
    const int tid = otid(), w = tid >> 6, lane = tid & 63, l15 = lane & 15, g = lane >> 4, q4 = l15 >> 2, p4 = l15 & 3;
    const int mt = w >> 1, nt = w & 1;
    auto loadr = [&](GdnRegs& R, int c) {
        if (c >= 36) return;
        u32x4* rr = R.r;
#pragma unroll
        for (int k = 0; k < 2; ++k) {
            const int e = tid + 512 * k, r = e >> 4, ch = e & 15; const size_t off = ((size_t)seq * PT + 64 * c + r) * 128 + 8 * ch;
            rr[k] = *(const u32x4*)(W + off); rr[2 + k] = *(const u32x4*)(QI + off); rr[4 + k] = *(const u32x4*)(KO + off);
        }
        { const int r = tid >> 3, ch = tid & 7; rr[6] = *(const u32x4*)(AT + (((size_t)seq * 36 + c) * 64 + r) * 64 + 8 * ch); }
        if (tid < 256) { const int r = tid >> 2, ch = tid & 3; rr[7] = __builtin_nontemporal_load((const u32x4*)(U + ((size_t)seq * PT + 64 * c + r) * 128 + 32 * cq + 8 * ch)); }
    };
    auto storel = [&](const GdnRegs& R, int buf) {
        const u32x4* rr = R.r;
        bf16_t* sW = (bf16_t*)(smem + buf * BUFB); bf16_t* sQI = sW + 64 * 136; bf16_t* sKO = sQI + 64 * 136; bf16_t* sAT = sKO + 64 * 136; bf16_t* sU = sAT + 64 * 72;
#pragma unroll
        for (int k = 0; k < 2; ++k) {
            const int e = tid + 512 * k, r = e >> 4, ch = e & 15; const int off = r * 136 + 8 * ch;
            *(u32x4*)(sW + off) = rr[k]; *(u32x4*)(sQI + off) = rr[2 + k]; *(u32x4*)(sKO + off) = rr[4 + k];
        }
        { const int r = tid >> 3, ch = tid & 7; *(u32x4*)(sAT + r * 72 + 8 * ch) = rr[6]; }
        if (tid < 256) { const int r = tid >> 2, ch = tid & 3; *(u32x4*)(sU + r * 40 + 8 * ch) = rr[7]; }
    };
    u32x4* sBS = (u32x4*)(smem + 2 * BUFB + 5120 + 256);
    f32x4 st[2];
    st[0] = (f32x4){0.f, 0.f, 0.f, 0.f}; st[1] = (f32x4){0.f, 0.f, 0.f, 0.f};
    sBS[(nt * 4 + mt) * 64 + lane] = (u32x4){0u, 0u, 0u, 0u};
    if (tid < 36) sdec[tid] = DC[seq * 36 + tid];
    const int sgn = dir ? -1 : 1;
    auto step = [&](GdnRegs& R, int c) {
        storel(R, c & 1);
        __syncthreads();
        loadr(R, c + 3);
        const bf16_t* sW = (const bf16_t*)(smem + (c & 1) * BUFB); const bf16_t* sQI = sW + 64 * 136; const bf16_t* sKO = sQI + 64 * 136; const bf16_t* sAT = sKO + 64 * 136; const bf16_t* sU = sAT + 64 * 72;
        const float dec = sdec[c];
        bf16x8 Bs[4];
#pragma unroll
        for (int ks = 0; ks < 4; ++ks) Bs[ks] = __builtin_bit_cast(bf16x8, sBS[(nt * 4 + ks) * 64 + lane]);
        {
            f32x4 acc = (f32x4){0.f, 0.f, 0.f, 0.f};
#pragma unroll
            for (int ks = 0; ks < 4; ++ks) { const bf16_t* r0 = sW + (16 * mt + l15) * 136 + 32 * ks + 4 * g; acc = mfma16(Bs[ks], ld4x2(r0, r0 + 16), acc); }
            {
                const u32x2 uu = *(const u32x2*)(sU + (16 * mt + l15) * 40 + 16 * nt + 4 * g);
                u32x2 vv; vv.x = pk2(lo16(uu.x) - acc[0], hi16(uu.x) - acc[1]); vv.y = pk2(lo16(uu.y) - acc[2], hi16(uu.y) - acc[3]);
                *(u32x2*)(sVN + (16 * mt + l15) * 40 + 16 * nt + 4 * g) = vv;
            }
        }
        __syncthreads();
        bf16x8 Bv[2];
#pragma unroll
        for (int k2 = 0; k2 < 2; ++k2) Bv[k2] = tr2(sVN + (32 * k2 + 8 * g + q4) * 40 + 16 * nt + 4 * p4, sVN + (32 * k2 + 8 * g + 4 + q4) * 40 + 16 * nt + 4 * p4);
        {
            f32x4 acc = (f32x4){0.f, 0.f, 0.f, 0.f};
#pragma unroll
            for (int ks = 0; ks < 4; ++ks) { const bf16_t* r0 = sQI + (16 * mt + l15) * 136 + 32 * ks + 4 * g; acc = mfma16(Bs[ks], ld4x2(r0, r0 + 16), acc); }
#pragma unroll
            for (int k2 = 0; k2 < 2; ++k2) acc = mfma16(Bv[k2], ld8(sAT + (16 * mt + l15) * 72 + 32 * k2 + 8 * g), acc);
            bf16_t* ob = OG + (size_t)prow(b, dir, 64 * c) * 512 + 128 * h + 32 * cq;
            u32x2 ov; ov.x = pk2(acc[0], acc[1]); ov.y = pk2(acc[2], acc[3]);
            *(u32x2*)(ob + sgn * ((16 * mt + l15) * 512) + 16 * nt + 4 * g) = ov;
        }
#pragma unroll
        for (int j = 0; j < 2; ++j) {
            const int dt = 2 * mt + j;
            st[j] *= dec;
#pragma unroll
            for (int k2 = 0; k2 < 2; ++k2) {
                const bf16x8 ak = tr2(sKO + (32 * k2 + 8 * g + q4) * 136 + 16 * dt + 4 * p4, sKO + (32 * k2 + 8 * g + 4 + q4) * 136 + 16 * dt + 4 * p4);
                st[j] = mfma16(ak, Bv[k2], st[j]);
            }
        }
        sBS[(nt * 4 + mt) * 64 + lane] = __builtin_bit_cast(u32x4, packacc(st[0], st[1]));
    };
    GdnRegs R0, R1, R2;
    loadr(R0, 0); loadr(R1, 1); loadr(R2, 2);
#pragma unroll 1
    for (int c = 0; c < 36; c += 3) { step(R0, c); step(R1, c + 1); step(R2, c + 2); }
    __syncthreads();
}

DI void rope8(float* x1, float* x2, int g8, float posv) {
#pragma unroll
    for (int e = 0; e < 8; ++e) {
        const float inv = exp2f(-(float)(g8 + e) * 0.41524101186092f);
        float s, c; __sincosf(posv * inv, &s, &c);
        const float a = x1[e], bb = x2[e];
        x1[e] = a * c - bb * s; x2[e] = bb * c + a * s;
    }
}

DI void krope_item(const P& p, int r32) {
    const bf16_t* S = (const bf16_t*)(p.ws + WS_SBUF);
    bf16_t* KR = (bf16_t*)(p.ws + WS_KR);
    const int tid = otid(); const int row = r32 * 32 + (tid >> 4), u = tid & 15, hk = u >> 3, hf = (u >> 2) & 1, e8 = (u & 3) * 8;
    const bf16_t* src = S + (size_t)row * NP + C_SWA_K + 128 * hk + 64 * hf + e8;
    float x1[8], x2[8]; unpack8(__builtin_nontemporal_load((const u32x4*)src), x1); unpack8(__builtin_nontemporal_load((const u32x4*)(src + 32)), x2);
    const int kp = row & 2047;
    rope8(x1, x2, e8, (float)(hf == 0 ? (kp >> 6) : (kp & 63)));
    bf16_t* dst = KR + (size_t)row * 256 + 128 * hk + 64 * hf + e8;
    *(u32x4*)dst = pack8(x1); *(u32x4*)(dst + 32) = pack8(x2);
}

struct SwaRegs { u32x4 pr1, pr2, pv1, pv2; };
DI void swa_item(const P& p, int l, int item, unsigned char* smem) {
    bf16_t* sK = (bf16_t*)smem; bf16_t* sV = sK + 64 * 136;
    const bf16_t* S = (const bf16_t*)(p.ws + WS_SBUF);
    const bf16_t* KR = (const bf16_t*)(p.ws + WS_KR);
    bf16_t* Y = (bf16_t*)(p.ws + WS_YBUF);
    bool lat; int b, hk, qb;
    if (item < 256) { lat = true; b = item >> 6; hk = (item >> 5) & 1; qb = item & 31; } else { const int it = item - 256; lat = false; b = it >> 3; hk = (it >> 2) & 1; qb = it & 3; }
    const int tid = otid(), w = tid >> 6, lane = tid & 63, l15 = lane & 15, g = lane >> 4, q4 = l15 >> 2, p4 = l15 & 3;
    const int hq = 2 * hk + (w >> 2);
    const int qpos = 64 * qb + 16 * (w & 3) + l15;
    const size_t qrow = lat ? (size_t)(b * SL + qpos) : (size_t)(NLAT + b * CL + qpos);
    bf16x8 Qf[4];
    {
        float xs[4][8];
#pragma unroll
        for (int ks = 0; ks < 4; ++ks) unpack8(*(const u32x4*)(S + qrow * NP + C_SWA_Q + 128 * hq + 32 * ks + 8 * g), xs[ks]);
        if (lat) { rope8(xs[0], xs[1], 8 * g, (float)(qpos >> 6)); rope8(xs[2], xs[3], 8 * g, (float)(qpos & 63)); }
        const float qs = 0.08838834764831845f * 1.4426950408889634f;
#pragma unroll
        for (int ks = 0; ks < 4; ++ks) {
#pragma unroll
            for (int e = 0; e < 8; ++e) xs[ks][e] *= qs;
            Qf[ks] = __builtin_bit_cast(bf16x8, pack8(xs[ks]));
        }
    }
    float m = p.swa_sink[l * 4 + hq] * 1.4426950408889634f;
    float lsum = (g == 0) ? 1.f : 0.f;
    f32x4 ot[8];
#pragma unroll
    for (int i = 0; i < 8; ++i) ot[i] = (f32x4){0.f, 0.f, 0.f, 0.f};
    int lo = 0, ntl = 0;
    if (lat) { lo = 64 * qb - 128; if (lo < 0) lo = 0; int hi = 64 * qb + 192; if (hi > SL) hi = SL; ntl = (hi - lo) >> 6; }
    const int ntot = ntl + 4;
    const int skey = tid >> 3, ssub = tid & 7, shf = ssub >> 2, se8 = (ssub & 3) * 8;
    auto kvload = [&](SwaRegs& R, int tix) {
        if (tix >= ntot) return;
        const bool loc = tix < ntl;
        const int kpos0 = loc ? lo + 64 * tix : 64 * (tix - ntl);
        const size_t krow0 = loc ? (size_t)(b * SL + kpos0) : (size_t)(NLAT + b * CL + kpos0);
        const bf16_t* src = loc ? KR + (krow0 + skey) * 256 + 128 * hk + 64 * shf + se8 : S + (krow0 + skey) * NP + C_SWA_K + 128 * hk + 64 * shf + se8;
        R.pr1 = *(const u32x4*)src; R.pr2 = *(const u32x4*)(src + 32);
        const bf16_t* vsrc = S + (krow0 + skey) * NP + C_SWA_V + 128 * hk + 16 * ssub;
        R.pv1 = *(const u32x4*)vsrc; R.pv2 = *(const u32x4*)(vsrc + 8);
    };
    auto tile = [&](SwaRegs& R, int tix) {
        const bool loc = tix < ntl;
        const int kpos0 = loc ? lo + 64 * tix : 64 * (tix - ntl);
        __syncthreads();
        {
            const u32x4 r1 = R.pr1, r2 = R.pr2;
            *(u32x4*)(sK + skey * 136 + 64 * shf + se8) = r1; *(u32x4*)(sK + skey * 136 + 64 * shf + 32 + se8) = r2;
            *(u32x4*)(sV + skey * 144 + 16 * ssub) = R.pv1; *(u32x4*)(sV + skey * 144 + 16 * ssub + 8) = R.pv2;
        }
        __syncthreads();
        kvload(R, tix + 2);
        f32x4 sc[4];
#pragma unroll
        for (int kt = 0; kt < 4; ++kt) {
            f32x4 acc = (f32x4){0.f, 0.f, 0.f, 0.f};
#pragma unroll
            for (int ks = 0; ks < 4; ++ks) acc = mfma16(ld8(sK + (16 * kt + l15) * 136 + 32 * ks + 8 * g), Qf[ks], acc);
            sc[kt] = acc;
        }
        if (loc && (kpos0 <= 64 * qb - 128 || kpos0 >= 64 * qb + 128)) {
#pragma unroll
            for (int kt = 0; kt < 4; ++kt)
#pragma unroll
                for (int r = 0; r < 4; ++r) { const int dd = kpos0 + 16 * kt + 4 * g + r - qpos; if (dd > 128 || dd < -128) sc[kt][r] = -1e30f; }
        }
        float tmax = -1e30f;
#pragma unroll
        for (int kt = 0; kt < 4; ++kt)
#pragma unroll
            for (int r = 0; r < 4; ++r) tmax = fmaxf(tmax, sc[kt][r]);
        tmax = fmaxf(tmax, __shfl_xor(tmax, 16)); tmax = fmaxf(tmax, __shfl_xor(tmax, 32));
        const float mn = fmaxf(m, tmax), alpha = __builtin_amdgcn_exp2f(m - mn);
        m = mn;
        float psum = 0.f;
#pragma unroll
        for (int kt = 0; kt < 4; ++kt)
#pragma unroll
            for (int r = 0; r < 4; ++r) { const float pv = __builtin_amdgcn_exp2f(sc[kt][r] - mn); sc[kt][r] = pv; psum += pv; }
        lsum = lsum * alpha + psum;
        bf16x8 Bp[2];
        Bp[0] = packacc(sc[0], sc[1]); Bp[1] = packacc(sc[2], sc[3]);
#pragma unroll
        for (int nt = 0; nt < 8; ++nt) {
            ot[nt] *= alpha;
#pragma unroll
            for (int k2 = 0; k2 < 2; ++k2) {
                const bf16x8 av = tr2(sV + (32 * k2 + 4 * g + q4) * 144 + 16 * nt + 4 * p4, sV + (32 * k2 + 16 + 4 * g + q4) * 144 + 16 * nt + 4 * p4);
                ot[nt] = mfma16(av, Bp[k2], ot[nt]);
            }
        }
    };
    SwaRegs RA, RB;
    kvload(RA, 0); kvload(RB, 1);
#pragma unroll 1
    for (int tix = 0; tix < ntot; tix += 2) { tile(RA, tix); if (tix + 1 < ntot) tile(RB, tix + 1); }
    lsum += __shfl_xor(lsum, 16); lsum += __shfl_xor(lsum, 32);
    const float inv = __builtin_amdgcn_rcpf(lsum);
#pragma unroll
    for (int nt = 0; nt < 8; ++nt) {
        const int dvb = 16 * nt + 4 * g;
        const u32x2 gw = *(const u32x2*)(S + qrow * NP + C_SWA_G + 128 * hq + dvb);
        const float g0 = lo16(gw.x), g1 = hi16(gw.x), g2 = lo16(gw.y), g3 = hi16(gw.y);
        u32x2 o; o.x = pk2(ot[nt][0] * inv * siluf(g0), ot[nt][1] * inv * siluf(g1)); o.y = pk2(ot[nt][2] * inv * siluf(g2), ot[nt][3] * inv * siluf(g3));
        *(u32x2*)(Y + qrow * DM + 1536 + 128 * hq + dvb) = o;
    }
}


#define XB_TMO      128
#define XB_XCNT(j)  (256  + 64 * (j))
#define XB_XSUB(j)  (1280 + 64 * (j))
#define XB_XGEN(j)  (2304 + 64 * (j))
#define XB_TOP      3328
#define XB_TOPGEN   3392
#define XCD_BAR_WORDS 3456
#define XB_SPIN_CAP (1u << 18)
DI unsigned xb_ld(unsigned* p)              { return __hip_atomic_load(p, __ATOMIC_RELAXED, __HIP_MEMORY_SCOPE_AGENT); }
DI unsigned xb_add(unsigned* p, unsigned v) { return __hip_atomic_fetch_add(p, v, __ATOMIC_RELAXED, __HIP_MEMORY_SCOPE_AGENT); }
DI unsigned xb_xcc_id() { return (unsigned)__builtin_amdgcn_s_getreg((3 << 11) | 20) & 0xFu; }
#define XB_SPIN(cond, bar) do { unsigned _sp = 0; while (cond) { __builtin_amdgcn_s_sleep(1); \
    if ((++_sp & 255u) == 0u) { if (xb_ld(&(bar)[XB_TMO])) break; if (_sp > XB_SPIN_CAP) { atomicAdd(&(bar)[XB_TMO], 1u); break; } } } } while (0)
struct XcdBarrier { unsigned* bar; unsigned x; volatile LAS unsigned* st; };
DI XcdBarrier xcd_barrier_post(unsigned* bar, volatile LAS unsigned* st) {
    XcdBarrier b; b.bar = bar; b.x = xb_xcc_id(); b.st = st;
    if (threadIdx.x == 0) (void)xb_add(&bar[XB_XCNT(b.x)], 1u);
    return b;
}
DI void xcd_barrier_complete(unsigned* bar, unsigned x, unsigned& nloc, unsigned& nx) {
    const unsigned G = gridDim.x * gridDim.y * gridDim.z;
    unsigned sum, cnt, mine, sp = 0u;
    for (;;) {
        sum = 0u; cnt = 0u; mine = 0u;
#pragma unroll
        for (unsigned j = 0; j < 16; ++j) { const unsigned c = xb_ld(&bar[XB_XCNT(j)]); sum += c; cnt += (c > 0u) ? 1u : 0u; mine = (j == x) ? c : mine; }
        if (sum == G) break;
        __builtin_amdgcn_s_sleep(1);
        if ((++sp & 255u) == 0u) { if (xb_ld(&bar[XB_TMO])) break; if (sp > XB_SPIN_CAP) { atomicAdd(&bar[XB_TMO], 1u); break; } }
    }
    nloc = mine > 0u ? mine : 1u; nx = cnt > 0u ? cnt : 1u;
}
DI void xcd_barrier(const XcdBarrier& b) {
    asm volatile("s_waitcnt vmcnt(0)" ::: "memory");
    __syncthreads();
    if (threadIdx.x == 0) {
        unsigned* bar = b.bar;
        __builtin_amdgcn_s_waitcnt(0);
        unsigned nloc = b.st[0], nx = b.st[1];
        if (nloc == 0u) { xcd_barrier_complete(bar, b.x, nloc, nx); b.st[0] = nloc; b.st[1] = nx; }
        const unsigned old = xb_add(&bar[XB_XSUB(b.x)], 1u);
        const unsigned gen = old / nloc;
        if (old + 1u == (gen + 1u) * nloc) {
            __builtin_amdgcn_fence(__ATOMIC_RELEASE, "agent");
            asm volatile("s_waitcnt vmcnt(0)" ::: "memory");
            const unsigned og = xb_add(&bar[XB_TOP], 1u);
            const unsigned tg = og / nx;
            if (og + 1u == (tg + 1u) * nx) xb_add(&bar[XB_TOPGEN], 1u);
            else XB_SPIN(xb_ld(&bar[XB_TOPGEN]) == tg, bar);
            __builtin_amdgcn_fence(__ATOMIC_ACQUIRE, "agent");
            xb_add(&bar[XB_XGEN(b.x)], 1u);
            asm volatile("s_waitcnt vmcnt(0)" ::: "memory");
        } else {
            XB_SPIN(xb_ld(&bar[XB_XGEN(b.x)]) == gen, bar);
            __builtin_amdgcn_fence(__ATOMIC_ACQUIRE, "agent");
            asm volatile("s_waitcnt vmcnt(0)" ::: "memory");
        }
    }
    __syncthreads();
}

DI void weight_prep_item(const P& q, int l, int it, unsigned char* sm) {
    if (it < 96) adaln_item(q, l * 96 + it, sm);
    else if (it < 96 + 896) { const int r = it - 96, kt = r / 28, nt = r % 28;
        const int n0 = nt * 256, srcoff = n0 < 1024 ? 0 : (n0 < 3072 ? 32 : 48);
        transpose_item(q.w_in + (size_t)l * DM * INW, INW, srcoff, (bf16_t*)(q.ws + WS_WINT) + (size_t)l * NP * DM, kt, nt, sm); }
    else if (it < 96 + 896 + 256) { const int r = it - 96 - 896, kt = r / 8, nt = r % 8;
        transpose_item(q.w_out + (size_t)l * DM * DM, DM, 0, (bf16_t*)(q.ws + WS_WOUTT) + (size_t)l * DM * DM, kt, nt, sm); }
    else { const int kt = it - 96 - 896 - 256;
        narrow_item(q.w_in + (size_t)l * DM * INW, (bf16_t*)(q.ws + WS_WNT) + (size_t)l * NNAR * DM, kt); }
}

#define ITEM_BEGIN { size_t z_ = 0; asm volatile("" : "+s"(z_)); q.ws = p.ws + z_; sm = smem + osgpr(0); }
#define PHASE_BEGIN P q = p; { size_t z_ = 0; asm volatile("" : "+s"(z_)); q.ws = p.ws + z_; } unsigned char* sm = smem + osgpr(0); const int b1 = osgpr(bid); (void)sm; (void)b1;
__global__ __launch_bounds__(512, 2) void mega(P p) {
    extern __shared__ __attribute__((aligned(16))) unsigned char smem[];
    cg::grid_group grid = cg::this_grid();
    const int bid = blockIdx.x, nb = gridDim.x;
    volatile LAS unsigned* xst = (volatile LAS unsigned*)(smem + LDS_BYTES - 16);
    if (threadIdx.x < 4) xst[threadIdx.x] = 0u;
    __syncthreads();
    const XcdBarrier xb = xcd_barrier_post((unsigned*)(p.ws + WS_BAR), xst);
    if (p.ws == nullptr) grid.sync();
    for (int rep = 0; rep < REP_P0; ++rep) {
        PHASE_BEGIN
        for (int it = b1; it < 2560; it += nb) { ITEM_BEGIN weight_prep_item(q, it & 1, it >> 1, sm); }
    }
    xcd_barrier(xb);
    { PHASE_BEGIN norm0_phase(q, sm); }
    xcd_barrier(xb);
#pragma unroll 1
    for (int l0 = 0; l0 < 2; ++l0) {
        const int l = osgpr(l0);
        for (int rep = 0; rep < REP_G1; ++rep) {
            if (rep) xcd_barrier(xb);
            PHASE_BEGIN
            pg8::Gemm g{(const bf16_t*)(q.ws + WS_NBUF), (const bf16_t*)(q.ws + WS_WINT) + (size_t)l * NP * DM, NROW, NP, DM};
            pg8::StaticOrder so; so.init(g.M, g.N, nb, b1);
            pg8::EpiBf16 e{(bf16_t*)(q.ws + WS_SBUF), NP};
            pg8::gemm_phase((LAS unsigned char*)sm, g, so, e);
        }
        xcd_barrier(xb);
        for (int rep = 0; rep < REP_PREP; ++rep) {
            if (rep) xcd_barrier(xb);
            PHASE_BEGIN
            const int nconv = (l == 0 ? NROW : NLAT) / 32;
            const int ntot = 576 + 576 + nconv + 256;
            unsigned* qctr = xb.bar + 1 + l;
            volatile LAS unsigned* qw = xst + 2;
            unsigned nxt = 0u;
            if (threadIdx.x == 0) qw[0] = xb_add(qctr, 1u);
            __syncthreads();
            int it = (int)qw[0];
            __syncthreads();
            while (it < ntot) {
                ITEM_BEGIN
                if (threadIdx.x == 0) nxt = xb_add(qctr, 1u);
                if (it < 576) { for (int r2 = 0; r2 < REP_GDNP; ++r2) gdn_prep_item(q, l, it, sm); }
                else if (it < 576 + 576) { for (int r2 = 0; r2 < REP_GLAP; ++r2) gla_prep_item(q, l, it - 576, sm); }
                else if (it < 576 + 576 + nconv) conv_item(q, l, it - 576 - 576);
                else krope_item(q, it - 576 - 576 - nconv);
                if (threadIdx.x == 0) qw[0] = nxt;
                __syncthreads();
                it = (int)qw[0];
                __syncthreads();
            }
        }
        xcd_barrier(xb);
        for (int rep = 0; rep < REP_SCAN; ++rep) {
            if (rep) xcd_barrier(xb);
            PHASE_BEGIN
            if (b1 < 32) { for (int r2 = 0; r2 < REP_GLAS; ++r2) gla_scan_item(q, b1, sm); }
            else if (b1 < 160) { for (int r2 = 0; r2 < REP_GDNS; ++r2) gdn_scan_item(q, b1 - 32, sm); }
            else if (nb == 256) {
                const int j = b1 - 160, x = j & 7, nloc = l == 0 ? 36 : 32;
                unsigned* qctr = xb.bar + 8 + 8 * l + x;
                volatile LAS unsigned* qw = xst + 2;
                unsigned nxt = 0u;
                if (threadIdx.x == 0) qw[0] = xb_add(qctr, 1u);
                __syncthreads();
                int li = (int)qw[0];
                __syncthreads();
                while (li < nloc) { ITEM_BEGIN
                    if (threadIdx.x == 0) nxt = xb_add(qctr, 1u);
                    const int it = li < 32 ? ((x >> 1) * 64 + (x & 1) * 32 + li) : (256 + (x >> 1) * 8 + (x & 1) * 4 + (li - 32));
                    for (int r2 = 0; r2 < REP_SWA; ++r2) swa_item(q, l, it, sm);
                    if (threadIdx.x == 0) qw[0] = nxt;
                    __syncthreads();
                    li = (int)qw[0];
                    __syncthreads(); }
            }
            else { const int nsw = l == 0 ? 288 : 256; for (int it = b1 - 160; it < nsw; it += nb - 160) { ITEM_BEGIN for (int r2 = 0; r2 < REP_SWA; ++r2) swa_item(q, l, it, sm); } }
        }
        xcd_barrier(xb);
        { PHASE_BEGIN const int nf = (l == 0 ? NROW : NLAT) / 16; for (int it = b1; it < nf; it += nb) { ITEM_BEGIN finish_item(q, l, it); } }
        xcd_barrier(xb);
        for (int rep = 0; rep < REP_G2; ++rep) {
            if (rep) xcd_barrier(xb);
            PHASE_BEGIN
            pg8::Gemm g{(const bf16_t*)(q.ws + WS_YBUF), (const bf16_t*)(q.ws + WS_WOUTT) + (size_t)l * DM * DM, NLAT, DM, DM};
            pg8::StaticOrder so; so.init(g.M, g.N, nb, b1);
            pg8::EpiBf16 e{(bf16_t*)(q.ws + WS_SBUF), DM};
            pg8::gemm_phase((LAS unsigned char*)sm, g, so, e);
        }
        xcd_barrier(xb);
        if (l == 0) {
            {
                PHASE_BEGIN
                if (b1 < 32) {
                    pg8::Gemm g{(const bf16_t*)(q.ws + WS_YBUF) + (size_t)NLAT * DM, (const bf16_t*)(q.ws + WS_WOUTT), NROW - NLAT, DM, DM};
                    pg8::StaticOrder so; so.init(g.M, g.N, 32, b1);
                    pg8::EpiBf16 e{(bf16_t*)(q.ws + WS_SBUF) + (size_t)NLAT * DM, DM};
                    pg8::gemm_phase((LAS unsigned char*)sm, g, so, e);
                } else post_phase(q, 0, sm, 0, NLAT / 16, b1 - 32, nb - 32);
            }
            xcd_barrier(xb);
            { PHASE_BEGIN post_phase(q, 0, sm, NLAT / 16, NROW / 16, b1, nb); }
            xcd_barrier(xb);
        } else {
            PHASE_BEGIN post_phase(q, 1, sm, 0, NLAT / 16, b1, nb);
        }
    }
}

extern "C" void kernel_launch(void* const* d_in, const int* in_sizes, int n_in, void* d_out, int out_size, void* d_ws, size_t ws_size, hipStream_t stream) {
    static int grid = 0;
    if (grid == 0) {
        if (n_in != 19 || ws_size < WS_END) { fprintf(stderr, "kernel_launch: unexpected n_in %d / ws_size %zu (need %zu)\n", n_in, ws_size, (size_t)WS_END); grid = -1; return; }
        int dev = 0, cus = 0, per_cu = 0;
        hipGetDevice(&dev);
        hipDeviceGetAttribute(&cus, hipDeviceAttributeMultiprocessorCount, dev);
        hipFuncSetAttribute((const void*)mega, hipFuncAttributeMaxDynamicSharedMemorySize, LDS_BYTES);
        hipOccupancyMaxActiveBlocksPerMultiprocessor(&per_cu, (const void*)mega, 512, LDS_BYTES);
        if (per_cu < 1) per_cu = 1;
        grid = cus * per_cu;
        fprintf(stderr, "kernel_launch: cus %d per_cu %d grid %d ws %zu need %zu\n", cus, per_cu, grid, ws_size, (size_t)WS_END);
    }
    if (grid < 0) return;
    P p{};
    const float** f = (const float**)&p;
    for (int i = 0; i < 19; ++i) f[i] = (const float*)d_in[i];
    p.out = (float*)d_out; p.ws = (unsigned char*)d_ws;
    (void)hipMemsetAsync((unsigned char*)d_ws + WS_BAR, 0, 3456 * 4, stream);
    void* args[] = {&p};
    hipError_t e = hipLaunchCooperativeKernel((const void*)mega, dim3(grid), dim3(512), args, LDS_BYTES, stream);
    if (e != hipSuccess) fprintf(stderr, "cooperative launch failed: %s (grid %d)\n", hipGetErrorString(e), grid);
}
```

```cpp
#include <hip/hip_runtime.h>
#include <hip/hip_cooperative_groups.h>
#include <cstdio>
namespace cg = cooperative_groups;

#define DI __device__ __forceinline__
#define LAS __attribute__((address_space(3)))
typedef unsigned short bf16_t;
typedef short bf16x8 __attribute__((ext_vector_type(8)));
typedef short s16x4 __attribute__((ext_vector_type(4)));
typedef float f32x4 __attribute__((ext_vector_type(4)));
typedef unsigned u32x4 __attribute__((ext_vector_type(4)));
typedef unsigned u32x2 __attribute__((ext_vector_type(2)));

constexpr int DM = 2048, NBATCH = 4, SL = 2048, CL = 256, NROW = 9216, NLAT = 8192, INW = 7216, NP = 7168, PT = 2304, NNAR = 48;
constexpr int C_GLA_Q = 0, C_GLA_K = 256, C_GLA_V = 512, C_GLA_G = 1024, C_GDN_Q = 1536, C_GDN_K = 2048, C_GDN_V = 2560,
              C_GDN_G = 3072, C_SC_B = 3584, C_SC_C = 4096, C_SC_H = 4608, C_SC_G = 5120, C_SWA_Q = 5632,
              C_SWA_K = 6144, C_SWA_V = 6400, C_SWA_G = 6656;
constexpr int G_LR = 0, G_A = 32, G_B = 40;
constexpr int LDS_BYTES = 147456;
#ifndef REP_P0
#define REP_P0 1
#endif
#ifndef REP_G1
#define REP_G1 1
#endif
#ifndef REP_PREP
#define REP_PREP 1
#endif
#ifndef REP_SCAN
#define REP_SCAN 1
#endif
#ifndef REP_GDNP
#define REP_GDNP 1
#endif
#ifndef REP_GLAP
#define REP_GLAP 1
#endif
#ifndef REP_GLAS
#define REP_GLAS 1
#endif
#ifndef REP_GDNS
#define REP_GDNS 1
#endif
#ifndef REP_SWA
#define REP_SWA 1
#endif
#ifndef REP_G2
#define REP_G2 1
#endif

constexpr size_t al256(size_t x) { return (x + 255) & ~(size_t)255; }
constexpr size_t WS_WINT = 0;
constexpr size_t WS_WOUTT = WS_WINT + al256((size_t)2 * NP * DM * 2);
constexpr size_t WS_MOD = WS_WOUTT + al256((size_t)2 * DM * DM * 2);
constexpr size_t WS_NBUF = WS_MOD + al256((size_t)2 * 5 * 6144 * 4);
constexpr size_t WS_SBUF = WS_NBUF + al256((size_t)NROW * DM * 2);
constexpr size_t WS_YBUF = WS_SBUF + al256((size_t)NROW * NP * 2);
constexpr size_t WS_HC = WS_YBUF + al256((size_t)NROW * DM * 2);
constexpr size_t WS_GLA_QT = WS_HC + al256((size_t)1024 * DM * 4);
constexpr size_t WS_GLA_KO = WS_GLA_QT + al256((size_t)32 * PT * 64 * 2);
constexpr size_t WS_GLA_AT = WS_GLA_KO + al256((size_t)32 * PT * 64 * 2);
constexpr size_t WS_GLA_DC = WS_GLA_AT + al256((size_t)32 * 72 * 32 * 32 * 2);
constexpr size_t WS_GDN_U = WS_GLA_DC + al256((size_t)32 * 72 * 64 * 4);
constexpr size_t WS_GDN_W = WS_GDN_U + al256((size_t)32 * PT * 128 * 2);
constexpr size_t WS_GDN_QI = WS_GDN_W + al256((size_t)32 * PT * 128 * 2);
constexpr size_t WS_GDN_KO = WS_GDN_QI + al256((size_t)32 * PT * 128 * 2);
constexpr size_t WS_GDN_AT = WS_GDN_KO + al256((size_t)32 * PT * 128 * 2);
constexpr size_t WS_GDN_DC = WS_GDN_AT + al256((size_t)32 * 36 * 64 * 64 * 2);
constexpr size_t WS_WNT = WS_GDN_DC + al256((size_t)32 * 36 * 4);
constexpr size_t WS_G = WS_WNT + al256((size_t)2 * NNAR * DM * 2);
constexpr size_t WS_KR = WS_G + al256((size_t)NROW * NNAR * 4);
constexpr size_t WS_BAR = WS_KR + al256((size_t)NLAT * 256 * 2);
constexpr size_t WS_END = WS_BAR + al256((size_t)3456 * 4);

struct P {
    const float *x, *c, *ctx, *c_ctx, *ada_w, *ada_b, *norm_pre, *norm_post, *w_in, *w_out, *gla_wd, *gla_bd, *gla_norm, *gdn_conv, *gdn_alog,
        *gdn_dtb, *gdn_norm, *sc_conv, *swa_sink;
    float* out;
    unsigned char* ws;
};

typedef __bf16 bf16v2 __attribute__((ext_vector_type(2)));
DI bf16_t f2bf(float f) { return __builtin_bit_cast(bf16_t, (__bf16)f); }
DI float bf2f(bf16_t b) { return __uint_as_float(((unsigned)b) << 16); }
DI unsigned pk2(float lo, float hi) { bf16v2 v = {(__bf16)lo, (__bf16)hi}; return __builtin_bit_cast(unsigned, v); }
DI float lo16(unsigned u) { return __uint_as_float(u << 16); }
DI float hi16(unsigned u) { return __uint_as_float(u & 0xFFFF0000u); }
DI void unpack8(u32x4 v, float* o) { o[0] = lo16(v.x); o[1] = hi16(v.x); o[2] = lo16(v.y); o[3] = hi16(v.y); o[4] = lo16(v.z); o[5] = hi16(v.z); o[6] = lo16(v.w); o[7] = hi16(v.w); }
DI u32x4 pack8(const float* o) { u32x4 r; r.x = pk2(o[0], o[1]); r.y = pk2(o[2], o[3]); r.z = pk2(o[4], o[5]); r.w = pk2(o[6], o[7]); return r; }
DI float siluf(float x) { return x * __builtin_amdgcn_rcpf(1.f + __expf(-x)); }
DI bf16x8 ld8(const bf16_t* p) { return *(const bf16x8*)p; }
DI bf16x8 ld4x2(const bf16_t* p0, const bf16_t* p1) {
    s16x4 a = *(const s16x4*)p0, b = *(const s16x4*)p1;
    return __builtin_shufflevector(a, b, 0, 1, 2, 3, 4, 5, 6, 7);
}
DI s16x4 trread(const bf16_t* p) { return __builtin_amdgcn_ds_read_tr16_b64_v4i16((LAS s16x4*)p); }
DI bf16x8 tr2(const bf16_t* p0, const bf16_t* p1) { s16x4 a = trread(p0), b = trread(p1); return __builtin_shufflevector(a, b, 0, 1, 2, 3, 4, 5, 6, 7); }
DI bf16x8 packacc(f32x4 a, f32x4 b) {
    u32x4 r; r.x = pk2(a[0], a[1]); r.y = pk2(a[2], a[3]); r.z = pk2(b[0], b[1]); r.w = pk2(b[2], b[3]);
    return __builtin_bit_cast(bf16x8, r);
}
DI f32x4 mfma16(bf16x8 a, bf16x8 b, f32x4 c) { return __builtin_amdgcn_mfma_f32_16x16x32_bf16(a, b, c, 0, 0, 0); }
DI float wave_sum(float v) {
#pragma unroll
    for (int o = 32; o >= 1; o >>= 1) v += __shfl_xor(v, o);
    return v;
}
DI int otid() { int t = threadIdx.x; asm volatile("" : "+v"(t)); return t; }
DI int osgpr(int v) { asm volatile("" : "+s"(v)); return v; }
DI int prow(int b, int dir, int p) {
    if (p < CL) { const int t = dir ? (CL - 1 - p) : p; return NLAT + b * CL + t; }
    const int q = p - CL; const int t = dir ? (SL - 1 - q) : q; return b * SL + t;
}

namespace pg8 {
constexpr int BM = 256, BK = 64, HALF = 128, HTB = HALF * BK * 2, NXCD = 8, WGM = 4;
DI int lds_byte(int r, int c) { const int st = (r >> 4) * 2 + (c >> 5), rr = r & 15, cc = c & 31, ob = rr * 64 + cc * 2; return st * 1024 + (ob ^ (((ob >> 9) & 1) << 5)); }
DI void stage_rc(int b, int& R, int& C) { const int st = b / 1024, sb = b % 1024, swz = sb ^ (((sb >> 9) & 1) << 5); R = (st >> 1) * 16 + swz / 64; C = (st & 1) * 32 + (swz % 64) / 2; }
DI int perm32(int rho) { const int n = rho >> 4, i = rho & 15; return 8 * (i >> 2) + 4 * n + (i & 3); }
struct Unit { int pm, pn; };
struct Gemm { const bf16_t* A; const bf16_t* Bt; int M, N, K; };
struct StaticOrder {
    int nM, nN, nwg, G, c;
    DI void init(int M, int N, int G_, int c_) { nM = M / BM; nN = N / BM; nwg = nM * nN; G = G_; c = c_; }
    DI bool next(int i, Unit& u) const {
        const long L = (long)i * G + c; if (L >= nwg) return false;
        int wgid = (int)L; { const int q = nwg / NXCD, r = nwg % NXCD, xcd = wgid % NXCD, off = wgid / NXCD; wgid = (xcd < r ? xcd * (q + 1) : r * (q + 1) + (xcd - r) * q) + off; }
        const int nig = WGM * nN, gid = wgid / nig, fm = gid * WGM, gsz = (nM - fm) < WGM ? (nM - fm) : WGM;
        u.pm = fm + ((wgid % nig) % gsz); u.pn = (wgid % nig) / gsz; return true;
    }
};
struct EpiBf16 {
    bf16_t* O; int ldc;
    DI void operator()(const f32x4 (&acc)[2][2][4][2], const Unit& u, int wr, int wc, int fr, int fq) const {
        const int row0 = u.pm * BM + wr * 64 + fr; const int col0 = u.pn * BM + wc * 32 + 8 * fq;
#pragma unroll
        for (int ai = 0; ai < 2; ++ai)
#pragma unroll
            for (int m = 0; m < 4; ++m) { bf16_t* rowp = O + (size_t)(row0 + ai * HALF + m * 16) * ldc + col0;
#pragma unroll
                for (int bj = 0; bj < 2; ++bj) { const f32x4 v0 = acc[ai][bj][m][0], v1 = acc[ai][bj][m][1];
                    u32x4 w; w.x = pk2(v0[0], v0[1]); w.y = pk2(v0[2], v0[3]); w.z = pk2(v1[0], v1[1]); w.w = pk2(v1[2], v1[3]);
                    *(u32x4*)(rowp + bj * HALF) = w; } }
    }
};

DI void gemm_phase(LAS unsigned char* lds, const Gemm g, const StaticOrder& S, const EpiBf16& E) {
    const int tid = otid(), wid = __builtin_amdgcn_readfirstlane(tid >> 6), lane = tid & 63, wr = wid >> 2, wc = wid & 3, fr = lane & 15, fq = lane >> 4;
    const int K = g.K, nt = K / BK;
    unsigned voffA[2], voffB[2];
#pragma unroll
    for (int i = 0; i < 2; ++i) { int R, C; stage_rc(tid * 16 + i * 8192, R, C); const int Rb = (R & ~31) + perm32(R & 31);
        voffA[i] = (unsigned)(R * K + C) * 2u; voffB[i] = (unsigned)(Rb * K + C) * 2u; }
    const size_t kstep = (size_t)(BK * 2);
    const size_t hstep = (size_t)HALF * K * 2;
    const size_t tstep = 2 * hstep;
    const unsigned ldsw = (unsigned)wid * 1024u;
    const int aoff = lds_byte(wr * 64 + fr, fq * 8), boff = lds_byte(wc * 32 + fr, fq * 8);
#define PG8_SA(b, h) (((b) * 2 + (h)) * HTB)
#define PG8_SB(b, h) ((4 + (b) * 2 + (h)) * HTB)
#define PG8_STAGE(bufoff, gbase, voff) do { _Pragma("unroll") for (int _i = 0; _i < 2; ++_i) \
        __builtin_amdgcn_global_load_lds((const unsigned*)((const char*)(gbase) + (voff)[_i]), (LAS unsigned*)(lds + (bufoff) + ldsw + _i * 8192), 16, 0, 0); } while (0)
#define PG8_LDA(dst, b, h) do { _Pragma("unroll") for (int m = 0; m < 4; ++m) _Pragma("unroll") for (int k = 0; k < 2; ++k) dst[m][k] = *(const LAS bf16x8*)(lds + PG8_SA(b, h) + aoff + m * 2048 + k * 1024); } while (0)
#define PG8_LDB(dst, b, h) do { _Pragma("unroll") for (int n = 0; n < 2; ++n) _Pragma("unroll") for (int k = 0; k < 2; ++k) dst[n][k] = *(const LAS bf16x8*)(lds + PG8_SB(b, h) + boff + n * 2048 + k * 1024); } while (0)
#define PG8_MMA(ai, bj, At, Bt) do { __builtin_amdgcn_s_setprio(1); _Pragma("unroll") for (int m = 0; m < 4; ++m) _Pragma("unroll") for (int n = 0; n < 2; ++n) _Pragma("unroll") for (int k = 0; k < 2; ++k) \
        acc[ai][bj][m][n] = __builtin_amdgcn_mfma_f32_16x16x32_bf16(Bt[n][k], At[m][k], acc[ai][bj][m][n], 0, 0, 0); __builtin_amdgcn_s_setprio(0); } while (0)
#define PG8_WAIT_V(n) asm volatile("s_waitcnt vmcnt(" #n ")" ::: "memory")
#define PG8_WAIT_L(n) asm volatile("s_waitcnt lgkmcnt(" #n ")" ::: "memory")
#define PG8_BAR __builtin_amdgcn_s_barrier()
#define PG8_SCHED __builtin_amdgcn_sched_barrier(0)
    Unit cur, nxt; int ui = 0;
    if (!S.next(0, cur)) return;
    f32x4 acc[2][2][4][2];
#pragma unroll
    for (int a = 0; a < 2; ++a)
#pragma unroll
        for (int b = 0; b < 2; ++b)
#pragma unroll
            for (int m = 0; m < 4; ++m)
#pragma unroll
                for (int n = 0; n < 2; ++n) acc[a][b][m][n] = (f32x4){0.f, 0.f, 0.f, 0.f};
    bf16x8 At[4][2], B0[2][2], B1[2][2];
    const char* cA = (const char*)g.A + (size_t)cur.pm * tstep; const char* cB = (const char*)g.Bt + (size_t)cur.pn * tstep;
    PG8_STAGE(PG8_SB(0, 0), cB, voffB); PG8_STAGE(PG8_SA(0, 0), cA, voffA); PG8_STAGE(PG8_SB(0, 1), cB + hstep, voffB); PG8_STAGE(PG8_SA(0, 1), cA + hstep, voffA);
    if (wr == 1) PG8_BAR;
    PG8_WAIT_V(4); PG8_BAR;
    PG8_STAGE(PG8_SB(1, 0), cB + kstep, voffB); PG8_STAGE(PG8_SA(1, 0), cA + kstep, voffA); PG8_STAGE(PG8_SB(1, 1), cB + hstep + kstep, voffB);
    PG8_WAIT_V(6); PG8_BAR;
    for (;;) {
        const bool has_next = S.next(ui + 1, nxt);
        const char* nA = has_next ? (const char*)g.A + (size_t)nxt.pm * tstep : cA; const char* nB = has_next ? (const char*)g.Bt + (size_t)nxt.pn * tstep : cB;
        for (int t = 0; t < nt; t += 2) {
            const bool last = (t == nt - 2);
            const char* a1 = cA + (size_t)(t + 1) * kstep;
            const char* a2 = last ? nA : cA + (size_t)(t + 2) * kstep; const char* b2 = last ? nB : cB + (size_t)(t + 2) * kstep;
            const char* a3 = a2 + kstep; const char* b3 = b2 + kstep;
            PG8_LDB(B0, 0, 0); PG8_SCHED; PG8_LDA(At, 0, 0); PG8_STAGE(PG8_SA(1, 1), a1 + hstep, voffA);
            PG8_WAIT_L(8); PG8_BAR; PG8_WAIT_L(0); PG8_MMA(0, 0, At, B0); PG8_BAR; PG8_SCHED;
            PG8_LDB(B1, 0, 1); PG8_STAGE(PG8_SB(0, 0), b2, voffB);
            PG8_BAR; PG8_WAIT_L(0); PG8_MMA(0, 1, At, B1); PG8_BAR;
            PG8_LDA(At, 0, 1); PG8_STAGE(PG8_SA(0, 0), a2, voffA);
            PG8_BAR; PG8_WAIT_L(0); PG8_MMA(1, 0, At, B0); PG8_BAR; PG8_SCHED;
            PG8_STAGE(PG8_SB(0, 1), b2 + hstep, voffB);
            PG8_WAIT_V(6); PG8_BAR; PG8_MMA(1, 1, At, B1); PG8_BAR;
            PG8_LDB(B0, 1, 0); PG8_SCHED; PG8_LDA(At, 1, 0); PG8_STAGE(PG8_SA(0, 1), a2 + hstep, voffA);
            PG8_WAIT_L(8); PG8_BAR; PG8_WAIT_L(0); PG8_MMA(0, 0, At, B0); PG8_BAR; PG8_SCHED;
            PG8_LDB(B1, 1, 1); PG8_STAGE(PG8_SB(1, 0), b3, voffB);
            PG8_BAR; PG8_WAIT_L(0); PG8_MMA(0, 1, At, B1); PG8_BAR;
            PG8_LDA(At, 1, 1); PG8_STAGE(PG8_SA(1, 0), a3, voffA);
            PG8_BAR; PG8_WAIT_L(0); PG8_MMA(1, 0, At, B0); PG8_BAR; PG8_SCHED;
            PG8_STAGE(PG8_SB(1, 1), b3 + hstep, voffB);
            PG8_WAIT_V(6); PG8_BAR; PG8_MMA(1, 1, At, B1); PG8_BAR;
        }
        E(acc, cur, wr, wc, fr, fq);
        if (!has_next) break;
#pragma unroll
        for (int a = 0; a < 2; ++a)
#pragma unroll
            for (int b = 0; b < 2; ++b)
#pragma unroll
                for (int m = 0; m < 4; ++m)
#pragma unroll
                    for (int n = 0; n < 2; ++n) acc[a][b][m][n] = (f32x4){0.f, 0.f, 0.f, 0.f};
        cur = nxt; cA = nA; cB = nB; ++ui;
    }
    PG8_WAIT_V(0);
    if (wr == 0) PG8_BAR;
    PG8_BAR;
#undef PG8_SA
#undef PG8_SB
#undef PG8_STAGE
#undef PG8_LDA
#undef PG8_LDB
#undef PG8_MMA
#undef PG8_WAIT_V
#undef PG8_WAIT_L
#undef PG8_BAR
#undef PG8_SCHED
}
}

DI void adaln_item(const P& p, int a, unsigned char* smem) {
    float* sc = (float*)smem;
    float* red = sc + 5 * 2048;
    float* mod = (float*)(p.ws + WS_MOD);
    const int tid = otid();
    for (int e = tid; e < 5 * 2048; e += 512) { const int r = e >> 11, k = e & 2047; const float v = r < 4 ? p.c[r * 2048 + k] : p.c_ctx[k]; sc[e] = siluf(v); }
    __syncthreads();
    const int l = a / 96, j0 = (a % 96) * 64, cg4 = (tid & 15) * 4, kg = tid >> 4;
    const float* w = p.ada_w + (size_t)l * 2048 * 6144 + j0 + cg4;
    f32x4 acc[5];
#pragma unroll
    for (int r = 0; r < 5; ++r) acc[r] = (f32x4){0.f, 0.f, 0.f, 0.f};
#pragma unroll 1
    for (int i0 = 0; i0 < 64; i0 += 16) {
        f32x4 wv[16];
#pragma unroll
        for (int i = 0; i < 16; ++i) wv[i] = __builtin_nontemporal_load((const f32x4*)(w + (size_t)(kg + 32 * (i0 + i)) * 6144));
#pragma unroll
        for (int i = 0; i < 16; ++i) {
            const int k = kg + 32 * (i0 + i);
#pragma unroll
            for (int r = 0; r < 5; ++r) acc[r] += wv[i] * sc[r * 2048 + k];
        }
    }
#pragma unroll
    for (int r = 0; r < 5; ++r) *(f32x4*)(red + (kg * 5 + r) * 64 + cg4) = acc[r];
    __syncthreads();
    if (tid < 320) {
        const int r = tid >> 6, tx = tid & 63; float sum = 0.f;
#pragma unroll
        for (int k2 = 0; k2 < 32; ++k2) sum += red[(k2 * 5 + r) * 64 + tx];
        mod[(l * 5 + r) * 6144 + j0 + tx] = sum + p.ada_b[l * 6144 + j0 + tx];
    }
    __syncthreads();
}

DI void transpose_item(const float* src, int ld, int srcoff, bf16_t* dst, int kt, int nt, unsigned char* smem) {
    float* tile = (float*)smem;
    const int tid = otid();
#pragma unroll
    for (int i = 0; i < 8; ++i) {
        const int kr = (tid >> 6) + 8 * i, nc = (tid & 63) * 4;
        const f32x4 v = __builtin_nontemporal_load((const f32x4*)(src + (size_t)(kt * 64 + kr) * ld + srcoff + nt * 256 + nc));
        tile[kr * 257 + nc + 0] = v[0]; tile[kr * 257 + nc + 1] = v[1]; tile[kr * 257 + nc + 2] = v[2]; tile[kr * 257 + nc + 3] = v[3];
    }
    __syncthreads();
    {
        const int n = tid >> 1, k0 = (tid & 1) * 32;
#pragma unroll
        for (int k8 = 0; k8 < 4; ++k8) {
            float o[8];
#pragma unroll
            for (int j = 0; j < 8; ++j) o[j] = tile[(k0 + 8 * k8 + j) * 257 + n];
            *(u32x4*)(dst + (size_t)(nt * 256 + n) * 2048 + kt * 64 + k0 + 8 * k8) = pack8(o);
        }
    }
    __syncthreads();
}
DI void narrow_item(const float* src, bf16_t* dst, int kt) {
    const int tid = otid();
#pragma unroll
    for (int j = 0; j < 6; ++j) {
        const int e = tid + 512 * j, kr = e / 48, cn = e % 48;
        const int sc = cn < 32 ? 1024 + cn : 3104 + (cn - 32);
        dst[(size_t)cn * 2048 + kt * 64 + kr] = f2bf(src[(size_t)(kt * 64 + kr) * INW + sc]);
    }
}
DI void skinny_tile(const P& p, int l, int r0, float* red) {
    const bf16_t* A = (const bf16_t*)(p.ws + WS_NBUF);
    const bf16_t* Bt = (const bf16_t*)(p.ws + WS_WNT) + (size_t)l * NNAR * DM;
    float* G = (float*)(p.ws + WS_G);
    const int tid = otid(), w = tid >> 6, lane = tid & 63, l15 = lane & 15, g = lane >> 4;
    f32x4 acc[3];
#pragma unroll
    for (int n = 0; n < 3; ++n) acc[n] = (f32x4){0.f, 0.f, 0.f, 0.f};
    const bf16_t* ap = A + (size_t)(r0 + l15) * DM + 256 * w + 8 * g;
    const bf16_t* bp = Bt + (size_t)l15 * DM + 256 * w + 8 * g;
#pragma unroll
    for (int ks = 0; ks < 8; ++ks) {
        const bf16x8 a0 = *(const bf16x8*)(ap + 32 * ks);
#pragma unroll
        for (int n = 0; n < 3; ++n) acc[n] = mfma16(a0, *(const bf16x8*)(bp + (size_t)16 * n * DM + 32 * ks), acc[n]);
    }
#pragma unroll
    for (int n = 0; n < 3; ++n)
#pragma unroll
        for (int r = 0; r < 4; ++r) red[w * 768 + (4 * g + r) * 48 + 16 * n + l15] = acc[n][r];
    __syncthreads();
    for (int e = tid; e < 768; e += 512) {
        float sum = 0.f;
#pragma unroll
        for (int k = 0; k < 8; ++k) sum += red[k * 768 + e];
        G[(size_t)r0 * NNAR + e] = sum;
    }
    __syncthreads();
}

DI void norm0_phase(const P& p, unsigned char* smem, unsigned* qctr, volatile LAS unsigned* qw) {
    const int tid = otid(); const int wave = tid >> 6, lane = tid & 63;
    const float* mod = (const float*)(p.ws + WS_MOD);
    bf16_t* nb = (bf16_t*)(p.ws + WS_NBUF);
    unsigned nxt = 0u;
    if (threadIdx.x == 0) qw[0] = __hip_atomic_fetch_add(qctr, 1u, __ATOMIC_RELAXED, __HIP_MEMORY_SCOPE_AGENT);
    __syncthreads();
    int rt = (int)qw[0];
    __syncthreads();
    while (rt < NROW / 16) {
      if (threadIdx.x == 0) nxt = __hip_atomic_fetch_add(qctr, 1u, __ATOMIC_RELAXED, __HIP_MEMORY_SCOPE_AGENT);
      for (int rr = 0; rr < 2; ++rr) {
        const int row = rt * 16 + wave * 2 + rr;
        const float* h = row < NLAT ? p.x + (size_t)row * DM : p.ctx + (size_t)(row - NLAT) * DM;
        const int mr = row < NLAT ? (row >> 11) : 4;
        f32x4 v[8]; float ss = 0.f;
#pragma unroll
        for (int i = 0; i < 8; ++i) { v[i] = __builtin_nontemporal_load((const f32x4*)(h + i * 256 + lane * 4)); ss += v[i][0] * v[i][0] + v[i][1] * v[i][1] + v[i][2] * v[i][2] + v[i][3] * v[i][3]; }
        ss = wave_sum(ss);
        const float rstd = rsqrtf(ss * (1.f / 2048.f) + 1e-6f);
        const float* md = mod + (size_t)mr * 6144;
#pragma unroll
        for (int i = 0; i < 8; ++i) {
            const int j = i * 256 + lane * 4;
            const f32x4 gw = *(const f32x4*)(p.norm_pre + j), sh = *(const f32x4*)(md + j), scl = *(const f32x4*)(md + 2048 + j);
            float o[4];
#pragma unroll
            for (int e = 0; e < 4; ++e) o[e] = v[i][e] * rstd * gw[e] * (1.f + scl[e]) + sh[e];
            u32x2 w; w.x = pk2(o[0], o[1]); w.y = pk2(o[2], o[3]);
            *(u32x2*)(nb + (size_t)row * DM + j) = w;
        }
      }
      asm volatile("s_waitcnt vmcnt(0)" ::: "memory"); __syncthreads();
      skinny_tile(p, 0, rt * 16, (float*)smem);
      if (threadIdx.x == 0) qw[0] = nxt;
      __syncthreads();
      rt = (int)qw[0];
      __syncthreads();
    }
}

DI void post_phase(const P& p, int l, unsigned char* smem, int t0, int t1, int bstart, int bstride) {
    const int tid = otid(); const int wave = tid >> 6, lane = tid & 63;
    const float* mod = (const float*)(p.ws + WS_MOD);
    bf16_t* nb = (bf16_t*)(p.ws + WS_NBUF);
    const bf16_t* yo = (const bf16_t*)(p.ws + WS_SBUF);
    float* hc = (float*)(p.ws + WS_HC);
    for (int rt = t0 + osgpr(bstart); rt < t1; rt += bstride) {
      for (int rr = 0; rr < 2; ++rr) {
        const int row = rt * 16 + wave * 2 + rr;
        const int mr = row < NLAT ? (row >> 11) : 4;
        const float* h = l == 0 ? (row < NLAT ? p.x + (size_t)row * DM : p.ctx + (size_t)(row - NLAT) * DM) : p.out + (size_t)row * DM;
        float* hdst = row < NLAT ? p.out + (size_t)row * DM : hc + (size_t)(row - NLAT) * DM;
        f32x4 y[8]; float ss = 0.f;
#pragma unroll
        for (int i = 0; i < 8; ++i) {
            const u32x2 w = __builtin_nontemporal_load((const u32x2*)(yo + (size_t)row * DM + i * 256 + lane * 4));
            y[i] = (f32x4){lo16(w.x), hi16(w.x), lo16(w.y), hi16(w.y)};
            ss += y[i][0] * y[i][0] + y[i][1] * y[i][1] + y[i][2] * y[i][2] + y[i][3] * y[i][3];
        }
        ss = wave_sum(ss);
        const float rstd = rsqrtf(ss * (1.f / 2048.f) + 1e-6f);
        const float* md = mod + (size_t)(l * 5 + mr) * 6144;
        float ss2 = 0.f;
#pragma unroll
        for (int i = 0; i < 8; ++i) {
            const int j = i * 256 + lane * 4;
            const f32x4 hv = __builtin_nontemporal_load((const f32x4*)(h + j)), gt = *(const f32x4*)(md + 4096 + j), nw = *(const f32x4*)(p.norm_post + l * DM + j);
#pragma unroll
            for (int e = 0; e < 4; ++e) { y[i][e] = hv[e] + gt[e] * (y[i][e] * rstd * nw[e]); ss2 += y[i][e] * y[i][e]; }
            __builtin_nontemporal_store(y[i], (f32x4*)(hdst + j));
        }
        if (l == 0) {
            ss2 = wave_sum(ss2);
            const float rstd2 = rsqrtf(ss2 * (1.f / 2048.f) + 1e-6f);
            const float* md1 = mod + (size_t)(5 + mr) * 6144;
#pragma unroll
            for (int i = 0; i < 8; ++i) {
                const int j = i * 256 + lane * 4;
                const f32x4 gw = *(const f32x4*)(p.norm_pre + DM + j), sh = *(const f32x4*)(md1 + j), scl = *(const f32x4*)(md1 + 2048 + j);
                float o[4];
#pragma unroll
                for (int e = 0; e < 4; ++e) o[e] = y[i][e] * rstd2 * gw[e] * (1.f + scl[e]) + sh[e];
                u32x2 w; w.x = pk2(o[0], o[1]); w.y = pk2(o[2], o[3]);
                *(u32x2*)(nb + (size_t)row * DM + j) = w;
            }
        }
      }
      if (l == 0) { asm volatile("s_waitcnt vmcnt(0)" ::: "memory"); __syncthreads(); skinny_tile(p, 1, rt * 16, (float*)smem); }
    }
}

DI void conv_item(const P& p, int l, int r32) {
    const bf16_t* S = (const bf16_t*)(p.ws + WS_SBUF);
    bf16_t* Y = (bf16_t*)(p.ws + WS_YBUF);
    const int tid = otid(); const int row0 = r32 * 32 + (tid >> 6) * 4, ch = (tid & 63) * 8;
    int t0, len;
    if (row0 < NLAT) { t0 = row0 & 2047; len = SL; } else { t0 = (row0 - NLAT) & 255; len = CL; }
    u32x4 rc[6], rh[6], rb[4], rg[4];
#pragma unroll
    for (int k = 0; k < 6; ++k) {
        int tt = t0 + k - 1; const int tcl = tt < 0 ? 0 : (tt >= len ? len - 1 : tt);
        const bf16_t* rp = S + (size_t)(row0 + (tcl - t0)) * NP;
        rc[k] = __builtin_nontemporal_load((const u32x4*)(rp + C_SC_C + ch)); rh[k] = __builtin_nontemporal_load((const u32x4*)(rp + C_SC_H + ch));
    }
#pragma unroll
    for (int k = 0; k < 4; ++k) { const bf16_t* rp = S + (size_t)(row0 + k) * NP; rb[k] = __builtin_nontemporal_load((const u32x4*)(rp + C_SC_B + ch)); rg[k] = __builtin_nontemporal_load((const u32x4*)(rp + C_SC_G + ch)); }
    f32x4 w0[3], w1[3];
#pragma unroll
    for (int j = 0; j < 3; ++j) { const float* w = p.sc_conv + (size_t)(l * 3 + j) * 512 + ch; w0[j] = *(const f32x4*)w; w1[j] = *(const f32x4*)(w + 4); }
    float prod[6][8];
#pragma unroll
    for (int k = 0; k < 6; ++k) {
        const int tt = t0 + k - 1; const float msk = (tt >= 0 && tt < len) ? 1.f : 0.f;
        float cc[8], hh[8]; unpack8(rc[k], cc); unpack8(rh[k], hh);
#pragma unroll
        for (int e = 0; e < 8; ++e) prod[k][e] = cc[e] * hh[e] * msk;
    }
#pragma unroll
    for (int k = 0; k < 4; ++k) {
        float bb[8], gg[8], o[8]; unpack8(rb[k], bb); unpack8(rg[k], gg);
#pragma unroll
        for (int e = 0; e < 8; ++e) {
            const float wa = e < 4 ? w0[0][e & 3] : w1[0][e & 3], wb = e < 4 ? w0[1][e & 3] : w1[1][e & 3], wc = e < 4 ? w0[2][e & 3] : w1[2][e & 3];
            const float acc = wa * prod[k][e] + wb * prod[k + 1][e] + wc * prod[k + 2][e];
            o[e] = bb[e] * acc * siluf(gg[e]);
        }
        *(u32x4*)(Y + (size_t)(row0 + k) * DM + 1024 + ch) = pack8(o);
    }
}

DI void finish_item(const P& p, int l, int r16) {
    const bf16_t* S = (const bf16_t*)(p.ws + WS_SBUF);
    bf16_t* Y = (bf16_t*)(p.ws + WS_YBUF);
    const bf16_t* O = (const bf16_t*)(p.ws + WS_NBUF);
    const int tid = otid(); const int row0 = r16 * 16 + (tid >> 7) * 4, u = tid & 127, mx = u >> 6, hh = (u >> 4) & 3, sub = u & 15;
    const int chn = 128 * hh + 8 * sub;
    u32x4 ra[4], rb[4], rg[4];
#pragma unroll
    for (int k = 0; k < 4; ++k) {
        ra[k] = __builtin_nontemporal_load((const u32x4*)(O + ((size_t)(mx * 2 + 0) * NROW + row0 + k) * 512 + chn));
        rb[k] = __builtin_nontemporal_load((const u32x4*)(O + ((size_t)(mx * 2 + 1) * NROW + row0 + k) * 512 + chn));
        rg[k] = __builtin_nontemporal_load((const u32x4*)(S + (size_t)(row0 + k) * NP + (mx ? C_GDN_G : C_GLA_G) + chn));
    }
    const float* nwp = (mx ? p.gdn_norm : p.gla_norm) + l * 128 + 8 * sub;
    const f32x4 nw0 = *(const f32x4*)nwp, nw1 = *(const f32x4*)(nwp + 4);
#pragma unroll
    for (int k = 0; k < 4; ++k) {
        float a[8], b[8], o[8], gt[8];
        unpack8(ra[k], a); unpack8(rb[k], b); unpack8(rg[k], gt);
        float ss = 0.f;
#pragma unroll
        for (int e = 0; e < 8; ++e) { o[e] = a[e] + b[e]; ss += o[e] * o[e]; }
        ss += __shfl_xor(ss, 1); ss += __shfl_xor(ss, 2); ss += __shfl_xor(ss, 4); ss += __shfl_xor(ss, 8);
        const float rstd = rsqrtf(ss * (1.f / 128.f) + 1e-6f);
#pragma unroll
        for (int e = 0; e < 8; ++e) o[e] = o[e] * rstd * (e < 4 ? nw0[e & 3] : nw1[e & 3]) * siluf(gt[e]);
        *(u32x4*)(Y + (size_t)(row0 + k) * DM + 512 * mx + chn) = pack8(o);
    }
}

DI void gla_prep_item(const P& p, int l, int item, unsigned char* smem) {
    const int c = item % 72, bd = item / 72, dir = bd & 1, b = bd >> 1;
    float* slr = (float*)smem;
    float* stot = slr + 512;
    float* slast = stot + 256;
    bf16_t* sq = (bf16_t*)(slast + 256);
    bf16_t* sk = sq + 4 * 32 * 72;
    const bf16_t* S = (const bf16_t*)(p.ws + WS_SBUF);
    bf16_t* QT = (bf16_t*)(p.ws + WS_GLA_QT); bf16_t* KO = (bf16_t*)(p.ws + WS_GLA_KO); bf16_t* AT = (bf16_t*)(p.ws + WS_GLA_AT); float* DC = (float*)(p.ws + WS_GLA_DC);
    const int tid = otid();
    { const int i = tid >> 4, r = tid & 15; slr[i * 16 + r] = ((const float*)(p.ws + WS_G))[(size_t)prow(b, dir, 32 * c + i) * NNAR + G_LR + 16 * dir + r]; }
    __syncthreads();
    const int cch = tid & 255, half = tid >> 8, h = cch >> 6, d = cch & 63;
    bf16_t qraw[16], kraw[16];
#pragma unroll
    for (int ii = 0; ii < 16; ++ii) { const size_t row = (size_t)prow(b, dir, 32 * c + 16 * half + ii); qraw[ii] = S[row * NP + C_GLA_Q + cch]; kraw[ii] = S[row * NP + C_GLA_K + cch]; }
    float wd[16];
#pragma unroll
    for (int r = 0; r < 16; ++r) wd[r] = p.gla_wd[((size_t)(l * 2 + dir) * 16 + r) * 256 + cch];
    const float bdv = p.gla_bd[(l * 2 + dir) * 256 + cch];
    float cum[16]; float run = 0.f;
#pragma unroll
    for (int ii = 0; ii < 16; ++ii) {
        const int i = 16 * half + ii; float z = bdv;
#pragma unroll
        for (int r = 0; r < 16; ++r) z += slr[i * 16 + r] * wd[r];
        const float ls = fminf(z, 0.f) - __logf(1.f + __expf(-fabsf(z)));
        run += ls * (1.f / 16.f); cum[ii] = run;
    }
    if (half == 0) stot[cch] = run;
    __syncthreads();
    if (half == 1) { const float t = stot[cch];
#pragma unroll
        for (int ii = 0; ii < 16; ++ii) cum[ii] += t;
        slast[cch] = cum[15]; }
    __syncthreads();
    const float cl = slast[cch];
    const int seq = (dir * 4 + b) * 4 + h;
#pragma unroll
    for (int ii = 0; ii < 16; ++ii) {
        const int i = 16 * half + ii, pp = 32 * c + i;
        const float q = bf2f(qraw[ii]) * 0.125f, k = bf2f(kraw[ii]);
        const float qt = q * __expf(cum[ii]), kt = k * __expf(-cum[ii]), ko = k * __expf(cl - cum[ii]);
        QT[((size_t)seq * PT + pp) * 64 + d] = f2bf(qt); KO[((size_t)seq * PT + pp) * 64 + d] = f2bf(ko);
        sq[(h * 32 + i) * 72 + d] = f2bf(qt); sk[(h * 32 + i) * 72 + d] = f2bf(kt);
    }
    if (half == 0) DC[((size_t)seq * 72 + c) * 64 + d] = __expf(cl);
    __syncthreads();
    {
        const int w = tid >> 6, lane = tid & 63, l15 = lane & 15, g = lane >> 4, hh = w >> 1, mt = w & 1;
        const int seqh = (dir * 4 + b) * 4 + hh;
#pragma unroll
        for (int nt = 0; nt < 2; ++nt) {
            f32x4 acc = (f32x4){0.f, 0.f, 0.f, 0.f};
#pragma unroll
            for (int ks = 0; ks < 2; ++ks) {
                const bf16x8 a = ld8(sq + (hh * 32 + 16 * mt + l15) * 72 + 32 * ks + 8 * g), bb = ld8(sk + (hh * 32 + 16 * nt + l15) * 72 + 32 * ks + 8 * g);
                acc = mfma16(bb, a, acc);
            }
            const int i = 16 * mt + l15, j0 = 16 * nt + 4 * g;
            u32x2 ov; ov.x = pk2(j0 <= i ? acc[0] : 0.f, j0 + 1 <= i ? acc[1] : 0.f); ov.y = pk2(j0 + 2 <= i ? acc[2] : 0.f, j0 + 3 <= i ? acc[3] : 0.f);
            *(u32x2*)(AT + (((size_t)seqh * 72 + c) * 32 + i) * 32 + j0) = ov;
        }
    }
    __syncthreads();
}

struct GlaRegs { u32x4 rv, rq, ra; float rd; };
DI void gla_scan_item(const P& p, int seq, unsigned char* smem) {
    const int dir = seq >> 4, b = (seq >> 2) & 3, h = seq & 3;
    constexpr int BUFB = 20736;
    const bf16_t* S = (const bf16_t*)(p.ws + WS_SBUF);
    const bf16_t* QT = (const bf16_t*)(p.ws + WS_GLA_QT); const bf16_t* KO = (const bf16_t*)(p.ws + WS_GLA_KO); const bf16_t* AT = (const bf16_t*)(p.ws + WS_GLA_AT); const float* DC = (const float*)(p.ws + WS_GLA_DC);
    bf16_t* OG = (bf16_t*)(p.ws + WS_NBUF) + (size_t)dir * NROW * 512;
    const int tid = otid(), w = tid >> 6, lane = tid & 63, l15 = lane & 15, g = lane >> 4, q4 = l15 >> 2, p4 = l15 & 3;
    auto loadr = [&](GlaRegs& R, int c) {
        if (c >= 72) return;
        { const int pos = tid >> 4, ch = tid & 15; R.rv = *(const u32x4*)(S + (size_t)prow(b, dir, 32 * c + pos) * NP + C_GLA_V + 128 * h + 8 * ch); }
        { const int t2 = tid & 255, pos = t2 >> 3, ch = t2 & 7; const bf16_t* src = (tid < 256 ? QT : KO) + ((size_t)seq * PT + 32 * c + pos) * 64 + 8 * ch; R.rq = __builtin_nontemporal_load((const u32x4*)src); }
        if (tid < 128) { const int i = tid >> 2, ch = tid & 3; R.ra = __builtin_nontemporal_load((const u32x4*)(AT + (((size_t)seq * 72 + c) * 32 + i) * 32 + 8 * ch)); }
        if (tid >= 128 && tid < 192) R.rd = DC[((size_t)seq * 72 + c) * 64 + (tid - 128)];
    };
    auto storel = [&](const GlaRegs& R, int buf) {
        unsigned char* base = smem + buf * BUFB;
        bf16_t* sat = (bf16_t*)base; bf16_t* sqt = (bf16_t*)(base + 2560); bf16_t* sko = (bf16_t*)(base + 2560 + 4608); bf16_t* sv = (bf16_t*)(base + 2560 + 9216); float* sdc = (float*)(base + 2560 + 9216 + 8704);
        { const int pos = tid >> 4, ch = tid & 15; *(u32x4*)(sv + pos * 136 + 8 * ch) = R.rv; }
        { const int t2 = tid & 255, pos = t2 >> 3, ch = t2 & 7; *(u32x4*)((tid < 256 ? sqt : sko) + pos * 72 + 8 * ch) = R.rq; }
        if (tid < 128) { const int i = tid >> 2, ch = tid & 3; *(u32x4*)(sat + i * 40 + 8 * ch) = R.ra; }
        if (tid >= 128 && tid < 192) sdc[tid - 128] = R.rd;
    };
    f32x4 st[4];
#pragma unroll
    for (int i = 0; i < 4; ++i) st[i] = (f32x4){0.f, 0.f, 0.f, 0.f};
    const int sgn = dir ? -1 : 1;
    auto compute = [&](int c) {
        const unsigned char* base = smem + (c & 1) * BUFB;
        const bf16_t* sat = (const bf16_t*)base; const bf16_t* sqt = (const bf16_t*)(base + 2560); const bf16_t* sko = (const bf16_t*)(base + 2560 + 4608); const bf16_t* sv = (const bf16_t*)(base + 2560 + 9216); const float* sdc = (const float*)(base + 2560 + 9216 + 8704);
        const int dv0 = 16 * w;
        const bf16x8 vb = tr2(sv + (8 * g + q4) * 136 + dv0 + 4 * p4, sv + (8 * g + 4 + q4) * 136 + dv0 + 4 * p4);
        bf16x8 bs[2];
        bs[0] = packacc(st[0], st[1]); bs[1] = packacc(st[2], st[3]);
#pragma unroll
        for (int mt = 0; mt < 2; ++mt) {
            f32x4 acc = (f32x4){0.f, 0.f, 0.f, 0.f};
            acc = mfma16(vb, ld8(sat + (16 * mt + l15) * 40 + 8 * g), acc);
#pragma unroll
            for (int ks = 0; ks < 2; ++ks) {
                const bf16_t* r0 = sqt + (16 * mt + l15) * 72 + 32 * ks + 4 * g;
                acc = mfma16(bs[ks], ld4x2(r0, r0 + 16), acc);
            }
            bf16_t* ob = OG + (size_t)prow(b, dir, 32 * c) * 512 + 128 * h;
            u32x2 ov; ov.x = pk2(acc[0], acc[1]); ov.y = pk2(acc[2], acc[3]);
            *(u32x2*)(ob + sgn * ((16 * mt + l15) * 512) + dv0 + 4 * g) = ov;
        }
#pragma unroll
        for (int dt = 0; dt < 4; ++dt) {
            const bf16x8 ak = tr2(sko + (8 * g + q4) * 72 + 16 * dt + 4 * p4, sko + (8 * g + 4 + q4) * 72 + 16 * dt + 4 * p4);
#pragma unroll
            for (int r = 0; r < 4; ++r) st[dt][r] *= sdc[16 * dt + 4 * g + r];
            st[dt] = mfma16(ak, vb, st[dt]);
        }
    };
    GlaRegs R0, R1, R2, R3, R4, R5;
    loadr(R0, 0); loadr(R1, 1); loadr(R2, 2); loadr(R3, 3); loadr(R4, 4); loadr(R5, 5);
#pragma unroll 1
    for (int c = 0; c < 72; c += 6) {
        storel(R0, 0); __syncthreads(); loadr(R0, c + 6); compute(c);
        storel(R1, 1); __syncthreads(); loadr(R1, c + 7); compute(c + 1);
        storel(R2, 0); __syncthreads(); loadr(R2, c + 8); compute(c + 2);
        storel(R3, 1); __syncthreads(); loadr(R3, c + 9); compute(c + 3);
        storel(R4, 0); __syncthreads(); loadr(R4, c + 10); compute(c + 4);
        storel(R5, 1); __syncthreads(); loadr(R5, c + 11); compute(c + 5);
    }
    __syncthreads();
}

DI void gdn_conv16(const bf16_t* raw, const float* cw, int ti, int cch, float* out) {
#pragma unroll
    for (int e = 0; e < 16; ++e) out[e] = 0.f;
#pragma unroll 1
    for (int j = 0; j < 5; ++j) {
        const bf16_t* rp = raw + (ti + j) * 392 + cch;
        float xv[16];
        unpack8(*(const u32x4*)rp, xv); unpack8(*(const u32x4*)(rp + 8), xv + 8);
        const float* w = cw + j * 384 + cch;
#pragma unroll
        for (int e4 = 0; e4 < 4; ++e4) { const f32x4 wv = *(const f32x4*)(w + 4 * e4);
#pragma unroll
            for (int e = 0; e < 4; ++e) out[4 * e4 + e] += wv[e] * xv[4 * e4 + e]; }
    }
#pragma unroll
    for (int e = 0; e < 16; ++e) out[e] = siluf(out[e]);
}

DI f32x4 mfma4(float a, float b, f32x4 c) { return __builtin_amdgcn_mfma_f32_16x16x4f32(a, b, c, 0, 0, 0); }

DI void gdn_prep_item(const P& p, int l, int item, unsigned char* smem) {
    const int sc = item % 36, bh = item / 36, h = bh & 3, b = bh >> 2;
    constexpr int LS = 68;
    bf16_t* sK = (bf16_t*)smem;
    bf16_t* sKB = sK + 64 * 136;
    bf16_t* sQ = sKB + 64 * 136;
    bf16_t* sVb = sQ + 64 * 136;
    bf16_t* sKEb = sVb + 64 * 136;
    float* sL = (float*)(sKEb + 64 * 136);
    bf16_t* sLb = (bf16_t*)(sL + 64 * LS);
    bf16_t* sTd = sLb + 64 * 72;
    float* sg = (float*)(sTd + 4 * 16 * 24); float* sbeta = sg + 64; float* scum = sbeta + 64;
    const bf16_t* S = (const bf16_t*)(p.ws + WS_SBUF);
    bf16_t* U = (bf16_t*)(p.ws + WS_GDN_U); bf16_t* W = (bf16_t*)(p.ws + WS_GDN_W); bf16_t* QI = (bf16_t*)(p.ws + WS_GDN_QI); bf16_t* KO = (bf16_t*)(p.ws + WS_GDN_KO);
    bf16_t* AT = (bf16_t*)(p.ws + WS_GDN_AT); float* DC = (float*)(p.ws + WS_GDN_DC);
    const int tid = otid(), ti = tid >> 3, sub = tid & 7;
    const int w = __builtin_amdgcn_readfirstlane(tid >> 6), lane = tid & 63, l15 = lane & 15, g = lane >> 4, q4 = l15 >> 2, p4 = l15 & 3;
    int len, base, tlo, nseg, cseg, coff;
    if (sc < 4) { len = CL; base = NLAT + b * CL; cseg = sc; nseg = 4; coff = 0; } else { len = SL; base = b * SL; cseg = sc - 4; nseg = 32; coff = 4; }
    tlo = 64 * cseg;
    const size_t row = (size_t)(base + tlo + ti);
    const float* Gp = (const float*)(p.ws + WS_G) + row * NNAR;
    const float a_raw0 = Gp[G_A + h], a_raw1 = Gp[G_A + 4 + h], b_raw0 = Gp[G_B + h], b_raw1 = Gp[G_B + 4 + h];
    float* sCW = scum + 64;
    bf16_t* raw = (bf16_t*)smem;
    if (tid < 480) { const int j = tid / 96, r = tid % 96, part = r >> 5, e4 = r & 31;
        *(f32x4*)(sCW + j * 384 + part * 128 + 4 * e4) = *(const f32x4*)(p.gdn_conv + ((size_t)l * 5 + j) * 1536 + part * 512 + 128 * h + 4 * e4); }
#pragma unroll
    for (int k = 0; k < 7; ++k) {
        const int e = tid + 512 * k;
        if (e < 68 * 48) {
            const int r = e / 48, pc = e % 48, part = pc >> 4, wi = pc & 15;
            const int tt = tlo - 2 + r;
            u32x4 v = (u32x4){0u, 0u, 0u, 0u};
            if (tt >= 0 && tt < len) v = __builtin_nontemporal_load((const u32x4*)(S + (size_t)(base + tt) * NP + C_GDN_Q + part * 512 + 128 * h + 8 * wi));
            *(u32x4*)(raw + r * 392 + part * 128 + 8 * wi) = v;
        }
    }
    __syncthreads();
    float xq[16], xk[16], xv[16];
    gdn_conv16(raw, sCW, ti, 0 + 16 * sub, xq);
    gdn_conv16(raw, sCW, ti, 128 + 16 * sub, xk);
    gdn_conv16(raw, sCW, ti, 256 + 16 * sub, xv);
    float sq_ = 0.f, sk_ = 0.f;
#pragma unroll
    for (int e = 0; e < 16; ++e) { sq_ += xq[e] * xq[e]; sk_ += xk[e] * xk[e]; }
    sq_ += __shfl_xor(sq_, 1); sq_ += __shfl_xor(sq_, 2); sq_ += __shfl_xor(sq_, 4);
    sk_ += __shfl_xor(sk_, 1); sk_ += __shfl_xor(sk_, 2); sk_ += __shfl_xor(sk_, 4);
    const float rq = rsqrtf(sq_ + 1e-6f) * 0.08838834764831845f, rk = rsqrtf(sk_ + 1e-6f);
#pragma unroll
    for (int e = 0; e < 16; ++e) { xq[e] *= rq; xk[e] *= rk; }
#pragma unroll 1
  for (int dir = 0; dir < 2; ++dir) {
    const int seq = (dir * 4 + b) * 4 + h;
    const int c = coff + (dir ? nseg - 1 - cseg : cseg);
    const int i = dir ? 63 - ti : ti;
    const int pp = 64 * c + i;
    if (sub == 0) {
        const float a_in = dir ? a_raw1 : a_raw0, b_in = dir ? b_raw1 : b_raw0;
        const float A = __expf(p.gdn_alog[(l * 2 + dir) * 4 + h]);
        const float xx = a_in + p.gdn_dtb[(l * 2 + dir) * 4 + h];
        const float sp = fmaxf(xx, 0.f) + log1pf(__expf(-fabsf(xx)));
        sg[i] = -A * sp; sbeta[i] = __builtin_amdgcn_rcpf(1.f + __expf(-b_in));
    }
    __syncthreads();
    if (tid < 64) {
        float v = sg[tid];
#pragma unroll
        for (int o = 1; o < 64; o <<= 1) { const float u = __shfl_up(v, o); if (tid >= o) v += u; }
        scum[tid] = v;
    }
    __syncthreads();
    const float cumi = scum[i], cl = scum[63], bet = sbeta[i], ei = __expf(cumi), eo = __expf(cl - cumi);
    {
        float t1[16], t2[16];
        *(u32x4*)(sK + i * 136 + 16 * sub) = pack8(xk); *(u32x4*)(sK + i * 136 + 16 * sub + 8) = pack8(xk + 8);
        *(u32x4*)(sQ + i * 136 + 16 * sub) = pack8(xq); *(u32x4*)(sQ + i * 136 + 16 * sub + 8) = pack8(xq + 8);
#pragma unroll
        for (int e = 0; e < 16; ++e) { t1[e] = xk[e] * bet; t2[e] = xv[e] * bet; }
        *(u32x4*)(sKB + i * 136 + 16 * sub) = pack8(t1); *(u32x4*)(sKB + i * 136 + 16 * sub + 8) = pack8(t1 + 8);
        *(u32x4*)(sVb + i * 136 + 16 * sub) = pack8(t2); *(u32x4*)(sVb + i * 136 + 16 * sub + 8) = pack8(t2 + 8);
#pragma unroll
        for (int e = 0; e < 16; ++e) t2[e] = t1[e] * ei;
        *(u32x4*)(sKEb + i * 136 + 16 * sub) = pack8(t2); *(u32x4*)(sKEb + i * 136 + 16 * sub + 8) = pack8(t2 + 8);
#pragma unroll
        for (int e = 0; e < 16; ++e) { t1[e] = xq[e] * ei; t2[e] = xk[e] * eo; }
        bf16_t* qd = QI + ((size_t)seq * PT + pp) * 128 + 16 * sub; bf16_t* kd = KO + ((size_t)seq * PT + pp) * 128 + 16 * sub;
        __builtin_nontemporal_store(pack8(t1), (u32x4*)qd); __builtin_nontemporal_store(pack8(t1 + 8), (u32x4*)(qd + 8));
        __builtin_nontemporal_store(pack8(t2), (u32x4*)kd); __builtin_nontemporal_store(pack8(t2 + 8), (u32x4*)(kd + 8));
        if (tid == 0) DC[seq * 36 + c] = __expf(cl);
    }
    __syncthreads();
    {
        const int mt = w >> 1;
#pragma unroll
        for (int n2 = 0; n2 < 2; ++n2) {
            const int nt = 2 * (w & 1) + n2;
            f32x4 aL = (f32x4){0.f, 0.f, 0.f, 0.f}, aA = (f32x4){0.f, 0.f, 0.f, 0.f};
#pragma unroll
            for (int ks = 0; ks < 4; ++ks) {
                const bf16x8 bk = ld8(sK + (16 * nt + l15) * 136 + 32 * ks + 8 * g);
                aL = mfma16(bk, ld8(sKB + (16 * mt + l15) * 136 + 32 * ks + 8 * g), aL);
                aA = mfma16(bk, ld8(sQ + (16 * mt + l15) * 136 + 32 * ks + 8 * g), aA);
            }
            const int ii = 16 * mt + l15, j0 = 16 * nt + 4 * g;
            const f32x4 cj = *(const f32x4*)(scum + j0); const float ci = scum[ii];
            f32x4 lv; float av[4];
#pragma unroll
            for (int r = 0; r < 4; ++r) {
                const float dcy = __expf(fminf(ci - cj[r], 0.f));
                lv[r] = (j0 + r < ii) ? aL[r] * dcy : 0.f;
                av[r] = (j0 + r <= ii) ? aA[r] * dcy : 0.f;
            }
            *(f32x4*)(sL + ii * LS + j0) = lv;
            { u32x2 lb; lb.x = pk2(lv[0], lv[1]); lb.y = pk2(lv[2], lv[3]); *(u32x2*)(sLb + ii * 72 + j0) = lb; }
            { u32x2 ab; ab.x = pk2(av[0], av[1]); ab.y = pk2(av[2], av[3]); *(u32x2*)(AT + (((size_t)seq * 36 + c) * 64 + ii) * 64 + j0) = ab; }
        }
    }
    __syncthreads();
    if (tid < 64) {
        const int I = tid >> 4, cc = tid & 15;
        float tt[16];
#pragma unroll
        for (int r = 0; r < 16; ++r) tt[r] = (r == cc) ? 1.f : 0.f;
#pragma unroll
        for (int j = 0; j < 15; ++j) {
            const float tj = tt[j];
#pragma unroll
            for (int r = j + 1; r < 16; ++r) tt[r] -= sL[(16 * I + r) * LS + 16 * I + j] * tj;
        }
#pragma unroll
        for (int r = 0; r < 16; ++r) sTd[(I * 16 + r) * 24 + cc] = f2bf(tt[r]);
    }
    __syncthreads();
    {
        const bf16_t* Rb = w < 4 ? sVb : sKEb;
        bf16_t* dstb = (w < 4 ? U : W) + ((size_t)seq * PT + 64 * c) * 128;
#pragma unroll
        for (int n2 = 0; n2 < 2; ++n2) {
            const int col0 = 32 * (w & 3) + 16 * n2;
            s16x4 Xb[4];
#pragma unroll
            for (int I = 0; I < 4; ++I) {
                f32x4 accL = (f32x4){0.f, 0.f, 0.f, 0.f};
#pragma unroll
                for (int J = 0; J < I; ++J)
                    accL = __builtin_amdgcn_mfma_f32_16x16x16bf16_1k(*(const s16x4*)(sLb + (16 * I + l15) * 72 + 16 * J + 4 * g), Xb[J], accL, 0, 0, 0);
                f32x4 rhs;
#pragma unroll
                for (int r = 0; r < 4; ++r) rhs[r] = bf2f(Rb[(16 * I + 4 * g + r) * 136 + col0 + l15]) - accL[r];
                u32x2 pb; pb.x = pk2(rhs[0], rhs[1]); pb.y = pk2(rhs[2], rhs[3]);
                const f32x4 X = __builtin_amdgcn_mfma_f32_16x16x16bf16_1k(*(const s16x4*)(sTd + (I * 16 + l15) * 24 + 4 * g), __builtin_bit_cast(s16x4, pb), (f32x4){0.f, 0.f, 0.f, 0.f}, 0, 0, 0);
                u32x2 px; px.x = pk2(X[0], X[1]); px.y = pk2(X[2], X[3]);
                Xb[I] = __builtin_bit_cast(s16x4, px);
#pragma unroll
                for (int r = 0; r < 4; ++r) dstb[(size_t)(16 * I + 4 * g + r) * 128 + col0 + l15] = f2bf(X[r]);
            }
        }
    }
    __syncthreads();
  }
}

struct GdnRegs { u32x4 r[8]; };
DI void gdn_scan_item(const P& p, int item, unsigned char* smem) {
    const int seq = (item & 7) * 4 + (item >> 5), cq = (item >> 3) & 3;
    const int dir = seq >> 4, b = (seq >> 2) & 3, h = seq & 3;
    constexpr int BUFB = 3 * 17408 + 9216 + 5120;
    bf16_t* sVN = (bf16_t*)(smem + 2 * BUFB);
    float* sdec = (float*)(smem + 2 * BUFB + 5120);
    const bf16_t* U = (const bf16_t*)(p.ws + WS_GDN_U); const bf16_t* W = (const bf16_t*)(p.ws + WS_GDN_W); const bf16_t* QI = (const bf16_t*)(p.ws + WS_GDN_QI); const bf16_t* KO = (const bf16_t*)(p.ws + WS_GDN_KO);
    const bf16_t* AT = (const bf16_t*)(p.ws + WS_GDN_AT); const float* DC = (const float*)(p.ws + WS_GDN_DC);
    bf16_t* OG = (bf16_t*)(p.ws + WS_NBUF) + (size_t)(2 + dir) * NROW * 512;
    const int tid = otid(), w = tid >> 6, lane = tid & 63, l15 = lane & 15, g = lane >> 4, q4 = l15 >> 2, p4 = l15 & 3;
    const int mt = w >> 1, nt = w & 1;
    auto loadr = [&](GdnRegs& R, int c) {
        if (c >= 36) return;
        u32x4* rr = R.r;
#pragma unroll
        for (int k = 0; k < 2; ++k) {
            const int e = tid + 512 * k, r = e >> 4, ch = e & 15; const size_t off = ((size_t)seq * PT + 64 * c + r) * 128 + 8 * ch;
            rr[k] = *(const u32x4*)(W + off); rr[2 + k] = *(const u32x4*)(QI + off); rr[4 + k] = *(const u32x4*)(KO + off);
        }
        { const int r = tid >> 3, ch = tid & 7; rr[6] = *(const u32x4*)(AT + (((size_t)seq * 36 + c) * 64 + r) * 64 + 8 * ch); }
        if (tid < 256) { const int r = tid >> 2, ch = tid & 3; rr[7] = __builtin_nontemporal_load((const u32x4*)(U + ((size_t)seq * PT + 64 * c + r) * 128 + 32 * cq + 8 * ch)); }
    };
    auto storel = [&](const GdnRegs& R, int buf) {
        const u32x4* rr = R.r;
        bf16_t* sW = (bf16_t*)(smem + buf * BUFB); bf16_t* sQI = sW + 64 * 136; bf16_t* sKO = sQI + 64 * 136; bf16_t* sAT = sKO + 64 * 136; bf16_t* sU = sAT + 64 * 72;
#pragma unroll
        for (int k = 0; k < 2; ++k) {
            const int e = tid + 512 * k, r = e >> 4, ch = e & 15; const int off = r * 136 + 8 * ch;
            *(u32x4*)(sW + off) = rr[k]; *(u32x4*)(sQI + off) = rr[2 + k]; *(u32x4*)(sKO + off) = rr[4 + k];
        }
        { const int r = tid >> 3, ch = tid & 7; *(u32x4*)(sAT + r * 72 + 8 * ch) = rr[6]; }
        if (tid < 256) { const int r = tid >> 2, ch = tid & 3; *(u32x4*)(sU + r * 40 + 8 * ch) = rr[7]; }
    };
    u32x4* sBS = (u32x4*)(smem + 2 * BUFB + 5120 + 256);
    f32x4 st[2];
    st[0] = (f32x4){0.f, 0.f, 0.f, 0.f}; st[1] = (f32x4){0.f, 0.f, 0.f, 0.f};
    sBS[(nt * 4 + mt) * 64 + lane] = (u32x4){0u, 0u, 0u, 0u};
    if (tid < 36) sdec[tid] = DC[seq * 36 + tid];
    const int sgn = dir ? -1 : 1;
    auto step = [&](GdnRegs& R, int c) {
        storel(R, c & 1);
        __syncthreads();
        loadr(R, c + 3);
        const bf16_t* sW = (const bf16_t*)(smem + (c & 1) * BUFB); const bf16_t* sQI = sW + 64 * 136; const bf16_t* sKO = sQI + 64 * 136; const bf16_t* sAT = sKO + 64 * 136; const bf16_t* sU = sAT + 64 * 72;
        const float dec = sdec[c];
        bf16x8 Bs[4];
#pragma unroll
        for (int ks = 0; ks < 4; ++ks) Bs[ks] = __builtin_bit_cast(bf16x8, sBS[(nt * 4 + ks) * 64 + lane]);
        {
            f32x4 acc = (f32x4){0.f, 0.f, 0.f, 0.f};
#pragma unroll
            for (int ks = 0; ks < 4; ++ks) { const bf16_t* r0 = sW + (16 * mt + l15) * 136 + 32 * ks + 4 * g; acc = mfma16(Bs[ks], ld4x2(r0, r0 + 16), acc); }
            {
                const u32x2 uu = *(const u32x2*)(sU + (16 * mt + l15) * 40 + 16 * nt + 4 * g);
                u32x2 vv; vv.x = pk2(lo16(uu.x) - acc[0], hi16(uu.x) - acc[1]); vv.y = pk2(lo16(uu.y) - acc[2], hi16(uu.y) - acc[3]);
                *(u32x2*)(sVN + (16 * mt + l15) * 40 + 16 * nt + 4 * g) = vv;
            }
        }
        __syncthreads();
        bf16x8 Bv[2];
#pragma unroll
        for (int k2 = 0; k2 < 2; ++k2) Bv[k2] = tr2(sVN + (32 * k2 + 8 * g + q4) * 40 + 16 * nt + 4 * p4, sVN + (32 * k2 + 8 * g + 4 + q4) * 40 + 16 * nt + 4 * p4);
        {
            f32x4 acc = (f32x4){0.f, 0.f, 0.f, 0.f};
#pragma unroll
            for (int ks = 0; ks < 4; ++ks) { const bf16_t* r0 = sQI + (16 * mt + l15) * 136 + 32 * ks + 4 * g; acc = mfma16(Bs[ks], ld4x2(r0, r0 + 16), acc); }
#pragma unroll
            for (int k2 = 0; k2 < 2; ++k2) acc = mfma16(Bv[k2], ld8(sAT + (16 * mt + l15) * 72 + 32 * k2 + 8 * g), acc);
            bf16_t* ob = OG + (size_t)prow(b, dir, 64 * c) * 512 + 128 * h + 32 * cq;
            u32x2 ov; ov.x = pk2(acc[0], acc[1]); ov.y = pk2(acc[2], acc[3]);
            *(u32x2*)(ob + sgn * ((16 * mt + l15) * 512) + 16 * nt + 4 * g) = ov;
        }
#pragma unroll
        for (int j = 0; j < 2; ++j) {
            const int dt = 2 * mt + j;
            st[j] *= dec;
#pragma unroll
            for (int k2 = 0; k2 < 2; ++k2) {
                const bf16x8 ak = tr2(sKO + (32 * k2 + 8 * g + q4) * 136 + 16 * dt + 4 * p4, sKO + (32 * k2 + 8 * g + 4 + q4) * 136 + 16 * dt + 4 * p4);
                st[j] = mfma16(ak, Bv[k2], st[j]);
            }
        }
        sBS[(nt * 4 + mt) * 64 + lane] = __builtin_bit_cast(u32x4, packacc(st[0], st[1]));
    };
    GdnRegs R0, R1, R2;
    loadr(R0, 0); loadr(R1, 1); loadr(R2, 2);
#pragma unroll 1
    for (int c = 0; c < 36; c += 3) { step(R0, c); step(R1, c + 1); step(R2, c + 2); }
    __syncthreads();
}

DI void rope8(float* x1, float* x2, int g8, float posv) {
#pragma unroll
    for (int e = 0; e < 8; ++e) {
        const float inv = exp2f(-(float)(g8 + e) * 0.41524101186092f);
        float s, c; __sincosf(posv * inv, &s, &c);
        const float a = x1[e], bb = x2[e];
        x1[e] = a * c - bb * s; x2[e] = bb * c + a * s;
    }
}

DI void krope_item(const P& p, int r32) {
    const bf16_t* S = (const bf16_t*)(p.ws + WS_SBUF);
    bf16_t* KR = (bf16_t*)(p.ws + WS_KR);
    const int tid = otid(); const int row = r32 * 32 + (tid >> 4), u = tid & 15, hk = u >> 3, hf = (u >> 2) & 1, e8 = (u & 3) * 8;
    const bf16_t* src = S + (size_t)row * NP + C_SWA_K + 128 * hk + 64 * hf + e8;
    float x1[8], x2[8]; unpack8(__builtin_nontemporal_load((const u32x4*)src), x1); unpack8(__builtin_nontemporal_load((const u32x4*)(src + 32)), x2);
    const int kp = row & 2047;
    rope8(x1, x2, e8, (float)(hf == 0 ? (kp >> 6) : (kp & 63)));
    bf16_t* dst = KR + (size_t)row * 256 + 128 * hk + 64 * hf + e8;
    *(u32x4*)dst = pack8(x1); *(u32x4*)(dst + 32) = pack8(x2);
}

struct SwaRegs { u32x4 pr1, pr2, pv1, pv2; };
DI void swa_item(const P& p, int l, int item, unsigned char* smem) {
    bf16_t* sK = (bf16_t*)smem; bf16_t* sV = sK + 64 * 136;
    const bf16_t* S = (const bf16_t*)(p.ws + WS_SBUF);
    const bf16_t* KR = (const bf16_t*)(p.ws + WS_KR);
    bf16_t* Y = (bf16_t*)(p.ws + WS_YBUF);
    bool lat; int b, hk, qb;
    if (item < 256) { lat = true; b = item >> 6; hk = (item >> 5) & 1; qb = item & 31; } else { const int it = item - 256; lat = false; b = it >> 3; hk = (it >> 2) & 1; qb = it & 3; }
    const int tid = otid(), w = tid >> 6, lane = tid & 63, l15 = lane & 15, g = lane >> 4, q4 = l15 >> 2, p4 = l15 & 3;
    const int hq = 2 * hk + (w >> 2);
    const int qpos = 64 * qb + 16 * (w & 3) + l15;
    const size_t qrow = lat ? (size_t)(b * SL + qpos) : (size_t)(NLAT + b * CL + qpos);
    bf16x8 Qf[4];
    {
        float xs[4][8];
#pragma unroll
        for (int ks = 0; ks < 4; ++ks) unpack8(*(const u32x4*)(S + qrow * NP + C_SWA_Q + 128 * hq + 32 * ks + 8 * g), xs[ks]);
        if (lat) { rope8(xs[0], xs[1], 8 * g, (float)(qpos >> 6)); rope8(xs[2], xs[3], 8 * g, (float)(qpos & 63)); }
        const float qs = 0.08838834764831845f * 1.4426950408889634f;
#pragma unroll
        for (int ks = 0; ks < 4; ++ks) {
#pragma unroll
            for (int e = 0; e < 8; ++e) xs[ks][e] *= qs;
            Qf[ks] = __builtin_bit_cast(bf16x8, pack8(xs[ks]));
        }
    }
    float m = p.swa_sink[l * 4 + hq] * 1.4426950408889634f;
    float lsum = (g == 0) ? 1.f : 0.f;
    f32x4 ot[8];
#pragma unroll
    for (int i = 0; i < 8; ++i) ot[i] = (f32x4){0.f, 0.f, 0.f, 0.f};
    int lo = 0, ntl = 0;
    if (lat) { lo = 64 * qb - 128; if (lo < 0) lo = 0; int hi = 64 * qb + 192; if (hi > SL) hi = SL; ntl = (hi - lo) >> 6; }
    const int ntot = ntl + 4;
    const int skey = tid >> 3, ssub = tid & 7, shf = ssub >> 2, se8 = (ssub & 3) * 8;
    auto kvload = [&](SwaRegs& R, int tix) {
        if (tix >= ntot) return;
        const bool loc = tix < ntl;
        const int kpos0 = loc ? lo + 64 * tix : 64 * (tix - ntl);
        const size_t krow0 = loc ? (size_t)(b * SL + kpos0) : (size_t)(NLAT + b * CL + kpos0);
        const bf16_t* src = loc ? KR + (krow0 + skey) * 256 + 128 * hk + 64 * shf + se8 : S + (krow0 + skey) * NP + C_SWA_K + 128 * hk + 64 * shf + se8;
        R.pr1 = *(const u32x4*)src; R.pr2 = *(const u32x4*)(src + 32);
        const bf16_t* vsrc = S + (krow0 + skey) * NP + C_SWA_V + 128 * hk + 16 * ssub;
        R.pv1 = *(const u32x4*)vsrc; R.pv2 = *(const u32x4*)(vsrc + 8);
    };
    auto tile = [&](SwaRegs& R, int tix) {
        const bool loc = tix < ntl;
        const int kpos0 = loc ? lo + 64 * tix : 64 * (tix - ntl);
        __syncthreads();
        {
            const u32x4 r1 = R.pr1, r2 = R.pr2;
            *(u32x4*)(sK + skey * 136 + 64 * shf + se8) = r1; *(u32x4*)(sK + skey * 136 + 64 * shf + 32 + se8) = r2;
            *(u32x4*)(sV + skey * 144 + 16 * ssub) = R.pv1; *(u32x4*)(sV + skey * 144 + 16 * ssub + 8) = R.pv2;
        }
        __syncthreads();
        kvload(R, tix + 2);
        f32x4 sc[4];
#pragma unroll
        for (int kt = 0; kt < 4; ++kt) {
            f32x4 acc = (f32x4){0.f, 0.f, 0.f, 0.f};
#pragma unroll
            for (int ks = 0; ks < 4; ++ks) acc = mfma16(ld8(sK + (16 * kt + l15) * 136 + 32 * ks + 8 * g), Qf[ks], acc);
            sc[kt] = acc;
        }
        if (loc && (kpos0 <= 64 * qb - 128 || kpos0 >= 64 * qb + 128)) {
#pragma unroll
            for (int kt = 0; kt < 4; ++kt)
#pragma unroll
                for (int r = 0; r < 4; ++r) { const int dd = kpos0 + 16 * kt + 4 * g + r - qpos; if (dd > 128 || dd < -128) sc[kt][r] = -1e30f; }
        }
        float tmax = -1e30f;
#pragma unroll
        for (int kt = 0; kt < 4; ++kt)
#pragma unroll
            for (int r = 0; r < 4; ++r) tmax = fmaxf(tmax, sc[kt][r]);
        tmax = fmaxf(tmax, __shfl_xor(tmax, 16)); tmax = fmaxf(tmax, __shfl_xor(tmax, 32));
        const float mn = fmaxf(m, tmax), alpha = __builtin_amdgcn_exp2f(m - mn);
        m = mn;
        float psum = 0.f;
#pragma unroll
        for (int kt = 0; kt < 4; ++kt)
#pragma unroll
            for (int r = 0; r < 4; ++r) { const float pv = __builtin_amdgcn_exp2f(sc[kt][r] - mn); sc[kt][r] = pv; psum += pv; }
        lsum = lsum * alpha + psum;
        bf16x8 Bp[2];
        Bp[0] = packacc(sc[0], sc[1]); Bp[1] = packacc(sc[2], sc[3]);
#pragma unroll
        for (int nt = 0; nt < 8; ++nt) {
            ot[nt] *= alpha;
#pragma unroll
            for (int k2 = 0; k2 < 2; ++k2) {
                const bf16x8 av = tr2(sV + (32 * k2 + 4 * g + q4) * 144 + 16 * nt + 4 * p4, sV + (32 * k2 + 16 + 4 * g + q4) * 144 + 16 * nt + 4 * p4);
                ot[nt] = mfma16(av, Bp[k2], ot[nt]);
            }
        }
    };
    SwaRegs RA, RB;
    kvload(RA, 0); kvload(RB, 1);
#pragma unroll 1
    for (int tix = 0; tix < ntot; tix += 2) { tile(RA, tix); if (tix + 1 < ntot) tile(RB, tix + 1); }
    lsum += __shfl_xor(lsum, 16); lsum += __shfl_xor(lsum, 32);
    const float inv = __builtin_amdgcn_rcpf(lsum);
#pragma unroll
    for (int nt = 0; nt < 8; ++nt) {
        const int dvb = 16 * nt + 4 * g;
        const u32x2 gw = *(const u32x2*)(S + qrow * NP + C_SWA_G + 128 * hq + dvb);
        const float g0 = lo16(gw.x), g1 = hi16(gw.x), g2 = lo16(gw.y), g3 = hi16(gw.y);
        u32x2 o; o.x = pk2(ot[nt][0] * inv * siluf(g0), ot[nt][1] * inv * siluf(g1)); o.y = pk2(ot[nt][2] * inv * siluf(g2), ot[nt][3] * inv * siluf(g3));
        *(u32x2*)(Y + qrow * DM + 1536 + 128 * hq + dvb) = o;
    }
}


#define XB_TMO      128
#define XB_XCNT(j)  (256  + 64 * (j))
#define XB_XSUB(j)  (1280 + 64 * (j))
#define XB_XGEN(j)  (2304 + 64 * (j))
#define XB_TOP      3328
#define XB_TOPGEN   3392
#define XCD_BAR_WORDS 3456
#define XB_SPIN_CAP (1u << 18)
DI unsigned xb_ld(unsigned* p)              { return __hip_atomic_load(p, __ATOMIC_RELAXED, __HIP_MEMORY_SCOPE_AGENT); }
DI unsigned xb_add(unsigned* p, unsigned v) { return __hip_atomic_fetch_add(p, v, __ATOMIC_RELAXED, __HIP_MEMORY_SCOPE_AGENT); }
DI unsigned xb_xcc_id() { return (unsigned)__builtin_amdgcn_s_getreg((3 << 11) | 20) & 0xFu; }
#define XB_SPIN(cond, bar) do { unsigned _sp = 0; while (cond) { __builtin_amdgcn_s_sleep(1); \
    if ((++_sp & 255u) == 0u) { if (xb_ld(&(bar)[XB_TMO])) break; if (_sp > XB_SPIN_CAP) { atomicAdd(&(bar)[XB_TMO], 1u); break; } } } } while (0)
struct XcdBarrier { unsigned* bar; unsigned x; volatile LAS unsigned* st; };
DI XcdBarrier xcd_barrier_post(unsigned* bar, volatile LAS unsigned* st) {
    XcdBarrier b; b.bar = bar; b.x = xb_xcc_id(); b.st = st;
    if (threadIdx.x == 0) (void)xb_add(&bar[XB_XCNT(b.x)], 1u);
    return b;
}
DI void xcd_barrier_complete(unsigned* bar, unsigned x, unsigned& nloc, unsigned& nx) {
    const unsigned G = gridDim.x * gridDim.y * gridDim.z;
    unsigned sum, cnt, mine, sp = 0u;
    for (;;) {
        sum = 0u; cnt = 0u; mine = 0u;
#pragma unroll
        for (unsigned j = 0; j < 16; ++j) { const unsigned c = xb_ld(&bar[XB_XCNT(j)]); sum += c; cnt += (c > 0u) ? 1u : 0u; mine = (j == x) ? c : mine; }
        if (sum == G) break;
        __builtin_amdgcn_s_sleep(1);
        if ((++sp & 255u) == 0u) { if (xb_ld(&bar[XB_TMO])) break; if (sp > XB_SPIN_CAP) { atomicAdd(&bar[XB_TMO], 1u); break; } }
    }
    nloc = mine > 0u ? mine : 1u; nx = cnt > 0u ? cnt : 1u;
}
DI void xcd_barrier(const XcdBarrier& b) {
    asm volatile("s_waitcnt vmcnt(0)" ::: "memory");
    __syncthreads();
    if (threadIdx.x == 0) {
        unsigned* bar = b.bar;
        __builtin_amdgcn_s_waitcnt(0);
        unsigned nloc = b.st[0], nx = b.st[1];
        if (nloc == 0u) { xcd_barrier_complete(bar, b.x, nloc, nx); b.st[0] = nloc; b.st[1] = nx; }
        const unsigned old = xb_add(&bar[XB_XSUB(b.x)], 1u);
        const unsigned gen = old / nloc;
        if (old + 1u == (gen + 1u) * nloc) {
            __builtin_amdgcn_fence(__ATOMIC_RELEASE, "agent");
            asm volatile("s_waitcnt vmcnt(0)" ::: "memory");
            const unsigned og = xb_add(&bar[XB_TOP], 1u);
            const unsigned tg = og / nx;
            if (og + 1u == (tg + 1u) * nx) xb_add(&bar[XB_TOPGEN], 1u);
            else XB_SPIN(xb_ld(&bar[XB_TOPGEN]) == tg, bar);
            __builtin_amdgcn_fence(__ATOMIC_ACQUIRE, "agent");
            xb_add(&bar[XB_XGEN(b.x)], 1u);
            asm volatile("s_waitcnt vmcnt(0)" ::: "memory");
        } else {
            XB_SPIN(xb_ld(&bar[XB_XGEN(b.x)]) == gen, bar);
            __builtin_amdgcn_fence(__ATOMIC_ACQUIRE, "agent");
            asm volatile("s_waitcnt vmcnt(0)" ::: "memory");
        }
    }
    __syncthreads();
}

DI void weight_prep_item(const P& q, int l, int it, unsigned char* sm) {
    if (it < 96) adaln_item(q, l * 96 + it, sm);
    else if (it < 96 + 896) { const int r = it - 96, kt = r / 28, nt = r % 28;
        const int n0 = nt * 256, srcoff = n0 < 1024 ? 0 : (n0 < 3072 ? 32 : 48);
        transpose_item(q.w_in + (size_t)l * DM * INW, INW, srcoff, (bf16_t*)(q.ws + WS_WINT) + (size_t)l * NP * DM, kt, nt, sm); }
    else if (it < 96 + 896 + 256) { const int r = it - 96 - 896, kt = r / 8, nt = r % 8;
        transpose_item(q.w_out + (size_t)l * DM * DM, DM, 0, (bf16_t*)(q.ws + WS_WOUTT) + (size_t)l * DM * DM, kt, nt, sm); }
    else { const int kt = it - 96 - 896 - 256;
        narrow_item(q.w_in + (size_t)l * DM * INW, (bf16_t*)(q.ws + WS_WNT) + (size_t)l * NNAR * DM, kt); }
}

#define ITEM_BEGIN { size_t z_ = 0; asm volatile("" : "+s"(z_)); q.ws = p.ws + z_; sm = smem + osgpr(0); }
#define PHASE_BEGIN P q = p; { size_t z_ = 0; asm volatile("" : "+s"(z_)); q.ws = p.ws + z_; } unsigned char* sm = smem + osgpr(0); const int b1 = osgpr(bid); (void)sm; (void)b1;
__global__ __launch_bounds__(512, 2) void mega(P p) {
    extern __shared__ __attribute__((aligned(16))) unsigned char smem[];
    cg::grid_group grid = cg::this_grid();
    const int bid = blockIdx.x, nb = gridDim.x;
    volatile LAS unsigned* xst = (volatile LAS unsigned*)(smem + LDS_BYTES - 16);
    if (threadIdx.x < 4) xst[threadIdx.x] = 0u;
    __syncthreads();
    const XcdBarrier xb = xcd_barrier_post((unsigned*)(p.ws + WS_BAR), xst);
    if (p.ws == nullptr) grid.sync();
    for (int rep = 0; rep < REP_P0; ++rep) {
        PHASE_BEGIN
        for (int it = b1; it < 2560; it += nb) { ITEM_BEGIN weight_prep_item(q, it & 1, it >> 1, sm); }
    }
    xcd_barrier(xb);
    { PHASE_BEGIN norm0_phase(q, sm, xb.bar + 32, xst + 2); }
    xcd_barrier(xb);
#pragma unroll 1
    for (int l0 = 0; l0 < 2; ++l0) {
        const int l = osgpr(l0);
        for (int rep = 0; rep < REP_G1; ++rep) {
            if (rep) xcd_barrier(xb);
            PHASE_BEGIN
            pg8::Gemm g{(const bf16_t*)(q.ws + WS_NBUF), (const bf16_t*)(q.ws + WS_WINT) + (size_t)l * NP * DM, NROW, NP, DM};
            pg8::StaticOrder so; so.init(g.M, g.N, nb, b1);
            pg8::EpiBf16 e{(bf16_t*)(q.ws + WS_SBUF), NP};
            pg8::gemm_phase((LAS unsigned char*)sm, g, so, e);
        }
        xcd_barrier(xb);
        for (int rep = 0; rep < REP_PREP; ++rep) {
            if (rep) xcd_barrier(xb);
            PHASE_BEGIN
            const int nconv = (l == 0 ? NROW : NLAT) / 32;
            const int ntot = 576 + 576 + nconv + 256;
            unsigned* qctr = xb.bar + 1 + l;
            volatile LAS unsigned* qw = xst + 2;
            unsigned nxt = 0u;
            if (threadIdx.x == 0) qw[0] = xb_add(qctr, 1u);
            __syncthreads();
            int it = (int)qw[0];
            __syncthreads();
            while (it < ntot) {
                ITEM_BEGIN
                if (threadIdx.x == 0) nxt = xb_add(qctr, 1u);
                if (it < 576) { for (int r2 = 0; r2 < REP_GDNP; ++r2) gdn_prep_item(q, l, it, sm); }
                else if (it < 576 + 576) { for (int r2 = 0; r2 < REP_GLAP; ++r2) gla_prep_item(q, l, it - 576, sm); }
                else if (it < 576 + 576 + nconv) conv_item(q, l, it - 576 - 576);
                else krope_item(q, it - 576 - 576 - nconv);
                if (threadIdx.x == 0) qw[0] = nxt;
                __syncthreads();
                it = (int)qw[0];
                __syncthreads();
            }
        }
        xcd_barrier(xb);
        for (int rep = 0; rep < REP_SCAN; ++rep) {
            if (rep) xcd_barrier(xb);
            PHASE_BEGIN
            if (b1 < 32) { for (int r2 = 0; r2 < REP_GLAS; ++r2) gla_scan_item(q, b1, sm); }
            else if (b1 < 160) { for (int r2 = 0; r2 < REP_GDNS; ++r2) gdn_scan_item(q, b1 - 32, sm); }
            else if (nb == 256) {
                const int j = b1 - 160, x = j & 7, nloc = l == 0 ? 36 : 32;
                unsigned* qctr = xb.bar + 8 + 8 * l + x;
                volatile LAS unsigned* qw = xst + 2;
                unsigned nxt = 0u;
                if (threadIdx.x == 0) qw[0] = xb_add(qctr, 1u);
                __syncthreads();
                int li = (int)qw[0];
                __syncthreads();
                while (li < nloc) { ITEM_BEGIN
                    if (threadIdx.x == 0) nxt = xb_add(qctr, 1u);
                    const int it = li < 32 ? ((x >> 1) * 64 + (x & 1) * 32 + li) : (256 + (x >> 1) * 8 + (x & 1) * 4 + (li - 32));
                    for (int r2 = 0; r2 < REP_SWA; ++r2) swa_item(q, l, it, sm);
                    if (threadIdx.x == 0) qw[0] = nxt;
                    __syncthreads();
                    li = (int)qw[0];
                    __syncthreads(); }
            }
            else { const int nsw = l == 0 ? 288 : 256; for (int it = b1 - 160; it < nsw; it += nb - 160) { ITEM_BEGIN for (int r2 = 0; r2 < REP_SWA; ++r2) swa_item(q, l, it, sm); } }
        }
        xcd_barrier(xb);
        { PHASE_BEGIN const int nf = (l == 0 ? NROW : NLAT) / 16; for (int it = b1; it < nf; it += nb) { ITEM_BEGIN finish_item(q, l, it); } }
        xcd_barrier(xb);
        for (int rep = 0; rep < REP_G2; ++rep) {
            if (rep) xcd_barrier(xb);
            PHASE_BEGIN
            pg8::Gemm g{(const bf16_t*)(q.ws + WS_YBUF), (const bf16_t*)(q.ws + WS_WOUTT) + (size_t)l * DM * DM, NLAT, DM, DM};
            pg8::StaticOrder so; so.init(g.M, g.N, nb, b1);
            pg8::EpiBf16 e{(bf16_t*)(q.ws + WS_SBUF), DM};
            pg8::gemm_phase((LAS unsigned char*)sm, g, so, e);
        }
        xcd_barrier(xb);
        if (l == 0) {
            {
                PHASE_BEGIN
                if (b1 < 32) {
                    pg8::Gemm g{(const bf16_t*)(q.ws + WS_YBUF) + (size_t)NLAT * DM, (const bf16_t*)(q.ws + WS_WOUTT), NROW - NLAT, DM, DM};
                    pg8::StaticOrder so; so.init(g.M, g.N, 32, b1);
                    pg8::EpiBf16 e{(bf16_t*)(q.ws + WS_SBUF) + (size_t)NLAT * DM, DM};
                    pg8::gemm_phase((LAS unsigned char*)sm, g, so, e);
                } else post_phase(q, 0, sm, 0, NLAT / 16, b1 - 32, nb - 32);
            }
            xcd_barrier(xb);
            { PHASE_BEGIN post_phase(q, 0, sm, NLAT / 16, NROW / 16, b1, nb); }
            xcd_barrier(xb);
        } else {
            PHASE_BEGIN post_phase(q, 1, sm, 0, NLAT / 16, b1, nb);
        }
    }
}

extern "C" void kernel_launch(void* const* d_in, const int* in_sizes, int n_in, void* d_out, int out_size, void* d_ws, size_t ws_size, hipStream_t stream) {
    static int grid = 0;
    if (grid == 0) {
        if (n_in != 19 || ws_size < WS_END) { fprintf(stderr, "kernel_launch: unexpected n_in %d / ws_size %zu (need %zu)\n", n_in, ws_size, (size_t)WS_END); grid = -1; return; }
        int dev = 0, cus = 0, per_cu = 0;
        hipGetDevice(&dev);
        hipDeviceGetAttribute(&cus, hipDeviceAttributeMultiprocessorCount, dev);
        hipFuncSetAttribute((const void*)mega, hipFuncAttributeMaxDynamicSharedMemorySize, LDS_BYTES);
        hipOccupancyMaxActiveBlocksPerMultiprocessor(&per_cu, (const void*)mega, 512, LDS_BYTES);
        if (per_cu < 1) per_cu = 1;
        grid = cus * per_cu;
        fprintf(stderr, "kernel_launch: cus %d per_cu %d grid %d ws %zu need %zu\n", cus, per_cu, grid, ws_size, (size_t)WS_END);
    }
    if (grid < 0) return;
    P p{};
    const float** f = (const float**)&p;
    for (int i = 0; i < 19; ++i) f[i] = (const float*)d_in[i];
    p.out = (float*)d_out; p.ws = (unsigned char*)d_ws;
    (void)hipMemsetAsync((unsigned char*)d_ws + WS_BAR, 0, 3456 * 4, stream);
    void* args[] = {&p};
    hipError_t e = hipLaunchCooperativeKernel((const void*)mega, dim3(grid), dim3(512), args, LDS_BYTES, stream);
    if (e != hipSuccess) fprintf(stderr, "cooperative launch failed: %s (grid %d)\n", hipGetErrorString(e), grid);
}
```

```cpp
#include <hip/hip_runtime.h>
#include <hip/hip_cooperative_groups.h>
#include <cstdio>
namespace cg = cooperative_groups;

#define DI __device__ __forceinline__
#define LAS __attribute__((address_space(3)))
typedef unsigned short bf16_t;
typedef short bf16x8 __attribute__((ext_vector_type(8)));
typedef short s16x4 __attribute__((ext_vector_type(4)));
typedef float f32x4 __attribute__((ext_vector_type(4)));
typedef unsigned u32x4 __attribute__((ext_vector_type(4)));
typedef unsigned u32x2 __attribute__((ext_vector_type(2)));

constexpr int DM = 2048, NBATCH = 4, SL = 2048, CL = 256, NROW = 9216, NLAT = 8192, INW = 7216, NP = 7168, PT = 2304, NNAR = 48;
constexpr int C_GLA_Q = 0, C_GLA_K = 256, C_GLA_V = 512, C_GLA_G = 1024, C_GDN_Q = 1536, C_GDN_K = 2048, C_GDN_V = 2560,
              C_GDN_G = 3072, C_SC_B = 3584, C_SC_C = 4096, C_SC_H = 4608, C_SC_G = 5120, C_SWA_Q = 5632,
              C_SWA_K = 6144, C_SWA_V = 6400, C_SWA_G = 6656;
constexpr int G_LR = 0, G_A = 32, G_B = 40;
constexpr int LDS_BYTES = 147456;
#ifndef REP_P0
#define REP_P0 1
#endif
#ifndef REP_G1
#define REP_G1 1
#endif
#ifndef REP_PREP
#define REP_PREP 1
#endif
#ifndef REP_SCAN
#define REP_SCAN 1
#endif
#ifndef REP_GDNP
#define REP_GDNP 1
#endif
#ifndef REP_GLAP
#define REP_GLAP 1
#endif
#ifndef REP_GLAS
#define REP_GLAS 1
#endif
#ifndef REP_GDNS
#define REP_GDNS 1
#endif
#ifndef REP_SWA
#define REP_SWA 1
#endif
#ifndef REP_G2
#define REP_G2 1
#endif

constexpr size_t al256(size_t x) { return (x + 255) & ~(size_t)255; }
constexpr size_t WS_WINT = 0;
constexpr size_t WS_WOUTT = WS_WINT + al256((size_t)2 * NP * DM * 2);
constexpr size_t WS_MOD = WS_WOUTT + al256((size_t)2 * DM * DM * 2);
constexpr size_t WS_NBUF = WS_MOD + al256((size_t)2 * 5 * 6144 * 4);
constexpr size_t WS_SBUF = WS_NBUF + al256((size_t)NROW * DM * 2);
constexpr size_t WS_YBUF = WS_SBUF + al256((size_t)NROW * NP * 2);
constexpr size_t WS_HC = WS_YBUF + al256((size_t)NROW * DM * 2);
constexpr size_t WS_GLA_QT = WS_HC + al256((size_t)1024 * DM * 4);
constexpr size_t WS_GLA_KO = WS_GLA_QT + al256((size_t)32 * PT * 64 * 2);
constexpr size_t WS_GLA_AT = WS_GLA_KO + al256((size_t)32 * PT * 64 * 2);
constexpr size_t WS_GLA_DC = WS_GLA_AT + al256((size_t)32 * 72 * 32 * 32 * 2);
constexpr size_t WS_GDN_U = WS_GLA_DC + al256((size_t)32 * 72 * 64 * 4);
constexpr size_t WS_GDN_W = WS_GDN_U + al256((size_t)32 * PT * 128 * 2);
constexpr size_t WS_GDN_QI = WS_GDN_W + al256((size_t)32 * PT * 128 * 2);
constexpr size_t WS_GDN_KO = WS_GDN_QI + al256((size_t)32 * PT * 128 * 2);
constexpr size_t WS_GDN_AT = WS_GDN_KO + al256((size_t)32 * PT * 128 * 2);
constexpr size_t WS_GDN_DC = WS_GDN_AT + al256((size_t)32 * 36 * 64 * 64 * 2);
constexpr size_t WS_WNT = WS_GDN_DC + al256((size_t)32 * 36 * 4);
constexpr size_t WS_G = WS_WNT + al256((size_t)2 * NNAR * DM * 2);
constexpr size_t WS_KR = WS_G + al256((size_t)NROW * NNAR * 4);
constexpr size_t WS_BAR = WS_KR + al256((size_t)NLAT * 256 * 2);
constexpr size_t WS_END = WS_BAR + al256((size_t)3456 * 4);

struct P {
    const float *x, *c, *ctx, *c_ctx, *ada_w, *ada_b, *norm_pre, *norm_post, *w_in, *w_out, *gla_wd, *gla_bd, *gla_norm, *gdn_conv, *gdn_alog,
        *gdn_dtb, *gdn_norm, *sc_conv, *swa_sink;
    float* out;
    unsigned char* ws;
};

typedef __bf16 bf16v2 __attribute__((ext_vector_type(2)));
DI bf16_t f2bf(float f) { return __builtin_bit_cast(bf16_t, (__bf16)f); }
DI float bf2f(bf16_t b) { return __uint_as_float(((unsigned)b) << 16); }
DI unsigned pk2(float lo, float hi) { bf16v2 v = {(__bf16)lo, (__bf16)hi}; return __builtin_bit_cast(unsigned, v); }
DI float lo16(unsigned u) { return __uint_as_float(u << 16); }
DI float hi16(unsigned u) { return __uint_as_float(u & 0xFFFF0000u); }
DI void unpack8(u32x4 v, float* o) { o[0] = lo16(v.x); o[1] = hi16(v.x); o[2] = lo16(v.y); o[3] = hi16(v.y); o[4] = lo16(v.z); o[5] = hi16(v.z); o[6] = lo16(v.w); o[7] = hi16(v.w); }
DI u32x4 pack8(const float* o) { u32x4 r; r.x = pk2(o[0], o[1]); r.y = pk2(o[2], o[3]); r.z = pk2(o[4], o[5]); r.w = pk2(o[6], o[7]); return r; }
DI float siluf(float x) { return x * __builtin_amdgcn_rcpf(1.f + __expf(-x)); }
DI bf16x8 ld8(const bf16_t* p) { return *(const bf16x8*)p; }
DI bf16x8 ld4x2(const bf16_t* p0, const bf16_t* p1) {
    s16x4 a = *(const s16x4*)p0, b = *(const s16x4*)p1;
    return __builtin_shufflevector(a, b, 0, 1, 2, 3, 4, 5, 6, 7);
}
DI s16x4 trread(const bf16_t* p) { return __builtin_amdgcn_ds_read_tr16_b64_v4i16((LAS s16x4*)p); }
DI bf16x8 tr2(const bf16_t* p0, const bf16_t* p1) { s16x4 a = trread(p0), b = trread(p1); return __builtin_shufflevector(a, b, 0, 1, 2, 3, 4, 5, 6, 7); }
DI bf16x8 packacc(f32x4 a, f32x4 b) {
    u32x4 r; r.x = pk2(a[0], a[1]); r.y = pk2(a[2], a[3]); r.z = pk2(b[0], b[1]); r.w = pk2(b[2], b[3]);
    return __builtin_bit_cast(bf16x8, r);
}
DI f32x4 mfma16(bf16x8 a, bf16x8 b, f32x4 c) { return __builtin_amdgcn_mfma_f32_16x16x32_bf16(a, b, c, 0, 0, 0); }
DI float wave_sum(float v) {
#pragma unroll
    for (int o = 32; o >= 1; o >>= 1) v += __shfl_xor(v, o);
    return v;
}
DI int otid() { int t = threadIdx.x; asm volatile("" : "+v"(t)); return t; }
DI int osgpr(int v) { asm volatile("" : "+s"(v)); return v; }
DI int prow(int b, int dir, int p) {
    if (p < CL) { const int t = dir ? (CL - 1 - p) : p; return NLAT + b * CL + t; }
    const int q = p - CL; const int t = dir ? (SL - 1 - q) : q; return b * SL + t;
}

namespace pg8 {
constexpr int BM = 256, BK = 64, HALF = 128, HTB = HALF * BK * 2, NXCD = 8, WGM = 4;
DI int lds_byte(int r, int c) { const int st = (r >> 4) * 2 + (c >> 5), rr = r & 15, cc = c & 31, ob = rr * 64 + cc * 2; return st * 1024 + (ob ^ (((ob >> 9) & 1) << 5)); }
DI void stage_rc(int b, int& R, int& C) { const int st = b / 1024, sb = b % 1024, swz = sb ^ (((sb >> 9) & 1) << 5); R = (st >> 1) * 16 + swz / 64; C = (st & 1) * 32 + (swz % 64) / 2; }
DI int perm32(int rho) { const int n = rho >> 4, i = rho & 15; return 8 * (i >> 2) + 4 * n + (i & 3); }
struct Unit { int pm, pn; };
struct Gemm { const bf16_t* A; const bf16_t* Bt; int M, N, K; };
struct StaticOrder {
    int nM, nN, nwg, G, c;
    DI void init(int M, int N, int G_, int c_) { nM = M / BM; nN = N / BM; nwg = nM * nN; G = G_; c = c_; }
    DI bool next(int i, Unit& u) const {
        const long L = (long)i * G + c; if (L >= nwg) return false;
        int wgid = (int)L; { const int q = nwg / NXCD, r = nwg % NXCD, xcd = wgid % NXCD, off = wgid / NXCD; wgid = (xcd < r ? xcd * (q + 1) : r * (q + 1) + (xcd - r) * q) + off; }
        const int nig = WGM * nN, gid = wgid / nig, fm = gid * WGM, gsz = (nM - fm) < WGM ? (nM - fm) : WGM;
        u.pm = fm + ((wgid % nig) % gsz); u.pn = (wgid % nig) / gsz; return true;
    }
};
struct EpiBf16 {
    bf16_t* O; int ldc;
    DI void operator()(const f32x4 (&acc)[2][2][4][2], const Unit& u, int wr, int wc, int fr, int fq) const {
        const int row0 = u.pm * BM + wr * 64 + fr; const int col0 = u.pn * BM + wc * 32 + 8 * fq;
#pragma unroll
        for (int ai = 0; ai < 2; ++ai)
#pragma unroll
            for (int m = 0; m < 4; ++m) { bf16_t* rowp = O + (size_t)(row0 + ai * HALF + m * 16) * ldc + col0;
#pragma unroll
                for (int bj = 0; bj < 2; ++bj) { const f32x4 v0 = acc[ai][bj][m][0], v1 = acc[ai][bj][m][1];
                    u32x4 w; w.x = pk2(v0[0], v0[1]); w.y = pk2(v0[2], v0[3]); w.z = pk2(v1[0], v1[1]); w.w = pk2(v1[2], v1[3]);
                    *(u32x4*)(rowp + bj * HALF) = w; } }
    }
};

DI void gemm_phase(LAS unsigned char* lds, const Gemm g, const StaticOrder& S, const EpiBf16& E) {
    const int tid = otid(), wid = __builtin_amdgcn_readfirstlane(tid >> 6), lane = tid & 63, wr = wid >> 2, wc = wid & 3, fr = lane & 15, fq = lane >> 4;
    const int K = g.K, nt = K / BK;
    unsigned voffA[2], voffB[2];
#pragma unroll
    for (int i = 0; i < 2; ++i) { int R, C; stage_rc(tid * 16 + i * 8192, R, C); const int Rb = (R & ~31) + perm32(R & 31);
        voffA[i] = (unsigned)(R * K + C) * 2u; voffB[i] = (unsigned)(Rb * K + C) * 2u; }
    const size_t kstep = (size_t)(BK * 2);
    const size_t hstep = (size_t)HALF * K * 2;
    const size_t tstep = 2 * hstep;
    const unsigned ldsw = (unsigned)wid * 1024u;
    const int aoff = lds_byte(wr * 64 + fr, fq * 8), boff = lds_byte(wc * 32 + fr, fq * 8);
#define PG8_SA(b, h) (((b) * 2 + (h)) * HTB)
#define PG8_SB(b, h) ((4 + (b) * 2 + (h)) * HTB)
#define PG8_STAGE(bufoff, gbase, voff) do { _Pragma("unroll") for (int _i = 0; _i < 2; ++_i) \
        __builtin_amdgcn_global_load_lds((const unsigned*)((const char*)(gbase) + (voff)[_i]), (LAS unsigned*)(lds + (bufoff) + ldsw + _i * 8192), 16, 0, 0); } while (0)
#define PG8_LDA(dst, b, h) do { _Pragma("unroll") for (int m = 0; m < 4; ++m) _Pragma("unroll") for (int k = 0; k < 2; ++k) dst[m][k] = *(const LAS bf16x8*)(lds + PG8_SA(b, h) + aoff + m * 2048 + k * 1024); } while (0)
#define PG8_LDB(dst, b, h) do { _Pragma("unroll") for (int n = 0; n < 2; ++n) _Pragma("unroll") for (int k = 0; k < 2; ++k) dst[n][k] = *(const LAS bf16x8*)(lds + PG8_SB(b, h) + boff + n * 2048 + k * 1024); } while (0)
#define PG8_MMA(ai, bj, At, Bt) do { __builtin_amdgcn_s_setprio(1); _Pragma("unroll") for (int m = 0; m < 4; ++m) _Pragma("unroll") for (int n = 0; n < 2; ++n) _Pragma("unroll") for (int k = 0; k < 2; ++k) \
        acc[ai][bj][m][n] = __builtin_amdgcn_mfma_f32_16x16x32_bf16(Bt[n][k], At[m][k], acc[ai][bj][m][n], 0, 0, 0); __builtin_amdgcn_s_setprio(0); } while (0)
#define PG8_WAIT_V(n) asm volatile("s_waitcnt vmcnt(" #n ")" ::: "memory")
#define PG8_WAIT_L(n) asm volatile("s_waitcnt lgkmcnt(" #n ")" ::: "memory")
#define PG8_BAR __builtin_amdgcn_s_barrier()
#define PG8_SCHED __builtin_amdgcn_sched_barrier(0)
    Unit cur, nxt; int ui = 0;
    if (!S.next(0, cur)) return;
    f32x4 acc[2][2][4][2];
#pragma unroll
    for (int a = 0; a < 2; ++a)
#pragma unroll
        for (int b = 0; b < 2; ++b)
#pragma unroll
            for (int m = 0; m < 4; ++m)
#pragma unroll
                for (int n = 0; n < 2; ++n) acc[a][b][m][n] = (f32x4){0.f, 0.f, 0.f, 0.f};
    bf16x8 At[4][2], B0[2][2], B1[2][2];
    const char* cA = (const char*)g.A + (size_t)cur.pm * tstep; const char* cB = (const char*)g.Bt + (size_t)cur.pn * tstep;
    PG8_STAGE(PG8_SB(0, 0), cB, voffB); PG8_STAGE(PG8_SA(0, 0), cA, voffA); PG8_STAGE(PG8_SB(0, 1), cB + hstep, voffB); PG8_STAGE(PG8_SA(0, 1), cA + hstep, voffA);
    if (wr == 1) PG8_BAR;
    PG8_WAIT_V(4); PG8_BAR;
    PG8_STAGE(PG8_SB(1, 0), cB + kstep, voffB); PG8_STAGE(PG8_SA(1, 0), cA + kstep, voffA); PG8_STAGE(PG8_SB(1, 1), cB + hstep + kstep, voffB);
    PG8_WAIT_V(6); PG8_BAR;
    for (;;) {
        const bool has_next = S.next(ui + 1, nxt);
        const char* nA = has_next ? (const char*)g.A + (size_t)nxt.pm * tstep : cA; const char* nB = has_next ? (const char*)g.Bt + (size_t)nxt.pn * tstep : cB;
        for (int t = 0; t < nt; t += 2) {
            const bool last = (t == nt - 2);
            const char* a1 = cA + (size_t)(t + 1) * kstep;
            const char* a2 = last ? nA : cA + (size_t)(t + 2) * kstep; const char* b2 = last ? nB : cB + (size_t)(t + 2) * kstep;
            const char* a3 = a2 + kstep; const char* b3 = b2 + kstep;
            PG8_LDB(B0, 0, 0); PG8_SCHED; PG8_LDA(At, 0, 0); PG8_STAGE(PG8_SA(1, 1), a1 + hstep, voffA);
            PG8_WAIT_L(8); PG8_BAR; PG8_WAIT_L(0); PG8_MMA(0, 0, At, B0); PG8_BAR; PG8_SCHED;
            PG8_LDB(B1, 0, 1); PG8_STAGE(PG8_SB(0, 0), b2, voffB);
            PG8_BAR; PG8_WAIT_L(0); PG8_MMA(0, 1, At, B1); PG8_BAR;
            PG8_LDA(At, 0, 1); PG8_STAGE(PG8_SA(0, 0), a2, voffA);
            PG8_BAR; PG8_WAIT_L(0); PG8_MMA(1, 0, At, B0); PG8_BAR; PG8_SCHED;
            PG8_STAGE(PG8_SB(0, 1), b2 + hstep, voffB);
            PG8_WAIT_V(6); PG8_BAR; PG8_MMA(1, 1, At, B1); PG8_BAR;
            PG8_LDB(B0, 1, 0); PG8_SCHED; PG8_LDA(At, 1, 0); PG8_STAGE(PG8_SA(0, 1), a2 + hstep, voffA);
            PG8_WAIT_L(8); PG8_BAR; PG8_WAIT_L(0); PG8_MMA(0, 0, At, B0); PG8_BAR; PG8_SCHED;
            PG8_LDB(B1, 1, 1); PG8_STAGE(PG8_SB(1, 0), b3, voffB);
            PG8_BAR; PG8_WAIT_L(0); PG8_MMA(0, 1, At, B1); PG8_BAR;
            PG8_LDA(At, 1, 1); PG8_STAGE(PG8_SA(1, 0), a3, voffA);
            PG8_BAR; PG8_WAIT_L(0); PG8_MMA(1, 0, At, B0); PG8_BAR; PG8_SCHED;
            PG8_STAGE(PG8_SB(1, 1), b3 + hstep, voffB);
            PG8_WAIT_V(6); PG8_BAR; PG8_MMA(1, 1, At, B1); PG8_BAR;
        }
        E(acc, cur, wr, wc, fr, fq);
        if (!has_next) break;
#pragma unroll
        for (int a = 0; a < 2; ++a)
#pragma unroll
            for (int b = 0; b < 2; ++b)
#pragma unroll
                for (int m = 0; m < 4; ++m)
#pragma unroll
                    for (int n = 0; n < 2; ++n) acc[a][b][m][n] = (f32x4){0.f, 0.f, 0.f, 0.f};
        cur = nxt; cA = nA; cB = nB; ++ui;
    }
    PG8_WAIT_V(0);
    if (wr == 0) PG8_BAR;
    PG8_BAR;
#undef PG8_SA
#undef PG8_SB
#undef PG8_STAGE
#undef PG8_LDA
#undef PG8_LDB
#undef PG8_MMA
#undef PG8_WAIT_V
#undef PG8_WAIT_L
#undef PG8_BAR
#undef PG8_SCHED
}
}

DI void adaln_item(const P& p, int a, unsigned char* smem) {
    float* sc = (float*)smem;
    float* red = sc + 5 * 2048;
    float* mod = (float*)(p.ws + WS_MOD);
    const int tid = otid();
    for (int e = tid; e < 5 * 2048; e += 512) { const int r = e >> 11, k = e & 2047; const float v = r < 4 ? p.c[r * 2048 + k] : p.c_ctx[k]; sc[e] = siluf(v); }
    __syncthreads();
    const int l = a / 96, j0 = (a % 96) * 64, cg4 = (tid & 15) * 4, kg = tid >> 4;
    const float* w = p.ada_w + (size_t)l * 2048 * 6144 + j0 + cg4;
    f32x4 acc[5];
#pragma unroll
    for (int r = 0; r < 5; ++r) acc[r] = (f32x4){0.f, 0.f, 0.f, 0.f};
#pragma unroll 1
    for (int i0 = 0; i0 < 64; i0 += 16) {
        f32x4 wv[16];
#pragma unroll
        for (int i = 0; i < 16; ++i) wv[i] = __builtin_nontemporal_load((const f32x4*)(w + (size_t)(kg + 32 * (i0 + i)) * 6144));
#pragma unroll
        for (int i = 0; i < 16; ++i) {
            const int k = kg + 32 * (i0 + i);
#pragma unroll
            for (int r = 0; r < 5; ++r) acc[r] += wv[i] * sc[r * 2048 + k];
        }
    }
#pragma unroll
    for (int r = 0; r < 5; ++r) *(f32x4*)(red + (kg * 5 + r) * 64 + cg4) = acc[r];
    __syncthreads();
    if (tid < 320) {
        const int r = tid >> 6, tx = tid & 63; float sum = 0.f;
#pragma unroll
        for (int k2 = 0; k2 < 32; ++k2) sum += red[(k2 * 5 + r) * 64 + tx];
        mod[(l * 5 + r) * 6144 + j0 + tx] = sum + p.ada_b[l * 6144 + j0 + tx];
    }
    __syncthreads();
}

DI void transpose_item(const float* src, int ld, int srcoff, bf16_t* dst, int kt, int nt, unsigned char* smem) {
    float* tile = (float*)smem;
    const int tid = otid();
#pragma unroll
    for (int i = 0; i < 8; ++i) {
        const int kr = (tid >> 6) + 8 * i, nc = (tid & 63) * 4;
        const f32x4 v = __builtin_nontemporal_load((const f32x4*)(src + (size_t)(kt * 64 + kr) * ld + srcoff + nt * 256 + nc));
        tile[kr * 257 + nc + 0] = v[0]; tile[kr * 257 + nc + 1] = v[1]; tile[kr * 257 + nc + 2] = v[2]; tile[kr * 257 + nc + 3] = v[3];
    }
    __syncthreads();
    {
        const int n = tid >> 1, k0 = (tid & 1) * 32;
#pragma unroll
        for (int k8 = 0; k8 < 4; ++k8) {
            float o[8];
#pragma unroll
            for (int j = 0; j < 8; ++j) o[j] = tile[(k0 + 8 * k8 + j) * 257 + n];
            *(u32x4*)(dst + (size_t)(nt * 256 + n) * 2048 + kt * 64 + k0 + 8 * k8) = pack8(o);
        }
    }
    __syncthreads();
}
DI void narrow_item(const float* src, bf16_t* dst, int kt) {
    const int tid = otid();
#pragma unroll
    for (int j = 0; j < 6; ++j) {
        const int e = tid + 512 * j, kr = e / 48, cn = e % 48;
        const int sc = cn < 32 ? 1024 + cn : 3104 + (cn - 32);
        dst[(size_t)cn * 2048 + kt * 64 + kr] = f2bf(src[(size_t)(kt * 64 + kr) * INW + sc]);
    }
}
DI void skinny_tile(const P& p, int l, int r0, float* red) {
    const bf16_t* A = (const bf16_t*)(p.ws + WS_NBUF);
    const bf16_t* Bt = (const bf16_t*)(p.ws + WS_WNT) + (size_t)l * NNAR * DM;
    float* G = (float*)(p.ws + WS_G);
    const int tid = otid(), w = tid >> 6, lane = tid & 63, l15 = lane & 15, g = lane >> 4;
    f32x4 acc[3];
#pragma unroll
    for (int n = 0; n < 3; ++n) acc[n] = (f32x4){0.f, 0.f, 0.f, 0.f};
    const bf16_t* ap = A + (size_t)(r0 + l15) * DM + 256 * w + 8 * g;
    const bf16_t* bp = Bt + (size_t)l15 * DM + 256 * w + 8 * g;
#pragma unroll
    for (int ks = 0; ks < 8; ++ks) {
        const bf16x8 a0 = *(const bf16x8*)(ap + 32 * ks);
#pragma unroll
        for (int n = 0; n < 3; ++n) acc[n] = mfma16(a0, *(const bf16x8*)(bp + (size_t)16 * n * DM + 32 * ks), acc[n]);
    }
#pragma unroll
    for (int n = 0; n < 3; ++n)
#pragma unroll
        for (int r = 0; r < 4; ++r) red[w * 768 + (4 * g + r) * 48 + 16 * n + l15] = acc[n][r];
    __syncthreads();
    for (int e = tid; e < 768; e += 512) {
        float sum = 0.f;
#pragma unroll
        for (int k = 0; k < 8; ++k) sum += red[k * 768 + e];
        G[(size_t)r0 * NNAR + e] = sum;
    }
    __syncthreads();
}

DI void norm0_phase(const P& p, unsigned char* smem, unsigned* qctr, volatile LAS unsigned* qw) {
    const int tid = otid(); const int wave = tid >> 6, lane = tid & 63;
    const float* mod = (const float*)(p.ws + WS_MOD);
    bf16_t* nb = (bf16_t*)(p.ws + WS_NBUF);
    unsigned nxt = 0u;
    if (threadIdx.x == 0) qw[0] = __hip_atomic_fetch_add(qctr, 1u, __ATOMIC_RELAXED, __HIP_MEMORY_SCOPE_AGENT);
    __syncthreads();
    int rt = (int)qw[0];
    __syncthreads();
    while (rt < NROW / 16) {
      if (threadIdx.x == 0) nxt = __hip_atomic_fetch_add(qctr, 1u, __ATOMIC_RELAXED, __HIP_MEMORY_SCOPE_AGENT);
      for (int rr = 0; rr < 2; ++rr) {
        const int row = rt * 16 + wave * 2 + rr;
        const float* h = row < NLAT ? p.x + (size_t)row * DM : p.ctx + (size_t)(row - NLAT) * DM;
        const int mr = row < NLAT ? (row >> 11) : 4;
        f32x4 v[8]; float ss = 0.f;
#pragma unroll
        for (int i = 0; i < 8; ++i) { v[i] = __builtin_nontemporal_load((const f32x4*)(h + i * 256 + lane * 4)); ss += v[i][0] * v[i][0] + v[i][1] * v[i][1] + v[i][2] * v[i][2] + v[i][3] * v[i][3]; }
        ss = wave_sum(ss);
        const float rstd = rsqrtf(ss * (1.f / 2048.f) + 1e-6f);
        const float* md = mod + (size_t)mr * 6144;
#pragma unroll
        for (int i = 0; i < 8; ++i) {
            const int j = i * 256 + lane * 4;
            const f32x4 gw = *(const f32x4*)(p.norm_pre + j), sh = *(const f32x4*)(md + j), scl = *(const f32x4*)(md + 2048 + j);
            float o[4];
#pragma unroll
            for (int e = 0; e < 4; ++e) o[e] = v[i][e] * rstd * gw[e] * (1.f + scl[e]) + sh[e];
            u32x2 w; w.x = pk2(o[0], o[1]); w.y = pk2(o[2], o[3]);
            *(u32x2*)(nb + (size_t)row * DM + j) = w;
        }
      }
      asm volatile("s_waitcnt vmcnt(0)" ::: "memory"); __syncthreads();
      skinny_tile(p, 0, rt * 16, (float*)smem);
      if (threadIdx.x == 0) qw[0] = nxt;
      __syncthreads();
      rt = (int)qw[0];
      __syncthreads();
    }
}

DI void post_phase(const P& p, int l, unsigned char* smem, int t0, int t1, int bstart, int bstride) {
    const int tid = otid(); const int wave = tid >> 6, lane = tid & 63;
    const float* mod = (const float*)(p.ws + WS_MOD);
    bf16_t* nb = (bf16_t*)(p.ws + WS_NBUF);
    const bf16_t* yo = (const bf16_t*)(p.ws + WS_SBUF);
    float* hc = (float*)(p.ws + WS_HC);
    for (int rt = t0 + osgpr(bstart); rt < t1; rt += bstride) {
      for (int rr = 0; rr < 2; ++rr) {
        const int row = rt * 16 + wave * 2 + rr;
        const int mr = row < NLAT ? (row >> 11) : 4;
        const float* h = l == 0 ? (row < NLAT ? p.x + (size_t)row * DM : p.ctx + (size_t)(row - NLAT) * DM) : p.out + (size_t)row * DM;
        float* hdst = row < NLAT ? p.out + (size_t)row * DM : hc + (size_t)(row - NLAT) * DM;
        f32x4 y[8]; float ss = 0.f;
#pragma unroll
        for (int i = 0; i < 8; ++i) {
            const u32x2 w = __builtin_nontemporal_load((const u32x2*)(yo + (size_t)row * DM + i * 256 + lane * 4));
            y[i] = (f32x4){lo16(w.x), hi16(w.x), lo16(w.y), hi16(w.y)};
            ss += y[i][0] * y[i][0] + y[i][1] * y[i][1] + y[i][2] * y[i][2] + y[i][3] * y[i][3];
        }
        ss = wave_sum(ss);
        const float rstd = rsqrtf(ss * (1.f / 2048.f) + 1e-6f);
        const float* md = mod + (size_t)(l * 5 + mr) * 6144;
        float ss2 = 0.f;
#pragma unroll
        for (int i = 0; i < 8; ++i) {
            const int j = i * 256 + lane * 4;
            const f32x4 hv = __builtin_nontemporal_load((const f32x4*)(h + j)), gt = *(const f32x4*)(md + 4096 + j), nw = *(const f32x4*)(p.norm_post + l * DM + j);
#pragma unroll
            for (int e = 0; e < 4; ++e) { y[i][e] = hv[e] + gt[e] * (y[i][e] * rstd * nw[e]); ss2 += y[i][e] * y[i][e]; }
            __builtin_nontemporal_store(y[i], (f32x4*)(hdst + j));
        }
        if (l == 0) {
            ss2 = wave_sum(ss2);
            const float rstd2 = rsqrtf(ss2 * (1.f / 2048.f) + 1e-6f);
            const float* md1 = mod + (size_t)(5 + mr) * 6144;
#pragma unroll
            for (int i = 0; i < 8; ++i) {
                const int j = i * 256 + lane * 4;
                const f32x4 gw = *(const f32x4*)(p.norm_pre + DM + j), sh = *(const f32x4*)(md1 + j), scl = *(const f32x4*)(md1 + 2048 + j);
                float o[4];
#pragma unroll
                for (int e = 0; e < 4; ++e) o[e] = y[i][e] * rstd2 * gw[e] * (1.f + scl[e]) + sh[e];
                u32x2 w; w.x = pk2(o[0], o[1]); w.y = pk2(o[2], o[3]);
                *(u32x2*)(nb + (size_t)row * DM + j) = w;
            }
        }
      }
      if (l == 0) { asm volatile("s_waitcnt vmcnt(0)" ::: "memory"); __syncthreads(); skinny_tile(p, 1, rt * 16, (float*)smem); }
    }
}

DI void conv_item(const P& p, int l, int r32) {
    const bf16_t* S = (const bf16_t*)(p.ws + WS_SBUF);
    bf16_t* Y = (bf16_t*)(p.ws + WS_YBUF);
    const int tid = otid(); const int row0 = r32 * 32 + (tid >> 6) * 4, ch = (tid & 63) * 8;
    int t0, len;
    if (row0 < NLAT) { t0 = row0 & 2047; len = SL; } else { t0 = (row0 - NLAT) & 255; len = CL; }
    u32x4 rc[6], rh[6], rb[4], rg[4];
#pragma unroll
    for (int k = 0; k < 6; ++k) {
        int tt = t0 + k - 1; const int tcl = tt < 0 ? 0 : (tt >= len ? len - 1 : tt);
        const bf16_t* rp = S + (size_t)(row0 + (tcl - t0)) * NP;
        rc[k] = __builtin_nontemporal_load((const u32x4*)(rp + C_SC_C + ch)); rh[k] = __builtin_nontemporal_load((const u32x4*)(rp + C_SC_H + ch));
    }
#pragma unroll
    for (int k = 0; k < 4; ++k) { const bf16_t* rp = S + (size_t)(row0 + k) * NP; rb[k] = __builtin_nontemporal_load((const u32x4*)(rp + C_SC_B + ch)); rg[k] = __builtin_nontemporal_load((const u32x4*)(rp + C_SC_G + ch)); }
    f32x4 w0[3], w1[3];
#pragma unroll
    for (int j = 0; j < 3; ++j) { const float* w = p.sc_conv + (size_t)(l * 3 + j) * 512 + ch; w0[j] = *(const f32x4*)w; w1[j] = *(const f32x4*)(w + 4); }
    float prod[6][8];
#pragma unroll
    for (int k = 0; k < 6; ++k) {
        const int tt = t0 + k - 1; const float msk = (tt >= 0 && tt < len) ? 1.f : 0.f;
        float cc[8], hh[8]; unpack8(rc[k], cc); unpack8(rh[k], hh);
#pragma unroll
        for (int e = 0; e < 8; ++e) prod[k][e] = cc[e] * hh[e] * msk;
    }
#pragma unroll
    for (int k = 0; k < 4; ++k) {
        float bb[8], gg[8], o[8]; unpack8(rb[k], bb); unpack8(rg[k], gg);
#pragma unroll
        for (int e = 0; e < 8; ++e) {
            const float wa = e < 4 ? w0[0][e & 3] : w1[0][e & 3], wb = e < 4 ? w0[1][e & 3] : w1[1][e & 3], wc = e < 4 ? w0[2][e & 3] : w1[2][e & 3];
            const float acc = wa * prod[k][e] + wb * prod[k + 1][e] + wc * prod[k + 2][e];
            o[e] = bb[e] * acc * siluf(gg[e]);
        }
        *(u32x4*)(Y + (size_t)(row0 + k) * DM + 1024 + ch) = pack8(o);
    }
}

DI void finish_item(const P& p, int l, int r16) {
    const bf16_t* S = (const bf16_t*)(p.ws + WS_SBUF);
    bf16_t* Y = (bf16_t*)(p.ws + WS_YBUF);
    const bf16_t* O = (const bf16_t*)(p.ws + WS_NBUF);
    const int tid = otid(); const int row0 = r16 * 16 + (tid >> 7) * 4, u = tid & 127, mx = u >> 6, hh = (u >> 4) & 3, sub = u & 15;
    const int chn = 128 * hh + 8 * sub;
    u32x4 ra[4], rb[4], rg[4];
#pragma unroll
    for (int k = 0; k < 4; ++k) {
        ra[k] = __builtin_nontemporal_load((const u32x4*)(O + ((size_t)(mx * 2 + 0) * NROW + row0 + k) * 512 + chn));
        rb[k] = __builtin_nontemporal_load((const u32x4*)(O + ((size_t)(mx * 2 + 1) * NROW + row0 + k) * 512 + chn));
        rg[k] = __builtin_nontemporal_load((const u32x4*)(S + (size_t)(row0 + k) * NP + (mx ? C_GDN_G : C_GLA_G) + chn));
    }
    const float* nwp = (mx ? p.gdn_norm : p.gla_norm) + l * 128 + 8 * sub;
    const f32x4 nw0 = *(const f32x4*)nwp, nw1 = *(const f32x4*)(nwp + 4);
#pragma unroll
    for (int k = 0; k < 4; ++k) {
        float a[8], b[8], o[8], gt[8];
        unpack8(ra[k], a); unpack8(rb[k], b); unpack8(rg[k], gt);
        float ss = 0.f;
#pragma unroll
        for (int e = 0; e < 8; ++e) { o[e] = a[e] + b[e]; ss += o[e] * o[e]; }
        ss += __shfl_xor(ss, 1); ss += __shfl_xor(ss, 2); ss += __shfl_xor(ss, 4); ss += __shfl_xor(ss, 8);
        const float rstd = rsqrtf(ss * (1.f / 128.f) + 1e-6f);
#pragma unroll
        for (int e = 0; e < 8; ++e) o[e] = o[e] * rstd * (e < 4 ? nw0[e & 3] : nw1[e & 3]) * siluf(gt[e]);
        *(u32x4*)(Y + (size_t)(row0 + k) * DM + 512 * mx + chn) = pack8(o);
    }
}

DI void gla_prep_item(const P& p, int l, int item, unsigned char* smem) {
    const int c = item % 72, bd = item / 72, dir = bd & 1, b = bd >> 1;
    float* slr = (float*)smem;
    float* stot = slr + 512;
    float* slast = stot + 256;
    bf16_t* sq = (bf16_t*)(slast + 256);
    bf16_t* sk = sq + 4 * 32 * 72;
    const bf16_t* S = (const bf16_t*)(p.ws + WS_SBUF);
    bf16_t* QT = (bf16_t*)(p.ws + WS_GLA_QT); bf16_t* KO = (bf16_t*)(p.ws + WS_GLA_KO); bf16_t* AT = (bf16_t*)(p.ws + WS_GLA_AT); float* DC = (float*)(p.ws + WS_GLA_DC);
    const int tid = otid();
    { const int i = tid >> 4, r = tid & 15; slr[i * 16 + r] = ((const float*)(p.ws + WS_G))[(size_t)prow(b, dir, 32 * c + i) * NNAR + G_LR + 16 * dir + r]; }
    __syncthreads();
    const int cch = tid & 255, half = tid >> 8, h = cch >> 6, d = cch & 63;
    bf16_t qraw[16], kraw[16];
#pragma unroll
    for (int ii = 0; ii < 16; ++ii) { const size_t row = (size_t)prow(b, dir, 32 * c + 16 * half + ii); qraw[ii] = S[row * NP + C_GLA_Q + cch]; kraw[ii] = S[row * NP + C_GLA_K + cch]; }
    float wd[16];
#pragma unroll
    for (int r = 0; r < 16; ++r) wd[r] = p.gla_wd[((size_t)(l * 2 + dir) * 16 + r) * 256 + cch];
    const float bdv = p.gla_bd[(l * 2 + dir) * 256 + cch];
    float cum[16]; float run = 0.f;
#pragma unroll
    for (int ii = 0; ii < 16; ++ii) {
        const int i = 16 * half + ii; float z = bdv;
#pragma unroll
        for (int r = 0; r < 16; ++r) z += slr[i * 16 + r] * wd[r];
        const float ls = fminf(z, 0.f) - __logf(1.f + __expf(-fabsf(z)));
        run += ls * (1.f / 16.f); cum[ii] = run;
    }
    if (half == 0) stot[cch] = run;
    __syncthreads();
    if (half == 1) { const float t = stot[cch];
#pragma unroll
        for (int ii = 0; ii < 16; ++ii) cum[ii] += t;
        slast[cch] = cum[15]; }
    __syncthreads();
    const float cl = slast[cch];
    const int seq = (dir * 4 + b) * 4 + h;
#pragma unroll
    for (int ii = 0; ii < 16; ++ii) {
        const int i = 16 * half + ii, pp = 32 * c + i;
        const float q = bf2f(qraw[ii]) * 0.125f, k = bf2f(kraw[ii]);
        const float qt = q * __expf(cum[ii]), kt = k * __expf(-cum[ii]), ko = k * __expf(cl - cum[ii]);
        QT[((size_t)seq * PT + pp) * 64 + d] = f2bf(qt); KO[((size_t)seq * PT + pp) * 64 + d] = f2bf(ko);
        sq[(h * 32 + i) * 72 + d] = f2bf(qt); sk[(h * 32 + i) * 72 + d] = f2bf(kt);
    }
    if (half == 0) DC[((size_t)seq * 72 + c) * 64 + d] = __expf(cl);
    __syncthreads();
    {
        const int w = tid >> 6, lane = tid & 63, l15 = lane & 15, g = lane >> 4, hh = w >> 1, mt = w & 1;
        const int seqh = (dir * 4 + b) * 4 + hh;
#pragma unroll
        for (int nt = 0; nt < 2; ++nt) {
            f32x4 acc = (f32x4){0.f, 0.f, 0.f, 0.f};
#pragma unroll
            for (int ks = 0; ks < 2; ++ks) {
                const bf16x8 a = ld8(sq + (hh * 32 + 16 * mt + l15) * 72 + 32 * ks + 8 * g), bb = ld8(sk + (hh * 32 + 16 * nt + l15) * 72 + 32 * ks + 8 * g);
                acc = mfma16(bb, a, acc);
            }
            const int i = 16 * mt + l15, j0 = 16 * nt + 4 * g;
            u32x2 ov; ov.x = pk2(j0 <= i ? acc[0] : 0.f, j0 + 1 <= i ? acc[1] : 0.f); ov.y = pk2(j0 + 2 <= i ? acc[2] : 0.f, j0 + 3 <= i ? acc[3] : 0.f);
            *(u32x2*)(AT + (((size_t)seqh * 72 + c) * 32 + i) * 32 + j0) = ov;
        }
    }
    __syncthreads();
}

struct GlaRegs { u32x4 rv, rq, ra; float rd; };
DI void gla_scan_item(const P& p, int seq, unsigned char* smem) {
    const int dir = seq >> 4, b = (seq >> 2) & 3, h = seq & 3;
    constexpr int BUFB = 20736;
    const bf16_t* S = (const bf16_t*)(p.ws + WS_SBUF);
    const bf16_t* QT = (const bf16_t*)(p.ws + WS_GLA_QT); const bf16_t* KO = (const bf16_t*)(p.ws + WS_GLA_KO); const bf16_t* AT = (const bf16_t*)(p.ws + WS_GLA_AT); const float* DC = (const float*)(p.ws + WS_GLA_DC);
    bf16_t* OG = (bf16_t*)(p.ws + WS_NBUF) + (size_t)dir * NROW * 512;
    const int tid = otid(), w = tid >> 6, lane = tid & 63, l15 = lane & 15, g = lane >> 4, q4 = l15 >> 2, p4 = l15 & 3;
    auto loadr = [&](GlaRegs& R, int c) {
        if (c >= 72) return;
        { const int pos = tid >> 4, ch = tid & 15; R.rv = *(const u32x4*)(S + (size_t)prow(b, dir, 32 * c + pos) * NP + C_GLA_V + 128 * h + 8 * ch); }
        { const int t2 = tid & 255, pos = t2 >> 3, ch = t2 & 7; const bf16_t* src = (tid < 256 ? QT : KO) + ((size_t)seq * PT + 32 * c + pos) * 64 + 8 * ch; R.rq = __builtin_nontemporal_load((const u32x4*)src); }
        if (tid < 128) { const int i = tid >> 2, ch = tid & 3; R.ra = __builtin_nontemporal_load((const u32x4*)(AT + (((size_t)seq * 72 + c) * 32 + i) * 32 + 8 * ch)); }
        if (tid >= 128 && tid < 192) R.rd = DC[((size_t)seq * 72 + c) * 64 + (tid - 128)];
    };
    auto storel = [&](const GlaRegs& R, int buf) {
        unsigned char* base = smem + buf * BUFB;
        bf16_t* sat = (bf16_t*)base; bf16_t* sqt = (bf16_t*)(base + 2560); bf16_t* sko = (bf16_t*)(base + 2560 + 4608); bf16_t* sv = (bf16_t*)(base + 2560 + 9216); float* sdc = (float*)(base + 2560 + 9216 + 8704);
        { const int pos = tid >> 4, ch = tid & 15; *(u32x4*)(sv + pos * 136 + 8 * ch) = R.rv; }
        { const int t2 = tid & 255, pos = t2 >> 3, ch = t2 & 7; *(u32x4*)((tid < 256 ? sqt : sko) + pos * 72 + 8 * ch) = R.rq; }
        if (tid < 128) { const int i = tid >> 2, ch = tid & 3; *(u32x4*)(sat + i * 40 + 8 * ch) = R.ra; }
        if (tid >= 128 && tid < 192) sdc[tid - 128] = R.rd;
    };
    f32x4 st[4];
#pragma unroll
    for (int i = 0; i < 4; ++i) st[i] = (f32x4){0.f, 0.f, 0.f, 0.f};
    const int sgn = dir ? -1 : 1;
    auto compute = [&](int c) {
        const unsigned char* base = smem + (c & 1) * BUFB;
        const bf16_t* sat = (const bf16_t*)base; const bf16_t* sqt = (const bf16_t*)(base + 2560); const bf16_t* sko = (const bf16_t*)(base + 2560 + 4608); const bf16_t* sv = (const bf16_t*)(base + 2560 + 9216); const float* sdc = (const float*)(base + 2560 + 9216 + 8704);
        const int dv0 = 16 * w;
        const bf16x8 vb = tr2(sv + (8 * g + q4) * 136 + dv0 + 4 * p4, sv + (8 * g + 4 + q4) * 136 + dv0 + 4 * p4);
        bf16x8 bs[2];
        bs[0] = packacc(st[0], st[1]); bs[1] = packacc(st[2], st[3]);
#pragma unroll
        for (int mt = 0; mt < 2; ++mt) {
            f32x4 acc = (f32x4){0.f, 0.f, 0.f, 0.f};
            acc = mfma16(vb, ld8(sat + (16 * mt + l15) * 40 + 8 * g), acc);
#pragma unroll
            for (int ks = 0; ks < 2; ++ks) {
                const bf16_t* r0 = sqt + (16 * mt + l15) * 72 + 32 * ks + 4 * g;
                acc = mfma16(bs[ks], ld4x2(r0, r0 + 16), acc);
            }
            bf16_t* ob = OG + (size_t)prow(b, dir, 32 * c) * 512 + 128 * h;
            u32x2 ov; ov.x = pk2(acc[0], acc[1]); ov.y = pk2(acc[2], acc[3]);
            *(u32x2*)(ob + sgn * ((16 * mt + l15) * 512) + dv0 + 4 * g) = ov;
        }
#pragma unroll
        for (int dt = 0; dt < 4; ++dt) {
            const bf16x8 ak = tr2(sko + (8 * g + q4) * 72 + 16 * dt + 4 * p4, sko + (8 * g + 4 + q4) * 72 + 16 * dt + 4 * p4);
#pragma unroll
            for (int r = 0; r < 4; ++r) st[dt][r] *= sdc[16 * dt + 4 * g + r];
            st[dt] = mfma16(ak, vb, st[dt]);
        }
    };
    GlaRegs R0, R1, R2, R3, R4, R5;
    loadr(R0, 0); loadr(R1, 1); loadr(R2, 2); loadr(R3, 3); loadr(R4, 4); loadr(R5, 5);
#pragma unroll 1
    for (int c = 0; c < 72; c += 6) {
        storel(R0, 0); __syncthreads(); loadr(R0, c + 6); compute(c);
        storel(R1, 1); __syncthreads(); loadr(R1, c + 7); compute(c + 1);
        storel(R2, 0); __syncthreads(); loadr(R2, c + 8); compute(c + 2);
        storel(R3, 1); __syncthreads(); loadr(R3, c + 9); compute(c + 3);
        storel(R4, 0); __syncthreads(); loadr(R4, c + 10); compute(c + 4);
        storel(R5, 1); __syncthreads(); loadr(R5, c + 11); compute(c + 5);
    }
    __syncthreads();
}

DI void gdn_conv16(const bf16_t* raw, const float* cw, int ti, int cch, float* out) {
#pragma unroll
    for (int e = 0; e < 16; ++e) out[e] = 0.f;
#pragma unroll 1
    for (int j = 0; j < 5; ++j) {
        const bf16_t* rp = raw + (ti + j) * 392 + cch;
        float xv[16];
        unpack8(*(const u32x4*)rp, xv); unpack8(*(const u32x4*)(rp + 8), xv + 8);
        const float* w = cw + j * 384 + cch;
#pragma unroll
        for (int e4 = 0; e4 < 4; ++e4) { const f32x4 wv = *(const f32x4*)(w + 4 * e4);
#pragma unroll
            for (int e = 0; e < 4; ++e) out[4 * e4 + e] += wv[e] * xv[4 * e4 + e]; }
    }
#pragma unroll
    for (int e = 0; e < 16; ++e) out[e] = siluf(out[e]);
}

DI f32x4 mfma4(float a, float b, f32x4 c) { return __builtin_amdgcn_mfma_f32_16x16x4f32(a, b, c, 0, 0, 0); }

DI void gdn_prep_item(const P& p, int l, int item, unsigned char* smem) {
    const int sc = item % 36, bh = item / 36, h = bh & 3, b = bh >> 2;
    constexpr int LS = 68;
    bf16_t* sK = (bf16_t*)smem;
    bf16_t* sKB = sK + 64 * 136;
    bf16_t* sQ = sKB + 64 * 136;
    bf16_t* sVb = sQ + 64 * 136;
    bf16_t* sKEb = sVb + 64 * 136;
    float* sL = (float*)(sKEb + 64 * 136);
    bf16_t* sLb = (bf16_t*)(sL + 64 * LS);
    bf16_t* sTd = sLb + 64 * 72;
    float* sg = (float*)(sTd + 4 * 16 * 24); float* sbeta = sg + 64; float* scum = sbeta + 64;
    const bf16_t* S = (const bf16_t*)(p.ws + WS_SBUF);
    bf16_t* U = (bf16_t*)(p.ws + WS_GDN_U); bf16_t* W = (bf16_t*)(p.ws + WS_GDN_W); bf16_t* QI = (bf16_t*)(p.ws + WS_GDN_QI); bf16_t* KO = (bf16_t*)(p.ws + WS_GDN_KO);
    bf16_t* AT = (bf16_t*)(p.ws + WS_GDN_AT); float* DC = (float*)(p.ws + WS_GDN_DC);
    const int tid = otid(), ti = tid >> 3, sub = tid & 7;
    const int w = __builtin_amdgcn_readfirstlane(tid >> 6), lane = tid & 63, l15 = lane & 15, g = lane >> 4, q4 = l15 >> 2, p4 = l15 & 3;
    int len, base, tlo, nseg, cseg, coff;
    if (sc < 4) { len = CL; base = NLAT + b * CL; cseg = sc; nseg = 4; coff = 0; } else { len = SL; base = b * SL; cseg = sc - 4; nseg = 32; coff = 4; }
    tlo = 64 * cseg;
    const size_t row = (size_t)(base + tlo + ti);
    const float* Gp = (const float*)(p.ws + WS_G) + row * NNAR;
    const float a_raw0 = Gp[G_A + h], a_raw1 = Gp[G_A + 4 + h], b_raw0 = Gp[G_B + h], b_raw1 = Gp[G_B + 4 + h];
    float* sCW = scum + 64;
    bf16_t* raw = (bf16_t*)smem;
    if (tid < 480) { const int j = tid / 96, r = tid % 96, part = r >> 5, e4 = r & 31;
        *(f32x4*)(sCW + j * 384 + part * 128 + 4 * e4) = *(const f32x4*)(p.gdn_conv + ((size_t)l * 5 + j) * 1536 + part * 512 + 128 * h + 4 * e4); }
#pragma unroll
    for (int k = 0; k < 7; ++k) {
        const int e = tid + 512 * k;
        if (e < 68 * 48) {
            const int r = e / 48, pc = e % 48, part = pc >> 4, wi = pc & 15;
            const int tt = tlo - 2 + r;
            u32x4 v = (u32x4){0u, 0u, 0u, 0u};
            if (tt >= 0 && tt < len) v = __builtin_nontemporal_load((const u32x4*)(S + (size_t)(base + tt) * NP + C_GDN_Q + part * 512 + 128 * h + 8 * wi));
            *(u32x4*)(raw + r * 392 + part * 128 + 8 * wi) = v;
        }
    }
    __syncthreads();
    float xq[16], xk[16], xv[16];
    gdn_conv16(raw, sCW, ti, 0 + 16 * sub, xq);
    gdn_conv16(raw, sCW, ti, 128 + 16 * sub, xk);
    gdn_conv16(raw, sCW, ti, 256 + 16 * sub, xv);
    float sq_ = 0.f, sk_ = 0.f;
#pragma unroll
    for (int e = 0; e < 16; ++e) { sq_ += xq[e] * xq[e]; sk_ += xk[e] * xk[e]; }
    sq_ += __shfl_xor(sq_, 1); sq_ += __shfl_xor(sq_, 2); sq_ += __shfl_xor(sq_, 4);
    sk_ += __shfl_xor(sk_, 1); sk_ += __shfl_xor(sk_, 2); sk_ += __shfl_xor(sk_, 4);
    const float rq = rsqrtf(sq_ + 1e-6f) * 0.08838834764831845f, rk = rsqrtf(sk_ + 1e-6f);
#pragma unroll
    for (int e = 0; e < 16; ++e) { xq[e] *= rq; xk[e] *= rk; }
#pragma unroll 1
  for (int dir = 0; dir < 2; ++dir) {
    const int seq = (dir * 4 + b) * 4 + h;
    const int c = coff + (dir ? nseg - 1 - cseg : cseg);
    const int i = dir ? 63 - ti : ti;
    const int pp = 64 * c + i;
    if (sub == 0) {
        const float a_in = dir ? a_raw1 : a_raw0, b_in = dir ? b_raw1 : b_raw0;
        const float A = __expf(p.gdn_alog[(l * 2 + dir) * 4 + h]);
        const float xx = a_in + p.gdn_dtb[(l * 2 + dir) * 4 + h];
        const float sp = fmaxf(xx, 0.f) + log1pf(__expf(-fabsf(xx)));
        sg[i] = -A * sp; sbeta[i] = __builtin_amdgcn_rcpf(1.f + __expf(-b_in));
    }
    __syncthreads();
    if (tid < 64) {
        float v = sg[tid];
#pragma unroll
        for (int o = 1; o < 64; o <<= 1) { const float u = __shfl_up(v, o); if (tid >= o) v += u; }
        scum[tid] = v;
    }
    __syncthreads();
    const float cumi = scum[i], cl = scum[63], bet = sbeta[i], ei = __expf(cumi), eo = __expf(cl - cumi);
    {
        float t1[16], t2[16];
        *(u32x4*)(sK + i * 136 + 16 * sub) = pack8(xk); *(u32x4*)(sK + i * 136 + 16 * sub + 8) = pack8(xk + 8);
        *(u32x4*)(sQ + i * 136 + 16 * sub) = pack8(xq); *(u32x4*)(sQ + i * 136 + 16 * sub + 8) = pack8(xq + 8);
#pragma unroll
        for (int e = 0; e < 16; ++e) { t1[e] = xk[e] * bet; t2[e] = xv[e] * bet; }
        *(u32x4*)(sKB + i * 136 + 16 * sub) = pack8(t1); *(u32x4*)(sKB + i * 136 + 16 * sub + 8) = pack8(t1 + 8);
        *(u32x4*)(sVb + i * 136 + 16 * sub) = pack8(t2); *(u32x4*)(sVb + i * 136 + 16 * sub + 8) = pack8(t2 + 8);
#pragma unroll
        for (int e = 0; e < 16; ++e) t2[e] = t1[e] * ei;
        *(u32x4*)(sKEb + i * 136 + 16 * sub) = pack8(t2); *(u32x4*)(sKEb + i * 136 + 16 * sub + 8) = pack8(t2 + 8);
#pragma unroll
        for (int e = 0; e < 16; ++e) { t1[e] = xq[e] * ei; t2[e] = xk[e] * eo; }
        bf16_t* qd = QI + ((size_t)seq * PT + pp) * 128 + 16 * sub; bf16_t* kd = KO + ((size_t)seq * PT + pp) * 128 + 16 * sub;
        __builtin_nontemporal_store(pack8(t1), (u32x4*)qd); __builtin_nontemporal_store(pack8(t1 + 8), (u32x4*)(qd + 8));
        __builtin_nontemporal_store(pack8(t2), (u32x4*)kd); __builtin_nontemporal_store(pack8(t2 + 8), (u32x4*)(kd + 8));
        if (tid == 0) DC[seq * 36 + c] = __expf(cl);
    }
    __syncthreads();
    {
        const int mt = w >> 1;
#pragma unroll
        for (int n2 = 0; n2 < 2; ++n2) {
            const int nt = 2 * (w & 1) + n2;
            f32x4 aL = (f32x4){0.f, 0.f, 0.f, 0.f}, aA = (f32x4){0.f, 0.f, 0.f, 0.f};
#pragma unroll
            for (int ks = 0; ks < 4; ++ks) {
                const bf16x8 bk = ld8(sK + (16 * nt + l15) * 136 + 32 * ks + 8 * g);
                aL = mfma16(bk, ld8(sKB + (16 * mt + l15) * 136 + 32 * ks + 8 * g), aL);
                aA = mfma16(bk, ld8(sQ + (16 * mt + l15) * 136 + 32 * ks + 8 * g), aA);
            }
            const int ii = 16 * mt + l15, j0 = 16 * nt + 4 * g;
            const f32x4 cj = *(const f32x4*)(scum + j0); const float ci = scum[ii];
            f32x4 lv; float av[4];
#pragma unroll
            for (int r = 0; r < 4; ++r) {
                const float dcy = __expf(fminf(ci - cj[r], 0.f));
                lv[r] = (j0 + r < ii) ? aL[r] * dcy : 0.f;
                av[r] = (j0 + r <= ii) ? aA[r] * dcy : 0.f;
            }
            *(f32x4*)(sL + ii * LS + j0) = lv;
            { u32x2 lb; lb.x = pk2(lv[0], lv[1]); lb.y = pk2(lv[2], lv[3]); *(u32x2*)(sLb + ii * 72 + j0) = lb; }
            { u32x2 ab; ab.x = pk2(av[0], av[1]); ab.y = pk2(av[2], av[3]); *(u32x2*)(AT + (((size_t)seq * 36 + c) * 64 + ii) * 64 + j0) = ab; }
        }
    }
    __syncthreads();
    if (tid < 64) {
        const int I = tid >> 4, cc = tid & 15;
        float tt[16];
#pragma unroll
        for (int r = 0; r < 16; ++r) tt[r] = (r == cc) ? 1.f : 0.f;
#pragma unroll
        for (int j = 0; j < 15; ++j) {
            const float tj = tt[j];
#pragma unroll
            for (int r = j + 1; r < 16; ++r) tt[r] -= sL[(16 * I + r) * LS + 16 * I + j] * tj;
        }
#pragma unroll
        for (int r = 0; r < 16; ++r) sTd[(I * 16 + r) * 24 + cc] = f2bf(tt[r]);
    }
    __syncthreads();
    {
        const bf16_t* Rb = w < 4 ? sVb : sKEb;
        bf16_t* dstb = (w < 4 ? U : W) + ((size_t)seq * PT + 64 * c) * 128;
#pragma unroll
        for (int n2 = 0; n2 < 2; ++n2) {
            const int col0 = 32 * (w & 3) + 16 * n2;
            s16x4 Xb[4];
#pragma unroll
            for (int I = 0; I < 4; ++I) {
                f32x4 accL = (f32x4){0.f, 0.f, 0.f, 0.f};
#pragma unroll
                for (int J = 0; J < I; ++J)
                    accL = __builtin_amdgcn_mfma_f32_16x16x16bf16_1k(*(const s16x4*)(sLb + (16 * I + l15) * 72 + 16 * J + 4 * g), Xb[J], accL, 0, 0, 0);
                f32x4 rhs;
#pragma unroll
                for (int r = 0; r < 4; ++r) rhs[r] = bf2f(Rb[(16 * I + 4 * g + r) * 136 + col0 + l15]) - accL[r];
                u32x2 pb; pb.x = pk2(rhs[0], rhs[1]); pb.y = pk2(rhs[2], rhs[3]);
                const f32x4 X = __builtin_amdgcn_mfma_f32_16x16x16bf16_1k(*(const s16x4*)(sTd + (I * 16 + l15) * 24 + 4 * g), __builtin_bit_cast(s16x4, pb), (f32x4){0.f, 0.f, 0.f, 0.f}, 0, 0, 0);
                u32x2 px; px.x = pk2(X[0], X[1]); px.y = pk2(X[2], X[3]);
                Xb[I] = __builtin_bit_cast(s16x4, px);
#pragma unroll
                for (int r = 0; r < 4; ++r) dstb[(size_t)(16 * I + 4 * g + r) * 128 + col0 + l15] = f2bf(X[r]);
            }
        }
    }
    __syncthreads();
  }
}

struct GdnRegs { u32x4 r[8]; };
DI void gdn_scan_item(const P& p, int item, unsigned char* smem) {
    const int seq = (item & 7) * 4 + (item >> 5), cq = (item >> 3) & 3;
    const int dir = seq >> 4, b = (seq >> 2) & 3, h = seq & 3;
    constexpr int BUFB = 3 * 17408 + 9216 + 5120;
    bf16_t* sVN = (bf16_t*)(smem + 2 * BUFB);
    float* sdec = (float*)(smem + 2 * BUFB + 5120);
    const bf16_t* U = (const bf16_t*)(p.ws + WS_GDN_U); const bf16_t* W = (const bf16_t*)(p.ws + WS_GDN_W); const bf16_t* QI = (const bf16_t*)(p.ws + WS_GDN_QI); const bf16_t* KO = (const bf16_t*)(p.ws + WS_GDN_KO);
    const bf16_t* AT = (const bf16_t*)(p.ws + WS_GDN_AT); const float* DC = (const float*)(p.ws + WS_GDN_DC);
    bf16_t* OG = (bf16_t*)(p.ws + WS_NBUF) + (size_t)(2 + dir) * NROW * 512;
    const int tid = otid(), w = tid >> 6, lane = tid & 63, l15 = lane & 15, g = lane >> 4, q4 = l15 >> 2, p4 = l15 & 3;
    const int mt = w >> 1, nt = w & 1;
    auto loadr = [&](GdnRegs& R, int c) {
        if (c >= 36) return;
        u32x4* rr = R.r;
#pragma unroll
        for (int k = 0; k < 2; ++k) {
            const int e = tid + 512 * k, r = e >> 4, ch = e & 15; const size_t off = ((size_t)seq * PT + 64 * c + r) * 128 + 8 * ch;
            rr[k] = *(const u32x4*)(W + off); rr[2 + k] = *(const u32x4*)(QI + off); rr[4 + k] = *(const u32x4*)(KO + off);
        }
        { const int r = tid >> 3, ch = tid & 7; rr[6] = *(const u32x4*)(AT + (((size_t)seq * 36 + c) * 64 + r) * 64 + 8 * ch); }
        if (tid < 256) { const int r = tid >> 2, ch = tid & 3; rr[7] = __builtin_nontemporal_load((const u32x4*)(U + ((size_t)seq * PT + 64 * c + r) * 128 + 32 * cq + 8 * ch)); }
    };
    auto storel = [&](const GdnRegs& R, int buf) {
        const u32x4* rr = R.r;
        bf16_t* sW = (bf16_t*)(smem + buf * BUFB); bf16_t* sQI = sW + 64 * 136; bf16_t* sKO = sQI + 64 * 136; bf16_t* sAT = sKO + 64 * 136; bf16_t* sU = sAT + 64 * 72;
#pragma unroll
        for (int k = 0; k < 2; ++k) {
            const int e = tid + 512 * k, r = e >> 4, ch = e & 15; const int off = r * 136 + 8 * ch;
            *(u32x4*)(sW + off) = rr[k]; *(u32x4*)(sQI + off) = rr[2 + k]; *(u32x4*)(sKO + off) = rr[4 + k];
        }
        { const int r = tid >> 3, ch = tid & 7; *(u32x4*)(sAT + r * 72 + 8 * ch) = rr[6]; }
        if (tid < 256) { const int r = tid >> 2, ch = tid & 3; *(u32x4*)(sU + r * 40 + 8 * ch) = rr[7]; }
    };
    u32x4* sBS = (u32x4*)(smem + 2 * BUFB + 5120 + 256);
    f32x4 st[2];
    st[0] = (f32x4){0.f, 0.f, 0.f, 0.f}; st[1] = (f32x4){0.f, 0.f, 0.f, 0.f};
    sBS[(nt * 4 + mt) * 64 + lane] = (u32x4){0u, 0u, 0u, 0u};
    if (tid < 36) sdec[tid] = DC[seq * 36 + tid];
    const int sgn = dir ? -1 : 1;
    auto step = [&](GdnRegs& R, int c) {
        storel(R, c & 1);
        __syncthreads();
        loadr(R, c + 3);
        const bf16_t* sW = (const bf16_t*)(smem + (c & 1) * BUFB); const bf16_t* sQI = sW + 64 * 136; const bf16_t* sKO = sQI + 64 * 136; const bf16_t* sAT = sKO + 64 * 136; const bf16_t* sU = sAT + 64 * 72;
        const float dec = sdec[c];
        bf16x8 Bs[4];
#pragma unroll
        for (int ks = 0; ks < 4; ++ks) Bs[ks] = __builtin_bit_cast(bf16x8, sBS[(nt * 4 + ks) * 64 + lane]);
        {
            f32x4 acc = (f32x4){0.f, 0.f, 0.f, 0.f};
#pragma unroll
            for (int ks = 0; ks < 4; ++ks) { const bf16_t* r0 = sW + (16 * mt + l15) * 136 + 32 * ks + 4 * g; acc = mfma16(Bs[ks], ld4x2(r0, r0 + 16), acc); }
            {
                const u32x2 uu = *(const u32x2*)(sU + (16 * mt + l15) * 40 + 16 * nt + 4 * g);
                u32x2 vv; vv.x = pk2(lo16(uu.x) - acc[0], hi16(uu.x) - acc[1]); vv.y = pk2(lo16(uu.y) - acc[2], hi16(uu.y) - acc[3]);
                *(u32x2*)(sVN + (16 * mt + l15) * 40 + 16 * nt + 4 * g) = vv;
            }
        }
        __syncthreads();
        bf16x8 Bv[2];
#pragma unroll
        for (int k2 = 0; k2 < 2; ++k2) Bv[k2] = tr2(sVN + (32 * k2 + 8 * g + q4) * 40 + 16 * nt + 4 * p4, sVN + (32 * k2 + 8 * g + 4 + q4) * 40 + 16 * nt + 4 * p4);
        {
            f32x4 acc = (f32x4){0.f, 0.f, 0.f, 0.f};
#pragma unroll
            for (int ks = 0; ks < 4; ++ks) { const bf16_t* r0 = sQI + (16 * mt + l15) * 136 + 32 * ks + 4 * g; acc = mfma16(Bs[ks], ld4x2(r0, r0 + 16), acc); }
#pragma unroll
            for (int k2 = 0; k2 < 2; ++k2) acc = mfma16(Bv[k2], ld8(sAT + (16 * mt + l15) * 72 + 32 * k2 + 8 * g), acc);
            bf16_t* ob = OG + (size_t)prow(b, dir, 64 * c) * 512 + 128 * h + 32 * cq;
            u32x2 ov; ov.x = pk2(acc[0], acc[1]); ov.y = pk2(acc[2], acc[3]);
            *(u32x2*)(ob + sgn * ((16 * mt + l15) * 512) + 16 * nt + 4 * g) = ov;
        }
#pragma unroll
        for (int j = 0; j < 2; ++j) {
            const int dt = 2 * mt + j;
            st[j] *= dec;
#pragma unroll
            for (int k2 = 0; k2 < 2; ++k2) {
                const bf16x8 ak = tr2(sKO + (32 * k2 + 8 * g + q4) * 136 + 16 * dt + 4 * p4, sKO + (32 * k2 + 8 * g + 4 + q4) * 136 + 16 * dt + 4 * p4);
                st[j] = mfma16(ak, Bv[k2], st[j]);
            }
        }
        sBS[(nt * 4 + mt) * 64 + lane] = __builtin_bit_cast(u32x4, packacc(st[0], st[1]));
    };
    GdnRegs R0, R1, R2;
    loadr(R0, 0); loadr(R1, 1); loadr(R2, 2);
#pragma unroll 1
    for (int c = 0; c < 36; c += 3) { step(R0, c); step(R1, c + 1); step(R2, c + 2); }
    __syncthreads();
}

DI void rope8(float* x1, float* x2, int g8, float posv) {
#pragma unroll
    for (int e = 0; e < 8; ++e) {
        const float inv = exp2f(-(float)(g8 + e) * 0.41524101186092f);
        float s, c; __sincosf(posv * inv, &s, &c);
        const float a = x1[e], bb = x2[e];
        x1[e] = a * c - bb * s; x2[e] = bb * c + a * s;
    }
}

DI void krope_item(const P& p, int r32) {
    const bf16_t* S = (const bf16_t*)(p.ws + WS_SBUF);
    bf16_t* KR = (bf16_t*)(p.ws + WS_KR);
    const int tid = otid(); const int row = r32 * 32 + (tid >> 4), u = tid & 15, hk = u >> 3, hf = (u >> 2) & 1, e8 = (u & 3) * 8;
    const bf16_t* src = S + (size_t)row * NP + C_SWA_K + 128 * hk + 64 * hf + e8;
    float x1[8], x2[8]; unpack8(__builtin_nontemporal_load((const u32x4*)src), x1); unpack8(__builtin_nontemporal_load((const u32x4*)(src + 32)), x2);
    const int kp = row & 2047;
    rope8(x1, x2, e8, (float)(hf == 0 ? (kp >> 6) : (kp & 63)));
    bf16_t* dst = KR + (size_t)row * 256 + 128 * hk + 64 * hf + e8;
    *(u32x4*)dst = pack8(x1); *(u32x4*)(dst + 32) = pack8(x2);
}

struct SwaRegs { u32x4 pr1, pr2, pv1, pv2; };
DI void swa_item(const P& p, int l, int item, unsigned char* smem) {
    bf16_t* sK = (bf16_t*)smem; bf16_t* sV = sK + 64 * 136;
    const bf16_t* S = (const bf16_t*)(p.ws + WS_SBUF);
    const bf16_t* KR = (const bf16_t*)(p.ws + WS_KR);
    bf16_t* Y = (bf16_t*)(p.ws + WS_YBUF);
    bool lat; int b, hk, qb;
    if (item < 256) { lat = true; b = item >> 6; hk = (item >> 5) & 1; qb = item & 31; } else { const int it = item - 256; lat = false; b = it >> 3; hk = (it >> 2) & 1; qb = it & 3; }
    const int tid = otid(), w = tid >> 6, lane = tid & 63, l15 = lane & 15, g = lane >> 4, q4 = l15 >> 2, p4 = l15 & 3;
    const int hq = 2 * hk + (w >> 2);
    const int qpos = 64 * qb + 16 * (w & 3) + l15;
    const size_t qrow = lat ? (size_t)(b * SL + qpos) : (size_t)(NLAT + b * CL + qpos);
    bf16x8 Qf[4];
    {
        float xs[4][8];
#pragma unroll
        for (int ks = 0; ks < 4; ++ks) unpack8(*(const u32x4*)(S + qrow * NP + C_SWA_Q + 128 * hq + 32 * ks + 8 * g), xs[ks]);
        if (lat) { rope8(xs[0], xs[1], 8 * g, (float)(qpos >> 6)); rope8(xs[2], xs[3], 8 * g, (float)(qpos & 63)); }
        const float qs = 0.08838834764831845f * 1.4426950408889634f;
#pragma unroll
        for (int ks = 0; ks < 4; ++ks) {
#pragma unroll
            for (int e = 0; e < 8; ++e) xs[ks][e] *= qs;
            Qf[ks] = __builtin_bit_cast(bf16x8, pack8(xs[ks]));
        }
    }
    float m = p.swa_sink[l * 4 + hq] * 1.4426950408889634f;
    float lsum = (g == 0) ? 1.f : 0.f;
    f32x4 ot[8];
#pragma unroll
    for (int i = 0; i < 8; ++i) ot[i] = (f32x4){0.f, 0.f, 0.f, 0.f};
    int lo = 0, ntl = 0;
    if (lat) { lo = 64 * qb - 128; if (lo < 0) lo = 0; int hi = 64 * qb + 192; if (hi > SL) hi = SL; ntl = (hi - lo) >> 6; }
    const int ntot = ntl + 4;
    const int skey = tid >> 3, ssub = tid & 7, shf = ssub >> 2, se8 = (ssub & 3) * 8;
    auto kvload = [&](SwaRegs& R, int tix) {
        if (tix >= ntot) return;
        const bool loc = tix < ntl;
        const int kpos0 = loc ? lo + 64 * tix : 64 * (tix - ntl);
        const size_t krow0 = loc ? (size_t)(b * SL + kpos0) : (size_t)(NLAT + b * CL + kpos0);
        const bf16_t* src = loc ? KR + (krow0 + skey) * 256 + 128 * hk + 64 * shf + se8 : S + (krow0 + skey) * NP + C_SWA_K + 128 * hk + 64 * shf + se8;
        R.pr1 = *(const u32x4*)src; R.pr2 = *(const u32x4*)(src + 32);
        const bf16_t* vsrc = S + (krow0 + skey) * NP + C_SWA_V + 128 * hk + 16 * ssub;
        R.pv1 = *(const u32x4*)vsrc; R.pv2 = *(const u32x4*)(vsrc + 8);
    };
    auto tile = [&](SwaRegs& R, int tix) {
        const bool loc = tix < ntl;
        const int kpos0 = loc ? lo + 64 * tix : 64 * (tix - ntl);
        __syncthreads();
        {
            const u32x4 r1 = R.pr1, r2 = R.pr2;
            *(u32x4*)(sK + skey * 136 + 64 * shf + se8) = r1; *(u32x4*)(sK + skey * 136 + 64 * shf + 32 + se8) = r2;
            *(u32x4*)(sV + skey * 144 + 16 * ssub) = R.pv1; *(u32x4*)(sV + skey * 144 + 16 * ssub + 8) = R.pv2;
        }
        __syncthreads();
        kvload(R, tix + 2);
        f32x4 sc[4];
#pragma unroll
        for (int kt = 0; kt < 4; ++kt) {
            f32x4 acc = (f32x4){0.f, 0.f, 0.f, 0.f};
#pragma unroll
            for (int ks = 0; ks < 4; ++ks) acc = mfma16(ld8(sK + (16 * kt + l15) * 136 + 32 * ks + 8 * g), Qf[ks], acc);
            sc[kt] = acc;
        }
        if (loc && (kpos0 <= 64 * qb - 128 || kpos0 >= 64 * qb + 128)) {
#pragma unroll
            for (int kt = 0; kt < 4; ++kt)
#pragma unroll
                for (int r = 0; r < 4; ++r) { const int dd = kpos0 + 16 * kt + 4 * g + r - qpos; if (dd > 128 || dd < -128) sc[kt][r] = -1e30f; }
        }
        float tmax = -1e30f;
#pragma unroll
        for (int kt = 0; kt < 4; ++kt)
#pragma unroll
            for (int r = 0; r < 4; ++r) tmax = fmaxf(tmax, sc[kt][r]);
        tmax = fmaxf(tmax, __shfl_xor(tmax, 16)); tmax = fmaxf(tmax, __shfl_xor(tmax, 32));
        const float mn = fmaxf(m, tmax), alpha = __builtin_amdgcn_exp2f(m - mn);
        m = mn;
        float psum = 0.f;
#pragma unroll
        for (int kt = 0; kt < 4; ++kt)
#pragma unroll
            for (int r = 0; r < 4; ++r) { const float pv = __builtin_amdgcn_exp2f(sc[kt][r] - mn); sc[kt][r] = pv; psum += pv; }
        lsum = lsum * alpha + psum;
        bf16x8 Bp[2];
        Bp[0] = packacc(sc[0], sc[1]); Bp[1] = packacc(sc[2], sc[3]);
#pragma unroll
        for (int nt = 0; nt < 8; ++nt) {
            ot[nt] *= alpha;
#pragma unroll
            for (int k2 = 0; k2 < 2; ++k2) {
                const bf16x8 av = tr2(sV + (32 * k2 + 4 * g + q4) * 144 + 16 * nt + 4 * p4, sV + (32 * k2 + 16 + 4 * g + q4) * 144 + 16 * nt + 4 * p4);
                ot[nt] = mfma16(av, Bp[k2], ot[nt]);
            }
        }
    };
    SwaRegs RA, RB;
    kvload(RA, 0); kvload(RB, 1);
#pragma unroll 1
    for (int tix = 0; tix < ntot; tix += 2) { tile(RA, tix); if (tix + 1 < ntot) tile(RB, tix + 1); }
    lsum += __shfl_xor(lsum, 16); lsum += __shfl_xor(lsum, 32);
    const float inv = __builtin_amdgcn_rcpf(lsum);
#pragma unroll
    for (int nt = 0; nt < 8; ++nt) {
        const int dvb = 16 * nt + 4 * g;
        const u32x2 gw = *(const u32x2*)(S + qrow * NP + C_SWA_G + 128 * hq + dvb);
        const float g0 = lo16(gw.x), g1 = hi16(gw.x), g2 = lo16(gw.y), g3 = hi16(gw.y);
        u32x2 o; o.x = pk2(ot[nt][0] * inv * siluf(g0), ot[nt][1] * inv * siluf(g1)); o.y = pk2(ot[nt][2] * inv * siluf(g2), ot[nt][3] * inv * siluf(g3));
        *(u32x2*)(Y + qrow * DM + 1536 + 128 * hq + dvb) = o;
    }
}


#define XB_TMO      128
#define XB_XCNT(j)  (256  + 64 * (j))
#define XB_XSUB(j)  (1280 + 64 * (j))
#define XB_XGEN(j)  (2304 + 64 * (j))
#define XB_TOP      3328
#define XB_TOPGEN   3392
#define XCD_BAR_WORDS 3456
#define XB_SPIN_CAP (1u << 18)
DI unsigned xb_ld(unsigned* p)              { return __hip_atomic_load(p, __ATOMIC_RELAXED, __HIP_MEMORY_SCOPE_AGENT); }
DI unsigned xb_add(unsigned* p, unsigned v) { return __hip_atomic_fetch_add(p, v, __ATOMIC_RELAXED, __HIP_MEMORY_SCOPE_AGENT); }
DI unsigned xb_xcc_id() { return (unsigned)__builtin_amdgcn_s_getreg((3 << 11) | 20) & 0xFu; }
#define XB_SPIN(cond, bar) do { unsigned _sp = 0; while (cond) { __builtin_amdgcn_s_sleep(1); \
    if ((++_sp & 255u) == 0u) { if (xb_ld(&(bar)[XB_TMO])) break; if (_sp > XB_SPIN_CAP) { atomicAdd(&(bar)[XB_TMO], 1u); break; } } } } while (0)
struct XcdBarrier { unsigned* bar; unsigned x; volatile LAS unsigned* st; };
DI XcdBarrier xcd_barrier_post(unsigned* bar, volatile LAS unsigned* st) {
    XcdBarrier b; b.bar = bar; b.x = xb_xcc_id(); b.st = st;
    if (threadIdx.x == 0) (void)xb_add(&bar[XB_XCNT(b.x)], 1u);
    return b;
}
DI void xcd_barrier_complete(unsigned* bar, unsigned x, unsigned& nloc, unsigned& nx) {
    const unsigned G = gridDim.x * gridDim.y * gridDim.z;
    unsigned sum, cnt, mine, sp = 0u;
    for (;;) {
        sum = 0u; cnt = 0u; mine = 0u;
#pragma unroll
        for (unsigned j = 0; j < 16; ++j) { const unsigned c = xb_ld(&bar[XB_XCNT(j)]); sum += c; cnt += (c > 0u) ? 1u : 0u; mine = (j == x) ? c : mine; }
        if (sum == G) break;
        __builtin_amdgcn_s_sleep(1);
        if ((++sp & 255u) == 0u) { if (xb_ld(&bar[XB_TMO])) break; if (sp > XB_SPIN_CAP) { atomicAdd(&bar[XB_TMO], 1u); break; } }
    }
    nloc = mine > 0u ? mine : 1u; nx = cnt > 0u ? cnt : 1u;
}
DI void xcd_barrier(const XcdBarrier& b) {
    asm volatile("s_waitcnt vmcnt(0)" ::: "memory");
    __syncthreads();
    if (threadIdx.x == 0) {
        unsigned* bar = b.bar;
        __builtin_amdgcn_s_waitcnt(0);
        unsigned nloc = b.st[0], nx = b.st[1];
        if (nloc == 0u) { xcd_barrier_complete(bar, b.x, nloc, nx); b.st[0] = nloc; b.st[1] = nx; }
        const unsigned old = xb_add(&bar[XB_XSUB(b.x)], 1u);
        const unsigned gen = old / nloc;
        if (old + 1u == (gen + 1u) * nloc) {
            __builtin_amdgcn_fence(__ATOMIC_RELEASE, "agent");
            asm volatile("s_waitcnt vmcnt(0)" ::: "memory");
            const unsigned og = xb_add(&bar[XB_TOP], 1u);
            const unsigned tg = og / nx;
            if (og + 1u == (tg + 1u) * nx) xb_add(&bar[XB_TOPGEN], 1u);
            else XB_SPIN(xb_ld(&bar[XB_TOPGEN]) == tg, bar);
            __builtin_amdgcn_fence(__ATOMIC_ACQUIRE, "agent");
            xb_add(&bar[XB_XGEN(b.x)], 1u);
            asm volatile("s_waitcnt vmcnt(0)" ::: "memory");
        } else {
            XB_SPIN(xb_ld(&bar[XB_XGEN(b.x)]) == gen, bar);
            __builtin_amdgcn_fence(__ATOMIC_ACQUIRE, "agent");
            asm volatile("s_waitcnt vmcnt(0)" ::: "memory");
        }
    }
    __syncthreads();
}

DI void weight_prep_item(const P& q, int l, int it, unsigned char* sm) {
    if (it < 96) adaln_item(q, l * 96 + it, sm);
    else if (it < 96 + 896) { const int r = it - 96, kt = r / 28, nt = r % 28;
        const int n0 = nt * 256, srcoff = n0 < 1024 ? 0 : (n0 < 3072 ? 32 : 48);
        transpose_item(q.w_in + (size_t)l * DM * INW, INW, srcoff, (bf16_t*)(q.ws + WS_WINT) + (size_t)l * NP * DM, kt, nt, sm); }
    else if (it < 96 + 896 + 256) { const int r = it - 96 - 896, kt = r / 8, nt = r % 8;
        transpose_item(q.w_out + (size_t)l * DM * DM, DM, 0, (bf16_t*)(q.ws + WS_WOUTT) + (size_t)l * DM * DM, kt, nt, sm); }
    else { const int kt = it - 96 - 896 - 256;
        narrow_item(q.w_in + (size_t)l * DM * INW, (bf16_t*)(q.ws + WS_WNT) + (size_t)l * NNAR * DM, kt); }
}

#define ITEM_BEGIN { size_t z_ = 0; asm volatile("" : "+s"(z_)); q.ws = p.ws + z_; sm = smem + osgpr(0); }
#define PHASE_BEGIN P q = p; { size_t z_ = 0; asm volatile("" : "+s"(z_)); q.ws = p.ws + z_; } unsigned char* sm = smem + osgpr(0); const int b1 = osgpr(bid); (void)sm; (void)b1;
__global__ __launch_bounds__(512, 2) void mega(P p) {
    extern __shared__ __attribute__((aligned(16))) unsigned char smem[];
    cg::grid_group grid = cg::this_grid();
    const int bid = blockIdx.x, nb = gridDim.x;
    volatile LAS unsigned* xst = (volatile LAS unsigned*)(smem + LDS_BYTES - 16);
    if (threadIdx.x < 4) xst[threadIdx.x] = 0u;
    __syncthreads();
    const XcdBarrier xb = xcd_barrier_post((unsigned*)(p.ws + WS_BAR), xst);
    if (p.ws == nullptr) grid.sync();
    for (int rep = 0; rep < REP_P0; ++rep) {
        PHASE_BEGIN
        {
            unsigned* qctr = xb.bar + 40;
            volatile LAS unsigned* qw = xst + 2;
            unsigned nxt = 0u;
            if (threadIdx.x == 0) qw[0] = xb_add(qctr, 1u);
            __syncthreads();
            int it = (int)qw[0];
            __syncthreads();
            while (it < 2560) { ITEM_BEGIN
                if (threadIdx.x == 0) nxt = xb_add(qctr, 1u);
                weight_prep_item(q, it & 1, it >> 1, sm);
                if (threadIdx.x == 0) qw[0] = nxt;
                __syncthreads();
                it = (int)qw[0];
                __syncthreads(); }
        }
    }
    xcd_barrier(xb);
    { PHASE_BEGIN norm0_phase(q, sm, xb.bar + 32, xst + 2); }
    xcd_barrier(xb);
#pragma unroll 1
    for (int l0 = 0; l0 < 2; ++l0) {
        const int l = osgpr(l0);
        for (int rep = 0; rep < REP_G1; ++rep) {
            if (rep) xcd_barrier(xb);
            PHASE_BEGIN
            pg8::Gemm g{(const bf16_t*)(q.ws + WS_NBUF), (const bf16_t*)(q.ws + WS_WINT) + (size_t)l * NP * DM, NROW, NP, DM};
            pg8::StaticOrder so; so.init(g.M, g.N, nb, b1);
            pg8::EpiBf16 e{(bf16_t*)(q.ws + WS_SBUF), NP};
            pg8::gemm_phase((LAS unsigned char*)sm, g, so, e);
        }
        xcd_barrier(xb);
        for (int rep = 0; rep < REP_PREP; ++rep) {
            if (rep) xcd_barrier(xb);
            PHASE_BEGIN
            const int nconv = (l == 0 ? NROW : NLAT) / 32;
            const int ntot = 576 + 576 + nconv + 256;
            unsigned* qctr = xb.bar + 1 + l;
            volatile LAS unsigned* qw = xst + 2;
            unsigned nxt = 0u;
            if (threadIdx.x == 0) qw[0] = xb_add(qctr, 1u);
            __syncthreads();
            int it = (int)qw[0];
            __syncthreads();
            while (it < ntot) {
                ITEM_BEGIN
                if (threadIdx.x == 0) nxt = xb_add(qctr, 1u);
                if (it < 576) { for (int r2 = 0; r2 < REP_GDNP; ++r2) gdn_prep_item(q, l, it, sm); }
                else if (it < 576 + 576) { for (int r2 = 0; r2 < REP_GLAP; ++r2) gla_prep_item(q, l, it - 576, sm); }
                else if (it < 576 + 576 + nconv) conv_item(q, l, it - 576 - 576);
                else krope_item(q, it - 576 - 576 - nconv);
                if (threadIdx.x == 0) qw[0] = nxt;
                __syncthreads();
                it = (int)qw[0];
                __syncthreads();
            }
        }
        xcd_barrier(xb);
        for (int rep = 0; rep < REP_SCAN; ++rep) {
            if (rep) xcd_barrier(xb);
            PHASE_BEGIN
            if (b1 < 32) { for (int r2 = 0; r2 < REP_GLAS; ++r2) gla_scan_item(q, b1, sm); }
            else if (b1 < 160) { for (int r2 = 0; r2 < REP_GDNS; ++r2) gdn_scan_item(q, b1 - 32, sm); }
            else if (nb == 256) {
                const int j = b1 - 160, x = j & 7, nloc = l == 0 ? 36 : 32;
                unsigned* qctr = xb.bar + 8 + 8 * l + x;
                volatile LAS unsigned* qw = xst + 2;
                unsigned nxt = 0u;
                if (threadIdx.x == 0) qw[0] = xb_add(qctr, 1u);
                __syncthreads();
                int li = (int)qw[0];
                __syncthreads();
                while (li < nloc) { ITEM_BEGIN
                    if (threadIdx.x == 0) nxt = xb_add(qctr, 1u);
                    const int it = li < 32 ? ((x >> 1) * 64 + (x & 1) * 32 + li) : (256 + (x >> 1) * 8 + (x & 1) * 4 + (li - 32));
                    for (int r2 = 0; r2 < REP_SWA; ++r2) swa_item(q, l, it, sm);
                    if (threadIdx.x == 0) qw[0] = nxt;
                    __syncthreads();
                    li = (int)qw[0];
                    __syncthreads(); }
            }
            else { const int nsw = l == 0 ? 288 : 256; for (int it = b1 - 160; it < nsw; it += nb - 160) { ITEM_BEGIN for (int r2 = 0; r2 < REP_SWA; ++r2) swa_item(q, l, it, sm); } }
        }
        xcd_barrier(xb);
        { PHASE_BEGIN const int nf = (l == 0 ? NROW : NLAT) / 16; for (int it = b1; it < nf; it += nb) { ITEM_BEGIN finish_item(q, l, it); } }
        xcd_barrier(xb);
        for (int rep = 0; rep < REP_G2; ++rep) {
            if (rep) xcd_barrier(xb);
            PHASE_BEGIN
            pg8::Gemm g{(const bf16_t*)(q.ws + WS_YBUF), (const bf16_t*)(q.ws + WS_WOUTT) + (size_t)l * DM * DM, NLAT, DM, DM};
            pg8::StaticOrder so; so.init(g.M, g.N, nb, b1);
            pg8::EpiBf16 e{(bf16_t*)(q.ws + WS_SBUF), DM};
            pg8::gemm_phase((LAS unsigned char*)sm, g, so, e);
        }
        xcd_barrier(xb);
        if (l == 0) {
            {
                PHASE_BEGIN
                if (b1 < 32) {
                    pg8::Gemm g{(const bf16_t*)(q.ws + WS_YBUF) + (size_t)NLAT * DM, (const bf16_t*)(q.ws + WS_WOUTT), NROW - NLAT, DM, DM};
                    pg8::StaticOrder so; so.init(g.M, g.N, 32, b1);
                    pg8::EpiBf16 e{(bf16_t*)(q.ws + WS_SBUF) + (size_t)NLAT * DM, DM};
                    pg8::gemm_phase((LAS unsigned char*)sm, g, so, e);
                } else post_phase(q, 0, sm, 0, NLAT / 16, b1 - 32, nb - 32);
            }
            xcd_barrier(xb);
            { PHASE_BEGIN post_phase(q, 0, sm, NLAT / 16, NROW / 16, b1, nb); }
            xcd_barrier(xb);
        } else {
            PHASE_BEGIN post_phase(q, 1, sm, 0, NLAT / 16, b1, nb);
        }
    }
}

extern "C" void kernel_launch(void* const* d_in, const int* in_sizes, int n_in, void* d_out, int out_size, void* d_ws, size_t ws_size, hipStream_t stream) {
    static int grid = 0;
    if (grid == 0) {
        if (n_in != 19 || ws_size < WS_END) { fprintf(stderr, "kernel_launch: unexpected n_in %d / ws_size %zu (need %zu)\n", n_in, ws_size, (size_t)WS_END); grid = -1; return; }
        int dev = 0, cus = 0, per_cu = 0;
        hipGetDevice(&dev);
        hipDeviceGetAttribute(&cus, hipDeviceAttributeMultiprocessorCount, dev);
        hipFuncSetAttribute((const void*)mega, hipFuncAttributeMaxDynamicSharedMemorySize, LDS_BYTES);
        hipOccupancyMaxActiveBlocksPerMultiprocessor(&per_cu, (const void*)mega, 512, LDS_BYTES);
        if (per_cu < 1) per_cu = 1;
        grid = cus * per_cu;
        fprintf(stderr, "kernel_launch: cus %d per_cu %d grid %d ws %zu need %zu\n", cus, per_cu, grid, ws_size, (size_t)WS_END);
    }
    if (grid < 0) return;
    P p{};
    const float** f = (const float**)&p;
    for (int i = 0; i < 19; ++i) f[i] = (const float*)d_in[i];
    p.out = (float*)d_out; p.ws = (unsigned char*)d_ws;
    (void)hipMemsetAsync((unsigned char*)d_ws + WS_BAR, 0, 3456 * 4, stream);
    void* args[] = {&p};
    hipError_t e = hipLaunchCooperativeKernel((const void*)mega, dim3(grid), dim3(512), args, LDS_BYTES, stream);
    if (e != hipSuccess) fprintf(stderr, "cooperative launch failed: %s (grid %d)\n", hipGetErrorString(e), grid);
}
```
